# Optimizing an MI355X kernel written in HIP

```python
import math
import jax, jax.numpy as jnp
from jax import lax
import numpy as np

D_MODEL = 1024
BATCH = 16
SEQ = 2048
DEPTH = 1
DEC_BATCH = 128
DEC_SEQ = 8
PAST_LEN = 8192
PAGE_SIZE = 128

MIX_WIDTH = D_MODEL
ATT_WIDTH = MIX_WIDTH // 2
LRU_WIDTH = MIX_WIDTH - ATT_WIDTH
HEAD_DIM = 64
N_ATT_HEADS = ATT_WIDTH // HEAD_DIM
N_LRU_BLOCKS = 8
LRU_BLOCK = LRU_WIDTH // N_LRU_BLOCKS
CONV_WIDTH = 4
LRU_C = 8.0
D_FF = 4 * D_MODEL
DILATED_CONFIGS = ((128, 1), (512, 4), (2048, 16))
WIN_MAX = max(w for w, _ in DILATED_CONFIGS)
N_BUCKETS = 32
BUCKET_MAX_DIST = WIN_MAX
NORM_EPS = 1e-6
NEG_INF = -1e30
IN_COLS = 3 * ATT_WIDTH + 2 * LRU_WIDTH

kernel_name = "hymba_rglru_dilated_swa_step"


def rms_norm(x, g):
    x32 = x.astype(jnp.float32)
    y = x32 * lax.rsqrt(jnp.mean(x32 * x32, axis=-1, keepdims=True) + NORM_EPS)
    return (y * g.astype(jnp.float32)).astype(x.dtype)


def t5_bucket(dist):
    max_exact = N_BUCKETS // 2
    d_f = jnp.maximum(dist, max_exact).astype(jnp.float32)
    large = max_exact + (jnp.log(d_f / max_exact) / math.log(BUCKET_MAX_DIST / max_exact)
                         * (N_BUCKETS - max_exact)).astype(jnp.int32)
    large = jnp.minimum(large, N_BUCKETS - 1)
    return jnp.where(dist < max_exact, dist, large)


def branch_bias(rel_bias, dilation, span):
    dist = jnp.arange(span + 1, dtype=jnp.int32) * dilation
    return rel_bias[t5_bucket(dist)].astype(jnp.float32).T


def dilated_branch_prompt(q, k, v, bias, dilation, span):
    b, s, h, dh = q.shape
    L = s // dilation
    blk = span
    nb = -(-L // blk)
    lp = nb * blk

    def to_sub(t):
        t = t.reshape(b, L, dilation, h, dh).transpose(0, 2, 3, 1, 4)
        t = jnp.pad(t, ((0, 0), (0, 0), (0, 0), (0, lp - L), (0, 0)))
        return t.reshape(b, dilation, h, nb, blk, dh)

    def with_prev(t):
        prev = jnp.pad(t, ((0, 0), (0, 0), (0, 0), (1, 0), (0, 0), (0, 0)))[:, :, :, :-1]
        return jnp.concatenate([prev, t], axis=4)

    qb = to_sub(q)
    kk = with_prev(to_sub(k))
    vv = with_prev(to_sub(v))
    qi = jnp.arange(blk)[:, None]
    ki = jnp.arange(2 * blk)[None, :]
    rel = blk + qi - ki
    in_band = (rel >= 0) & (rel <= span)
    first_blk = (jnp.arange(nb)[:, None, None] == 0) & (ki[None] < blk)
    mask = in_band[None] & ~first_blk
    bias_m = bias[:, jnp.clip(rel, 0, span)]
    logits = jnp.einsum('bchnqd,bchnkd->bchnqk', qb, kk).astype(jnp.float32) * (dh ** -0.5)
    logits = logits + bias_m[None, None, :, None]
    logits = jnp.where(mask[None, None, None], logits, NEG_INF)
    m = jnp.max(logits, axis=-1, keepdims=True)
    p = jnp.exp(logits - m)
    den = jnp.sum(p, axis=-1, keepdims=True)
    o = jnp.einsum('bchnqk,bchnkd->bchnqd', p, vv.astype(jnp.float32)) / den
    lse = (m + jnp.log(den))[..., 0]
    o = o.reshape(b, dilation, h, lp, dh)[:, :, :, :L].transpose(0, 3, 1, 2, 4).reshape(b, s, h, dh)
    lse = lse.reshape(b, dilation, h, lp)[:, :, :, :L].transpose(0, 3, 1, 2).reshape(b, s, h)
    return o, lse


def dilated_branch_sample(q, k_all, v_all, bias, dilation, span, n_buf):
    t, dh = q.shape[1], q.shape[3]
    idx = n_buf + jnp.arange(t)[:, None] - dilation * jnp.arange(span + 1)[None, :]
    valid = idx >= 0
    idx = jnp.maximum(idx, 0)
    kg = k_all[:, idx]
    vg = v_all[:, idx]
    logits = jnp.einsum('bthd,btjhd->bthj', q, kg).astype(jnp.float32) * (dh ** -0.5)
    logits = logits + bias[None, None]
    logits = jnp.where(valid[None, :, None, :], logits, NEG_INF)
    m = jnp.max(logits, axis=-1, keepdims=True)
    p = jnp.exp(logits - m)
    den = jnp.sum(p, axis=-1, keepdims=True)
    o = jnp.einsum('bthj,btjhd->bthd', p, vg.astype(jnp.float32)) / den[..., 0][..., None]
    lse = (m + jnp.log(den))[..., 0]
    return o, lse


def combine_branches(outs, lses):
    w = jax.nn.softmax(jnp.stack(lses, axis=0), axis=0)
    return jnp.einsum('gbth,gbthd->bthd', w, jnp.stack(outs, axis=0))


def causal_conv(x, buf, w, b):
    t = x.shape[1]
    xp = jnp.concatenate([buf.astype(x.dtype), x], axis=1)
    y = b
    for j in range(CONV_WIDTH):
        y = y + w[j] * xp[:, j:j + t]
    return y, xp[:, xp.shape[1] - (CONV_WIDTH - 1):]


def rg_lru(xc, h0, wa, ba, wx, bx, lam):
    b, t, c = xc.shape
    x32 = xc.astype(jnp.float32)
    xb = x32.reshape(b, t, N_LRU_BLOCKS, LRU_BLOCK)
    r = jax.nn.sigmoid(jnp.einsum('btgi,gio->btgo', xb, wa) + ba).reshape(b, t, c)
    gi = jax.nn.sigmoid(jnp.einsum('btgi,gio->btgo', xb, wx) + bx).reshape(b, t, c)
    log_a = -LRU_C * r * jax.nn.softplus(-lam.astype(jnp.float32))
    a = jnp.exp(log_a)
    u = jnp.sqrt(-jnp.expm1(2.0 * log_a)) * (gi * x32)

    def step(h, au):
        a_t, u_t = au
        h = a_t * h + u_t
        return h, h

    h_last, hs = lax.scan(step, h0.astype(jnp.float32), (a.transpose(1, 0, 2), u.transpose(1, 0, 2)))
    return hs.transpose(1, 0, 2), h_last


def hybrid_layer(x, conv_buf, h0, k_buf, v_buf, norm1_g, w_in, rel_bias, conv_w, conv_b,
                 gate_a_w, gate_a_b, gate_x_w, gate_x_b, lru_lambda, att_out_g, rnn_out_g,
                 w_out, norm2_g, w_mlp_in, w_mlp_out):
    b, t, _ = x.shape
    n = rms_norm(x, norm1_g)
    proj = n @ w_in
    q, k, v, xr, gr = jnp.split(
        proj, [ATT_WIDTH, 2 * ATT_WIDTH, 3 * ATT_WIDTH, 3 * ATT_WIDTH + LRU_WIDTH], axis=-1)
    q = q.reshape(b, t, N_ATT_HEADS, HEAD_DIM)
    k = k.reshape(b, t, N_ATT_HEADS, HEAD_DIM)
    v = v.reshape(b, t, N_ATT_HEADS, HEAD_DIM)

    outs, lses = [], []
    if k_buf is None:
        for (win, dil) in DILATED_CONFIGS:
            span = win // dil
            o, l = dilated_branch_prompt(q, k, v, branch_bias(rel_bias, dil, span), dil, span)
            outs.append(o)
            lses.append(l)
        keep = min(WIN_MAX, t)
        new_k, new_v = k[:, t - keep:], v[:, t - keep:]
        conv_buf = jnp.zeros((b, CONV_WIDTH - 1, LRU_WIDTH), x.dtype)
        h0 = jnp.zeros((b, LRU_WIDTH), jnp.float32)
        state_dtype = x.dtype
    else:
        n_buf = k_buf.shape[1]
        k_all = jnp.concatenate([k_buf.astype(k.dtype), k], axis=1)
        v_all = jnp.concatenate([v_buf.astype(v.dtype), v], axis=1)
        for (win, dil) in DILATED_CONFIGS:
            span = win // dil
            o, l = dilated_branch_sample(q, k_all, v_all, branch_bias(rel_bias, dil, span), dil, span, n_buf)
            outs.append(o)
            lses.append(l)
        new_k, new_v = k, v
        state_dtype = h0.dtype
    att = combine_branches(outs, lses).astype(x.dtype).reshape(b, t, ATT_WIDTH)

    xc, new_conv = causal_conv(xr, conv_buf, conv_w, conv_b)
    hs, h_last = rg_lru(xc, h0, gate_a_w, gate_a_b, gate_x_w, gate_x_b, lru_lambda)
    rnn = (hs * jax.nn.gelu(gr.astype(jnp.float32))).astype(x.dtype)

    mixed = jnp.concatenate([rms_norm(att, att_out_g), rms_norm(rnn, rnn_out_g)], axis=-1)
    x = x + mixed @ w_out
    hmid = rms_norm(x, norm2_g) @ w_mlp_in
    x = x + jnp.square(jax.nn.relu(hmid)) @ w_mlp_out
    return x, new_k, new_v, new_conv, h_last.astype(state_dtype)


def setup_inputs(seed: int = 0) -> dict:
    key = jax.random.key(seed)
    ks = jax.random.split(key, 24)
    n_buf = min(WIN_MAX, PAST_LEN)

    def nrm(k, shape, scale):
        return jax.random.normal(k, shape, jnp.float32) * scale

    a0 = jax.random.uniform(ks[14], (DEPTH, LRU_WIDTH), jnp.float32, 0.9, 0.999)
    s0 = a0 ** (1.0 / LRU_C)
    lru_lambda = jnp.log(s0) - jnp.log1p(-s0)
    return {
        "x_prompt": nrm(ks[0], (BATCH, SEQ, D_MODEL), 1.0),
        "x_sample": nrm(ks[1], (DEC_BATCH, DEC_SEQ, D_MODEL), 1.0),
        "cache_k": nrm(ks[2], (DEPTH, DEC_BATCH, n_buf, N_ATT_HEADS, HEAD_DIM), 1.0),
        "cache_v": nrm(ks[3], (DEPTH, DEC_BATCH, n_buf, N_ATT_HEADS, HEAD_DIM), 1.0),
        "state_conv": nrm(ks[4], (DEPTH, DEC_BATCH, CONV_WIDTH - 1, LRU_WIDTH), 1.0),
        "state_h": nrm(ks[5], (DEPTH, DEC_BATCH, LRU_WIDTH), 0.5),
        "norm1_g": 1.0 + nrm(ks[6], (DEPTH, D_MODEL), 0.02),
        "w_in": nrm(ks[7], (DEPTH, D_MODEL, IN_COLS), D_MODEL ** -0.5),
        "rel_bias": nrm(ks[8], (N_BUCKETS, N_ATT_HEADS), 0.5),
        "conv_w": nrm(ks[9], (DEPTH, CONV_WIDTH, LRU_WIDTH), CONV_WIDTH ** -0.5),
        "conv_b": nrm(ks[10], (DEPTH, LRU_WIDTH), 0.02),
        "gate_a_w": nrm(ks[11], (DEPTH, N_LRU_BLOCKS, LRU_BLOCK, LRU_BLOCK), LRU_BLOCK ** -0.5),
        "gate_a_b": nrm(ks[12], (DEPTH, N_LRU_BLOCKS, LRU_BLOCK), 0.02),
        "gate_x_w": nrm(ks[13], (DEPTH, N_LRU_BLOCKS, LRU_BLOCK, LRU_BLOCK), LRU_BLOCK ** -0.5),
        "gate_x_b": nrm(ks[15], (DEPTH, N_LRU_BLOCKS, LRU_BLOCK), 0.02),
        "lru_lambda": lru_lambda,
        "att_out_g": 1.0 + nrm(ks[16], (DEPTH, ATT_WIDTH), 0.02),
        "rnn_out_g": 1.0 + nrm(ks[17], (DEPTH, LRU_WIDTH), 0.02),
        "w_out": nrm(ks[18], (DEPTH, MIX_WIDTH, D_MODEL), MIX_WIDTH ** -0.5),
        "norm2_g": 1.0 + nrm(ks[19], (DEPTH, D_MODEL), 0.02),
        "w_mlp_in": nrm(ks[20], (DEPTH, D_MODEL, D_FF), D_MODEL ** -0.5),
        "w_mlp_out": nrm(ks[21], (DEPTH, D_FF, D_MODEL), D_FF ** -0.5),
        "final_g": 1.0 + nrm(ks[22], (D_MODEL,), 0.02),
    }


def reference(x_prompt, x_sample, cache_k, cache_v, state_conv, state_h, norm1_g, w_in, rel_bias,
              conv_w, conv_b, gate_a_w, gate_a_b, gate_x_w, gate_x_b, lru_lambda, att_out_g,
              rnn_out_g, w_out, norm2_g, w_mlp_in, w_mlp_out, final_g):
    xp, xs = x_prompt, x_sample
    kp_l, vp_l, cp_l, hp_l = [], [], [], []
    ks_l, vs_l, cs_l, hs_l = [], [], [], []
    for l in range(DEPTH):
        w = (norm1_g[l], w_in[l], rel_bias, conv_w[l], conv_b[l], gate_a_w[l], gate_a_b[l],
             gate_x_w[l], gate_x_b[l], lru_lambda[l], att_out_g[l], rnn_out_g[l], w_out[l],
             norm2_g[l], w_mlp_in[l], w_mlp_out[l])
        xp, kp, vp, cp, hp = hybrid_layer(xp, None, None, None, None, *w)
        xs, kn, vn, cn, hn = hybrid_layer(xs, state_conv[l], state_h[l], cache_k[l], cache_v[l], *w)
        kp_l.append(kp)
        vp_l.append(vp)
        cp_l.append(cp)
        hp_l.append(hp)
        ks_l.append(kn)
        vs_l.append(vn)
        cs_l.append(cn)
        hs_l.append(hn)
    y_prompt = rms_norm(xp, final_g)
    y_sample = rms_norm(xs, final_g)
    return (y_prompt, y_sample,
            jnp.stack(kp_l), jnp.stack(vp_l), jnp.stack(cp_l), jnp.stack(hp_l),
            jnp.stack(ks_l), jnp.stack(vs_l), jnp.stack(cs_l), jnp.stack(hs_l))
```

```cpp
#include <hip/hip_runtime.h>
#include <cstdio>
#include <cstdint>

constexpr int DM = 1024, NB = 16, SEQ = 2048, DECB = 128, DECT = 8, NH = 8, HD = 64, ATT = 512, LRU = 512, FF = 4096, NIN = 2560;
constexpr int MP = NB * SEQ;
constexpr int MS = DECB * DECT;
constexpr int MT = MP + MS;
constexpr int NCACHE = 2048;
constexpr float NORM_EPS = 1e-6f;
constexpr float NEGV = -1e30f;
constexpr float LOG2E = 1.4426950408889634f;
constexpr float QSCALE = 0.125f * LOG2E;
constexpr size_t OFF_Y = 0;
constexpr size_t OFF_NKP = (size_t)MT * DM;
constexpr size_t OFF_NVP = OFF_NKP + (size_t)MP * ATT;
constexpr size_t OFF_NCP = OFF_NVP + (size_t)MP * ATT;
constexpr size_t OFF_NHP = OFF_NCP + (size_t)NB * 3 * LRU;
constexpr size_t OFF_NKS = OFF_NHP + (size_t)NB * LRU;
constexpr size_t OFF_NVS = OFF_NKS + (size_t)MS * ATT;
constexpr size_t OFF_NCS = OFF_NVS + (size_t)MS * ATT;
constexpr size_t OFF_NHS = OFF_NCS + (size_t)DECB * 3 * LRU;
constexpr size_t OUT_TOTAL = OFF_NHS + (size_t)DECB * LRU;
static_assert(OUT_TOTAL == 69500928, "output size");

namespace pg8 {
#define PG8_LAS __attribute__((address_space(3)))
typedef unsigned short bf16_t;
typedef short bf16x8 __attribute__((ext_vector_type(8)));
typedef float f32x4 __attribute__((ext_vector_type(4)));
typedef unsigned u32x4 __attribute__((ext_vector_type(4)));
constexpr int BM = 256, BK = 64, HALF = 128, HTB = HALF * BK * 2  , STAGE_BYTES = 8 * HTB, NXCD = 8, WGM = 8;

__host__ __device__ __forceinline__ int lds_byte(int r, int c) { const int st = (r >> 4) * 2 + (c >> 5), rr = r & 15, cc = c & 31, ob = rr * 64 + cc * 2; return st * 1024 + (ob ^ (((ob >> 9) & 1) << 5)); }
__host__ __device__ __forceinline__ void stage_rc(int b, int& R, int& C) { const int st = b / 1024, sb = b % 1024, swz = sb ^ (((sb >> 9) & 1) << 5); R = (st >> 1) * 16 + swz / 64; C = (st & 1) * 32 + (swz % 64) / 2; }
__host__ __device__ __forceinline__ int perm32(int rho) { const int n = rho >> 4, i = rho & 15; return 8 * (i >> 2) + 4 * n + (i & 3); }

struct Unit { int pm, pn; int ko = 0; };
struct Gemm { const bf16_t* A; const bf16_t* Bt; int M, N, K; int ld = 0; };

struct StaticOrder {
    int nM, nN, nwg, G, c;
    __host__ __device__ void init(int M, int N, int G_, int c_) { nM = M / BM; nN = N / BM; nwg = nM * nN; G = G_; c = c_; }
    __host__ __device__ bool next(int i, Unit& u) const {
        const long L = (long)i * G + c; if (L >= nwg) return false;
        int wgid = (int)L; { const int q = nwg / NXCD, r = nwg % NXCD, xcd = wgid % NXCD, off = wgid / NXCD; wgid = (xcd < r ? xcd * (q + 1) : r * (q + 1) + (xcd - r) * q) + off; }
        const int nig = WGM * nN, gid = wgid / nig, fm = gid * WGM, gsz = (nM - fm) < WGM ? (nM - fm) : WGM;
        u.pm = fm + ((wgid % nig) % gsz); u.pn = (wgid % nig) / gsz; return true;
    }
    __device__ __forceinline__ void a_ready(const Unit&) const {}
    __device__ __forceinline__ void done(const Unit&) const {}
};

__device__ __forceinline__ unsigned cvt_pk_bf16(float lo, float hi) { unsigned r; asm volatile("v_cvt_pk_bf16_f32 %0, %1, %2" : "=v"(r) : "v"(lo), "v"(hi)); return r; }
__device__ __forceinline__ u32x4 pack8(const f32x4 v0, const f32x4 v1) { u32x4 w; w.x = cvt_pk_bf16(v0[0], v0[1]); w.y = cvt_pk_bf16(v0[2], v0[3]); w.z = cvt_pk_bf16(v1[0], v1[1]); w.w = cvt_pk_bf16(v1[2], v1[3]); return w; }

struct EpiInProj {
    static constexpr bool PERM = true, AFTER_DRAIN = false;
    bf16_t* proj; float* out; float qscale;
    __device__ __forceinline__ void operator()(const f32x4 (&acc)[2][2][4][2], const Unit& u, int wr, int wc, int fr, int fq) const {
        const int row0 = u.pm * BM + wr * 64 + fr, col0 = u.pn * BM + wc * 32 + 8 * fq;
        const int kind = u.pn >> 1;
        const float sc = (kind == 0) ? qscale : 1.f;
        float* fdst = nullptr;
        if (kind == 1 || kind == 2) {
            const bool smp = u.pm >= (MP / BM);
            const size_t off = smp ? (kind == 1 ? OFF_NKS : OFF_NVS) : (kind == 1 ? OFF_NKP : OFF_NVP);
            const int frow = smp ? row0 - MP : row0;
            fdst = out + off + (size_t)frow * ATT + (col0 - kind * ATT);
        }
#pragma unroll
        for (int ai = 0; ai < 2; ++ai)
#pragma unroll
            for (int m = 0; m < 4; ++m) { bf16_t* rowp = proj + (size_t)(row0 + ai * HALF + m * 16) * NIN + col0;
#pragma unroll
                for (int bj = 0; bj < 2; ++bj) { const f32x4 v0 = acc[ai][bj][m][0] * sc, v1 = acc[ai][bj][m][1] * sc;
                    *(u32x4*)(rowp + bj * HALF) = pack8(v0, v1);
                    if (fdst) { float* fp = fdst + (size_t)(ai * HALF + m * 16) * ATT + bj * HALF; __builtin_nontemporal_store(v0, (f32x4*)fp); __builtin_nontemporal_store(v1, (f32x4*)(fp + 4)); } } }
    }
};
struct EpiWout {
    static constexpr bool PERM = true, AFTER_DRAIN = false;
    const float* xp; const float* xs; bf16_t* x1b; float* ss1;
    __device__ __forceinline__ void operator()(const f32x4 (&acc)[2][2][4][2], const Unit& u, int wr, int wc, int fr, int fq) const {
        const int row0 = u.pm * BM + wr * 64 + fr, col0 = u.pn * BM + wc * 32 + 8 * fq;
        const float* xin = (u.pm >= (MP / BM)) ? xs + (size_t)(row0 - MP) * DM : xp + (size_t)row0 * DM;
#pragma unroll
        for (int ai = 0; ai < 2; ++ai)
#pragma unroll
            for (int m = 0; m < 4; ++m) { const int dr = ai * HALF + m * 16; const float* xr = xin + (size_t)dr * DM + col0; bf16_t* br = x1b + (size_t)(row0 + dr) * DM + col0;
                float ss = 0.f;
#pragma unroll
                for (int bj = 0; bj < 2; ++bj) { const f32x4 a0 = *(const f32x4*)(xr + bj * HALF), a1 = *(const f32x4*)(xr + bj * HALF + 4);
                    const f32x4 v0 = acc[ai][bj][m][0] + a0, v1 = acc[ai][bj][m][1] + a1;
                    *(u32x4*)(br + bj * HALF) = pack8(v0, v1);
                    ss += (v0[0] * v0[0] + v0[1] * v0[1]) + (v0[2] * v0[2] + v0[3] * v0[3]) + (v1[0] * v1[0] + v1[1] * v1[1]) + (v1[2] * v1[2] + v1[3] * v1[3]); }
                ss += __shfl_xor(ss, 16); ss += __shfl_xor(ss, 32);
                if (fq == 0) ss1[(size_t)(row0 + dr) * 16 + u.pn * 4 + wc] = ss; }
    }
};
struct EpiUp {
    static constexpr bool PERM = true, AFTER_DRAIN = false;
    bf16_t* hb; const float* ss1;
    __device__ __forceinline__ void operator()(const f32x4 (&acc)[2][2][4][2], const Unit& u, int wr, int wc, int fr, int fq) const {
        const int row0 = u.pm * BM + wr * 64 + fr, col0 = u.pn * BM + wc * 32 + 8 * fq;
        float rs2[2];
#pragma unroll
        for (int t = 0; t < 2; ++t) { const int r = row0 + (fq >> 1) * HALF + (2 * (fq & 1) + t) * 16; const f32x4* sp = (const f32x4*)(ss1 + (size_t)r * 16);
            const f32x4 s0 = sp[0], s1 = sp[1], s2 = sp[2], s3 = sp[3]; const f32x4 s = (s0 + s1) + (s2 + s3);
            rs2[t] = 1.0f / sqrtf(((s[0] + s[1]) + (s[2] + s[3])) * (1.0f / DM) + NORM_EPS); }
        float rstd[8];
#pragma unroll
        for (int e = 0; e < 8; ++e) rstd[e] = __shfl((e & 1) ? rs2[1] : rs2[0], (e >> 1) * 16 + fr);
#pragma unroll
        for (int ai = 0; ai < 2; ++ai)
#pragma unroll
            for (int m = 0; m < 4; ++m) { bf16_t* rowp = hb + (size_t)(row0 + ai * HALF + m * 16) * FF + col0; const float rs = rstd[ai * 4 + m];
#pragma unroll
                for (int bj = 0; bj < 2; ++bj) { f32x4 v0 = acc[ai][bj][m][0] * rs, v1 = acc[ai][bj][m][1] * rs;
#pragma unroll
                    for (int i = 0; i < 4; ++i) { const float a = fmaxf(v0[i], 0.f), b = fmaxf(v1[i], 0.f); v0[i] = a * a; v1[i] = b * b; }
                    *(u32x4*)(rowp + bj * HALF) = pack8(v0, v1); } }
    }
};
struct EpiDown {
    static constexpr bool PERM = true, AFTER_DRAIN = false;
    bf16_t* xb;
    __device__ __forceinline__ void operator()(const f32x4 (&acc)[2][2][4][2], const Unit& u, int wr, int wc, int fr, int fq) const {
        const int row0 = u.pm * BM + wr * 64 + fr, col0 = u.pn * BM + wc * 32 + 8 * fq;
#pragma unroll
        for (int ai = 0; ai < 2; ++ai)
#pragma unroll
            for (int m = 0; m < 4; ++m) { bf16_t* yr = xb + (size_t)(row0 + ai * HALF + m * 16) * DM + col0;
#pragma unroll
                for (int bj = 0; bj < 2; ++bj) { const u32x4 w = *(const u32x4*)(yr + bj * HALF);
                    const f32x4 a0 = {__uint_as_float(w.x << 16), __uint_as_float(w.x & 0xffff0000u), __uint_as_float(w.y << 16), __uint_as_float(w.y & 0xffff0000u)};
                    const f32x4 a1 = {__uint_as_float(w.z << 16), __uint_as_float(w.z & 0xffff0000u), __uint_as_float(w.w << 16), __uint_as_float(w.w & 0xffff0000u)};
                    *(u32x4*)(yr + bj * HALF) = pack8(acc[ai][bj][m][0] + a0, acc[ai][bj][m][1] + a1); } }
    }
};

struct EpiSlab {
    static constexpr bool PERM = false, AFTER_DRAIN = false;
    float* slab;
    __device__ __forceinline__ void operator()(const f32x4 (&acc)[2][2][4][2], const Unit& u, int wr, int wc, int fr, int fq) const {
        const int row0 = (u.pm - MP / BM) * BM + wr * 64 + fr, col0 = u.pn * BM + wc * 32 + 4 * fq;
        float* base = slab + (size_t)(u.ko >> 8) * MS * DM;
#pragma unroll
        for (int ai = 0; ai < 2; ++ai)
#pragma unroll
            for (int m = 0; m < 4; ++m) { float* yr = base + (size_t)(row0 + ai * HALF + m * 16) * DM + col0;
#pragma unroll
                for (int bj = 0; bj < 2; ++bj) { *(f32x4*)(yr + bj * HALF) = acc[ai][bj][m][0]; *(f32x4*)(yr + bj * HALF + 16) = acc[ai][bj][m][1]; } }
    }
};
struct SplitKOrder {
    int G, c, KS;
    __device__ __forceinline__ bool next(int i, Unit& u) const { const int L = i * G + c; if (L >= 16 * KS) return false; u.pn = L & 3; u.ko = ((L >> 2) % KS) * 256; u.pm = MP / BM + L / (4 * KS); return true; }
    __device__ __forceinline__ void a_ready(const Unit&) const {}
    __device__ __forceinline__ void done(const Unit&) const {}
};

template <class Epi, class Sched, bool ALIGN_EPI = false, bool SP2 = false>
__device__ __forceinline__ void gemm_phase(PG8_LAS unsigned char* lds, const Gemm g, const Sched& S, const Epi& E) {
    int tid_ = threadIdx.x; asm volatile("" : "+v"(tid_));
    const int tid = tid_, wid = __builtin_amdgcn_readfirstlane(tid >> 6), lane = tid & 63, wr = wid >> 2, wc = wid & 3, fr = lane & 15, fq = lane >> 4;
    const int nt = g.K / BK, K = g.ld ? g.ld : g.K;
    unsigned voffA[2], voffB[2];
#pragma unroll
    for (int i = 0; i < 2; ++i) { int R, C; stage_rc(tid * 16 + i * 8192, R, C); const int Rb = Epi::PERM ? ((R & ~31) + perm32(R & 31)) : R;
        voffA[i] = (unsigned)(R * K + C) * 2u; voffB[i] = (unsigned)(Rb * K + C) * 2u; }
    const size_t kstep = (size_t)(BK * 2);
    const size_t hstep = (size_t)HALF * K * 2;
    const size_t tstep = 2 * hstep;
    const unsigned ldsw = (unsigned)wid * 1024u;
    const int aoff = lds_byte(wr * 64 + fr, fq * 8), boff = lds_byte(wc * 32 + fr, fq * 8);
#define PG8_SA(b, h) (((b) * 2 + (h)) * HTB)
#define PG8_SB(b, h) ((4 + (b) * 2 + (h)) * HTB)
#define PG8_STAGE(bufoff, gbase, voff) do { _Pragma("unroll") for (int _i = 0; _i < 2; ++_i) \
        __builtin_amdgcn_global_load_lds((const unsigned*)((const char*)(gbase) + (voff)[_i]), (PG8_LAS unsigned*)(lds + (bufoff) + ldsw + _i * 8192), 16, 0, 0); } while (0)
#define PG8_LDA(dst, b, h) do { _Pragma("unroll") for (int m = 0; m < 4; ++m) _Pragma("unroll") for (int k = 0; k < 2; ++k) dst[m][k] = *(const PG8_LAS bf16x8*)(lds + PG8_SA(b, h) + aoff + m * 2048 + k * 1024); } while (0)
#define PG8_LDB(dst, b, h) do { _Pragma("unroll") for (int n = 0; n < 2; ++n) _Pragma("unroll") for (int k = 0; k < 2; ++k) dst[n][k] = *(const PG8_LAS bf16x8*)(lds + PG8_SB(b, h) + boff + n * 2048 + k * 1024); } while (0)
#define PG8_MMA(ai, bj, At, Bt) do { __builtin_amdgcn_s_setprio(1); _Pragma("unroll") for (int m = 0; m < 4; ++m) _Pragma("unroll") for (int n = 0; n < 2; ++n) _Pragma("unroll") for (int k = 0; k < 2; ++k) \
        acc[ai][bj][m][n] = __builtin_amdgcn_mfma_f32_16x16x32_bf16(Bt[n][k], At[m][k], acc[ai][bj][m][n], 0, 0, 0); __builtin_amdgcn_s_setprio(0); } while (0)
#define PG8_WAIT_V(n) asm volatile("s_waitcnt vmcnt(" #n ")" ::: "memory")
#define PG8_WAIT_L(n) asm volatile("s_waitcnt lgkmcnt(" #n ")" ::: "memory")
#define PG8_BAR __builtin_amdgcn_s_barrier()
#define PG8_SCHED __builtin_amdgcn_sched_barrier(0)
    Unit cur, nxt; int ui = 0;
    if (!S.next(0, cur)) return;
    f32x4 acc[2][2][4][2];
#pragma unroll
    for (int a = 0; a < 2; ++a)
#pragma unroll
        for (int b = 0; b < 2; ++b)
#pragma unroll
            for (int m = 0; m < 4; ++m)
#pragma unroll
                for (int n = 0; n < 2; ++n) acc[a][b][m][n] = (f32x4){0.f, 0.f, 0.f, 0.f};
    bf16x8 At[4][2], B0[2][2], B1[2][2];
    const char* cA = (const char*)g.A + (size_t)cur.pm * tstep + (size_t)cur.ko * 2; const char* cB = (const char*)g.Bt + (size_t)cur.pn * tstep + (size_t)cur.ko * 2;
    S.a_ready(cur);
    if constexpr (SP2) {
        PG8_STAGE(PG8_SB(0, 0), cB, voffB); PG8_STAGE(PG8_SB(0, 1), cB + hstep, voffB); PG8_STAGE(PG8_SA(0, 0), cA, voffA); PG8_STAGE(PG8_SA(0, 1), cA + hstep, voffA);
        if (wr == 1) PG8_BAR;
        PG8_WAIT_V(2); PG8_BAR;
        PG8_STAGE(PG8_SB(1, 0), cB + kstep, voffB); PG8_STAGE(PG8_SA(1, 0), cA + kstep, voffA); PG8_STAGE(PG8_SB(1, 1), cB + hstep + kstep, voffB);
        PG8_WAIT_V(6); PG8_BAR;
    } else {
        PG8_STAGE(PG8_SB(0, 0), cB, voffB); PG8_STAGE(PG8_SA(0, 0), cA, voffA); PG8_STAGE(PG8_SB(0, 1), cB + hstep, voffB); PG8_STAGE(PG8_SA(0, 1), cA + hstep, voffA);
        if (wr == 1) PG8_BAR;
        PG8_WAIT_V(4); PG8_BAR;
        PG8_STAGE(PG8_SB(1, 0), cB + kstep, voffB); PG8_STAGE(PG8_SA(1, 0), cA + kstep, voffA); PG8_STAGE(PG8_SB(1, 1), cB + hstep + kstep, voffB);
        PG8_WAIT_V(6); PG8_BAR;
    }
    for (;;) {
        const bool has_next = S.next(ui + 1, nxt);
        const char* nA = has_next ? (const char*)g.A + (size_t)nxt.pm * tstep + (size_t)nxt.ko * 2 : cA; const char* nB = has_next ? (const char*)g.Bt + (size_t)nxt.pn * tstep + (size_t)nxt.ko * 2 : cB;
        for (int t = 0; t < nt; t += 2) {
            const bool last = (t == nt - 2);
            const char* a1 = cA + (size_t)(t + 1) * kstep;
            const char* a2 = last ? nA : cA + (size_t)(t + 2) * kstep; const char* b2 = last ? nB : cB + (size_t)(t + 2) * kstep;
            const char* a3 = a2 + kstep; const char* b3 = b2 + kstep;
            if (last && has_next) S.a_ready(nxt);
            if constexpr (SP2) {
            PG8_LDB(B0, 0, 0); PG8_LDB(B1, 0, 1); PG8_SCHED; PG8_LDA(At, 0, 0); PG8_STAGE(PG8_SA(1, 1), a1 + hstep, voffA);
            PG8_WAIT_V(8); PG8_WAIT_L(0); PG8_BAR; PG8_MMA(0, 0, At, B0); PG8_MMA(0, 1, At, B1); PG8_BAR; PG8_SCHED;
            PG8_LDA(At, 0, 1); PG8_STAGE(PG8_SB(0, 0), b2, voffB); PG8_STAGE(PG8_SB(0, 1), b2 + hstep, voffB); PG8_STAGE(PG8_SA(0, 0), a2, voffA);
            PG8_WAIT_V(8); PG8_WAIT_L(0); PG8_BAR; PG8_MMA(1, 0, At, B0); PG8_MMA(1, 1, At, B1); PG8_BAR; PG8_SCHED;
            PG8_LDB(B0, 1, 0); PG8_LDB(B1, 1, 1); PG8_SCHED; PG8_LDA(At, 1, 0); PG8_STAGE(PG8_SA(0, 1), a2 + hstep, voffA);
            PG8_WAIT_V(8); PG8_WAIT_L(0); PG8_BAR; PG8_MMA(0, 0, At, B0); PG8_MMA(0, 1, At, B1); PG8_BAR; PG8_SCHED;
            PG8_LDA(At, 1, 1); PG8_STAGE(PG8_SB(1, 0), b3, voffB); PG8_STAGE(PG8_SB(1, 1), b3 + hstep, voffB); PG8_STAGE(PG8_SA(1, 0), a3, voffA);
            PG8_WAIT_V(8); PG8_WAIT_L(0); PG8_BAR; PG8_MMA(1, 0, At, B0); PG8_MMA(1, 1, At, B1); PG8_BAR; PG8_SCHED;
            } else {
            PG8_LDB(B0, 0, 0); PG8_SCHED; PG8_LDA(At, 0, 0); PG8_STAGE(PG8_SA(1, 1), a1 + hstep, voffA);
            PG8_WAIT_L(8); PG8_BAR; PG8_WAIT_L(0); PG8_MMA(0, 0, At, B0); PG8_BAR; PG8_SCHED;
            PG8_LDB(B1, 0, 1); PG8_STAGE(PG8_SB(0, 0), b2, voffB);
            PG8_BAR; PG8_WAIT_L(0); PG8_MMA(0, 1, At, B1); PG8_BAR;
            PG8_LDA(At, 0, 1); PG8_STAGE(PG8_SA(0, 0), a2, voffA);
            PG8_BAR; PG8_WAIT_L(0); PG8_MMA(1, 0, At, B0); PG8_BAR; PG8_SCHED;
            PG8_STAGE(PG8_SB(0, 1), b2 + hstep, voffB);
            PG8_WAIT_V(6); PG8_BAR; PG8_MMA(1, 1, At, B1); PG8_BAR;
            PG8_LDB(B0, 1, 0); PG8_SCHED; PG8_LDA(At, 1, 0); PG8_STAGE(PG8_SA(0, 1), a2 + hstep, voffA);
            PG8_WAIT_L(8); PG8_BAR; PG8_WAIT_L(0); PG8_MMA(0, 0, At, B0); PG8_BAR; PG8_SCHED;
            PG8_LDB(B1, 1, 1); PG8_STAGE(PG8_SB(1, 0), b3, voffB);
            PG8_BAR; PG8_WAIT_L(0); PG8_MMA(0, 1, At, B1); PG8_BAR;
            PG8_LDA(At, 1, 1); PG8_STAGE(PG8_SA(1, 0), a3, voffA);
            PG8_BAR; PG8_WAIT_L(0); PG8_MMA(1, 0, At, B0); PG8_BAR; PG8_SCHED;
            PG8_STAGE(PG8_SB(1, 1), b3 + hstep, voffB);
            PG8_WAIT_V(6); PG8_BAR; PG8_MMA(1, 1, At, B1); PG8_BAR;
            }
        }
        if constexpr (ALIGN_EPI) { if (wr == 0) PG8_BAR; }
        if constexpr (!Epi::AFTER_DRAIN) { E(acc, cur, wr, wc, fr, fq); S.done(cur); }
        if (!has_next) break;
#pragma unroll
        for (int a = 0; a < 2; ++a)
#pragma unroll
            for (int b = 0; b < 2; ++b)
#pragma unroll
                for (int m = 0; m < 4; ++m)
#pragma unroll
                    for (int n = 0; n < 2; ++n) acc[a][b][m][n] = (f32x4){0.f, 0.f, 0.f, 0.f};
        cur = nxt; cA = nA; cB = nB; ++ui;
        if constexpr (ALIGN_EPI) { if (wr == 1) PG8_BAR; }
    }
    PG8_WAIT_V(0);
    if constexpr (!ALIGN_EPI) { if (wr == 0) PG8_BAR; }
    PG8_BAR;
    if constexpr (Epi::AFTER_DRAIN) { E.fused(acc, cur, wr, wc, fr, fq, lds, wid, lane); S.done(cur); }
#undef PG8_SA
#undef PG8_SB
#undef PG8_STAGE
#undef PG8_LDA
#undef PG8_LDB
#undef PG8_MMA
#undef PG8_WAIT_V
#undef PG8_WAIT_L
#undef PG8_BAR
#undef PG8_SCHED
}
}

constexpr size_t MiB = 1u << 20;
constexpr size_t WS_CTL = 0, CTL_ZERO_BYTES = 64 * 1024;
constexpr size_t WS_WIN = 1 * MiB;
constexpr size_t WS_WOUT = 8 * MiB;
constexpr size_t WS_W1 = 10 * MiB;
constexpr size_t WS_W2 = 18 * MiB;
constexpr size_t WS_GW = 26 * MiB;
constexpr size_t WS_SS1 = 27 * MiB;
constexpr size_t WS_SUMA = 30 * MiB, WS_SUMH = 31 * MiB;
constexpr size_t WS_LSE = 32 * MiB;
constexpr size_t WS_LSES = 36 * MiB;
constexpr size_t WS_OBS = 37 * MiB;
constexpr size_t WS_XRS = 43 * MiB;
constexpr size_t WS_XN = 64 * MiB;
constexpr size_t WS_PROJ = 132 * MiB;
constexpr size_t WS_OB = 300 * MiB;
constexpr size_t WS_MIXED = 400 * MiB;
constexpr size_t WS_X1B = 468 * MiB;
constexpr size_t WS_HB = 536 * MiB;
constexpr size_t WS_Y2 = 804 * MiB;
constexpr size_t WS_SLAB = 840 * MiB;
constexpr size_t WS_END = 904 * MiB;
static_assert(WS_WIN + (size_t)NIN * DM * 2 <= WS_WOUT && WS_SS1 + (size_t)MT * 16 * 4 <= WS_SUMA && WS_LSE + (size_t)3 * MT * 8 * 4 <= WS_LSES && WS_OBS + (size_t)4 * MS * 512 * 2 <= WS_XN, "ws map 1");
static_assert(WS_XN + (size_t)MT * DM * 2 <= WS_PROJ && WS_PROJ + (size_t)MT * NIN * 2 <= WS_OB && WS_OB + (size_t)3 * MT * 512 * 2 <= WS_MIXED && WS_MIXED + (size_t)MT * DM * 2 <= WS_X1B && WS_X1B + (size_t)MT * DM * 2 <= WS_HB && WS_HB + (size_t)MT * FF * 2 <= WS_Y2 && WS_Y2 + (size_t)MT * LRU * 2 <= WS_SLAB && WS_SLAB + (size_t)16 * MS * DM * 4 <= WS_END, "ws map 2");
constexpr int CW_BAR = 4096;

constexpr int RING_OFF = 0, RING_BYTES = 131072;
constexpr int LDSCTL_OFF = RING_BYTES, MISC_OFF = LDSCTL_OFF + 320;
constexpr int GWL_OFF = LDSCTL_OFF + 1024;
constexpr int HAL_OFF = GWL_OFF + 16384;
constexpr int LDS_BYTES = HAL_OFF + 8192;
constexpr int BT_OFF = 0;
constexpr int TS_OFF = 18432;
constexpr int TS_STRIDE = 2112;
constexpr int CW_OFF = TS_OFF + 8 * TS_STRIDE * 4;
constexpr int CB_OFF = CW_OFF + 8192;
constexpr int STG_OFF = CB_OFF + 2048;
static_assert(STG_OFF + 8 * 4096 <= RING_BYTES, "P2 LDS scratch");

#define GAS __attribute__((address_space(1)))
#define LAS __attribute__((address_space(3)))
typedef unsigned short bf16;
typedef unsigned v4u __attribute__((ext_vector_type(4)));
typedef unsigned v2u __attribute__((ext_vector_type(2)));
typedef float f32x4 __attribute__((ext_vector_type(4)));
typedef float f32x16 __attribute__((ext_vector_type(16)));
typedef short bf16x8 __attribute__((ext_vector_type(8)));
typedef GAS unsigned gu32;
#define RLX_AGENT __ATOMIC_RELAXED, __HIP_MEMORY_SCOPE_AGENT
#define LDS_WAIT() asm volatile("s_waitcnt lgkmcnt(0)" ::: "memory")
#define VM_WAIT() asm volatile("s_waitcnt vmcnt(0)" ::: "memory")
#define MFMA32(a, b, c) __builtin_amdgcn_mfma_f32_32x32x16_bf16((a), (b), (c), 0, 0, 0)
__device__ __forceinline__ unsigned cvtpk(float lo, float hi) { typedef float f2_t __attribute__((ext_vector_type(2))); typedef __bf16 b2_t __attribute__((ext_vector_type(2))); f2_t v = {lo, hi}; b2_t b = __builtin_convertvector(v, b2_t); return __builtin_bit_cast(unsigned, b); }
__device__ __forceinline__ float bflo(unsigned w) { return __uint_as_float(w << 16); }
__device__ __forceinline__ float bfhi(unsigned w) { return __uint_as_float(w & 0xffff0000u); }
__device__ __forceinline__ bf16x8 pack8f(const f32x4 a, const f32x4 b) { v4u p; p.x = cvtpk(a[0], a[1]); p.y = cvtpk(a[2], a[3]); p.z = cvtpk(b[0], b[1]); p.w = cvtpk(b[2], b[3]); return __builtin_bit_cast(bf16x8, p); }
template <int S> __device__ __forceinline__ bf16x8 pack_step(const f32x16& x) { v4u p; p.x = cvtpk(x[8 * S], x[8 * S + 1]); p.y = cvtpk(x[8 * S + 2], x[8 * S + 3]); p.z = cvtpk(x[8 * S + 4], x[8 * S + 5]); p.w = cvtpk(x[8 * S + 6], x[8 * S + 7]); return __builtin_bit_cast(bf16x8, p); }
__device__ __forceinline__ float lo_half(float x) { auto rr = __builtin_amdgcn_permlane32_swap(__float_as_uint(x), __float_as_uint(x), false, false); return __uint_as_float(rr[0]); }
__device__ __forceinline__ float hi_half(float x) { auto rr = __builtin_amdgcn_permlane32_swap(__float_as_uint(x), __float_as_uint(x), false, false); return __uint_as_float(rr[1]); }
__device__ __forceinline__ float ex2(float x) { return __builtin_amdgcn_exp2f(x); }
__device__ __forceinline__ f32x16 zero16() { f32x16 z;
#pragma unroll
    for (int i = 0; i < 16; ++i) z[i] = 0.f; return z; }
__device__ __forceinline__ bf16x8 make_E(int s, int lane) { const int kk = (lane & 31) - 16 * s - 8 * (lane >> 5); bf16x8 e;
#pragma unroll
    for (int i = 0; i < 8; ++i) e[i] = (i == kk) ? (short)0x3F80 : (short)0; return e; }
__device__ __forceinline__ bf16x8 make_F(int s, int lane) { const int j = lane & 31, hb = lane >> 5; const bool on = ((j >> 4) == s) && (((j >> 2) & 1) == hb); const int kk = ((j >> 3) & 1) * 4 + (j & 3); bf16x8 e;
#pragma unroll
    for (int i = 0; i < 8; ++i) e[i] = (on && i == kk) ? (short)0x3F80 : (short)0; return e; }
__device__ __forceinline__ float wave_sum(float v) {
#pragma unroll
    for (int o = 1; o < 64; o <<= 1) v += __shfl_xor(v, o);
    return v;
}
__device__ __forceinline__ int t5_bucket(int dist) {
    if (dist < 16) return dist;
    const float df = (float)dist;
    int large = 16 + (int)(logf(df / 16.0f) / 4.852030263919617f * 16.0f);
    return large < 31 ? large : 31;
}

typedef short v4i16_t __attribute__((ext_vector_type(4)));
__device__ __forceinline__ bf16x8 vt_frag(const LAS unsigned char* img, int s, int nb, int lane) {
    const int hi = lane >> 5, a = (lane >> 4) & 1, q = (lane & 15) >> 2, p = lane & 3;
    const int r0 = 16 * s + 4 * hi + q, c16 = 4 * nb + 2 * a + (p >> 1), sw = (r0 >> 1) & 7;
    const LAS unsigned char* p0 = img + r0 * 128 + 16 * (c16 ^ sw) + 8 * (p & 1);
    const LAS unsigned char* p1 = img + (r0 + 8) * 128 + 16 * (c16 ^ sw ^ 4) + 8 * (p & 1);
    const v4i16_t lo = __builtin_amdgcn_ds_read_tr16_b64_v4i16((LAS v4i16_t*)p0), hh = __builtin_amdgcn_ds_read_tr16_b64_v4i16((LAS v4i16_t*)p1);
    return __builtin_shufflevector(lo, hh, 0, 1, 2, 3, 4, 5, 6, 7);
}
#define XB_TMO      128
#define XB_XCNT(j)  (256  + 64 * (j))
#define XB_XSUB(j)  (1280 + 64 * (j))
#define XB_XGEN(j)  (2304 + 64 * (j))
#define XB_TOP      3328
#define XB_TOPGEN   3392
#define XCD_BAR_WORDS 3456
#define XB_SPIN_CAP (1u << 18)

__device__ __forceinline__ unsigned xb_ld(unsigned* p)              { return __hip_atomic_load(p, __ATOMIC_RELAXED, __HIP_MEMORY_SCOPE_AGENT); }
__device__ __forceinline__ unsigned xb_add(unsigned* p, unsigned v) { return __hip_atomic_fetch_add(p, v, __ATOMIC_RELAXED, __HIP_MEMORY_SCOPE_AGENT); }
__device__ __forceinline__ unsigned xb_xcc_id() { return (unsigned)__builtin_amdgcn_s_getreg((3 << 11) | 20) & 0xFu; }
#define XB_SPIN(cond, bar) do { unsigned _sp = 0; while (cond) { __builtin_amdgcn_s_sleep(1); \
    if ((++_sp & 255u) == 0u) { if (xb_ld(&(bar)[XB_TMO])) break; if (_sp > XB_SPIN_CAP) { atomicAdd(&(bar)[XB_TMO], 1u); break; } } } } while (0)

struct XcdBarrier {
    unsigned* bar; unsigned x;
    volatile LAS unsigned* st;
};

__device__ __forceinline__ XcdBarrier xcd_barrier_post(unsigned* bar, volatile LAS unsigned* st) {
    XcdBarrier b; b.bar = bar; b.x = xb_xcc_id(); b.st = st;
    if (threadIdx.x == 0) (void)xb_add(&bar[XB_XCNT(b.x)], 1u);
    return b;
}
__device__ __forceinline__ void xcd_barrier_complete(unsigned* bar, unsigned x, unsigned& nloc, unsigned& nx) {
    const unsigned G = gridDim.x * gridDim.y * gridDim.z;
    unsigned sum, cnt, mine, sp = 0u;
    for (;;) {
        sum = 0u; cnt = 0u; mine = 0u;
#pragma unroll
        for (unsigned j = 0; j < 16; ++j) { const unsigned c = xb_ld(&bar[XB_XCNT(j)]); sum += c; cnt += (c > 0u) ? 1u : 0u; mine = (j == x) ? c : mine; }
        if (sum == G) break;
        __builtin_amdgcn_s_sleep(1);
        if ((++sp & 255u) == 0u) { if (xb_ld(&bar[XB_TMO])) break; if (sp > XB_SPIN_CAP) { atomicAdd(&bar[XB_TMO], 1u); break; } }
    }
    nloc = mine > 0u ? mine : 1u; nx = cnt > 0u ? cnt : 1u;
}

__device__ __forceinline__ void xcd_barrier(const XcdBarrier& b) {
    asm volatile("s_waitcnt vmcnt(0)" ::: "memory");
    __syncthreads();
    if (threadIdx.x == 0) {
        unsigned* bar = b.bar;
        __builtin_amdgcn_s_waitcnt(0);
        unsigned nloc = b.st[0], nx = b.st[1];
        if (nloc == 0u) { xcd_barrier_complete(bar, b.x, nloc, nx); b.st[0] = nloc; b.st[1] = nx; }
        const unsigned old = xb_add(&bar[XB_XSUB(b.x)], 1u);
        const unsigned gen = old / nloc;
        if (old + 1u == (gen + 1u) * nloc) {
            __builtin_amdgcn_fence(__ATOMIC_RELEASE, "agent");
            asm volatile("s_waitcnt vmcnt(0)" ::: "memory");
            const unsigned og = xb_add(&bar[XB_TOP], 1u);
            const unsigned tg = og / nx;
            if (og + 1u == (tg + 1u) * nx) xb_add(&bar[XB_TOPGEN], 1u);
            else XB_SPIN(xb_ld(&bar[XB_TOPGEN]) == tg, bar);
            __builtin_amdgcn_fence(__ATOMIC_ACQUIRE, "agent");
            xb_add(&bar[XB_XGEN(b.x)], 1u);
            asm volatile("s_waitcnt vmcnt(0)" ::: "memory");
        } else {
            XB_SPIN(xb_ld(&bar[XB_XGEN(b.x)]) == gen, bar);
            __builtin_amdgcn_fence(__ATOMIC_ACQUIRE, "agent");
            asm volatile("s_waitcnt vmcnt(0)" ::: "memory");
        }
    }
    __syncthreads();
}

__device__ __forceinline__ void p0_transpose_item(const float* W, const float* gain, int K, int N, bf16* WT, LAS float* scr, int item, int lane) {
    const int nblk = N / 32, kb = item / nblk, nb = item % nblk, k0 = 64 * kb, n0 = 32 * nb;
    const GAS float* wp = (const GAS float*)W + (size_t)(k0 + (lane >> 5)) * N + n0 + (lane & 31);
    float v[32];
#pragma unroll
    for (int i = 0; i < 32; ++i) v[i] = __builtin_nontemporal_load(wp + (size_t)(2 * i) * N);
    if (gain) {
#pragma unroll
        for (int i = 0; i < 32; ++i) v[i] *= ((const GAS float*)gain)[k0 + 2 * i + (lane >> 5)];
    }
#pragma unroll
    for (int i = 0; i < 32; ++i) scr[(2 * i + (lane >> 5)) * 33 + (lane & 31)] = v[i];
    LDS_WAIT(); asm volatile("" ::: "memory");
    const int c = lane & 7;
#pragma unroll
    for (int j = 0; j < 4; ++j) { const int n = (lane >> 3) + 8 * j; const LAS float* s = scr + (8 * c) * 33 + n;
        v4u o; o.x = cvtpk(s[0 * 33], s[1 * 33]); o.y = cvtpk(s[2 * 33], s[3 * 33]); o.z = cvtpk(s[4 * 33], s[5 * 33]); o.w = cvtpk(s[6 * 33], s[7 * 33]);
        *(GAS v4u*)(WT + (size_t)(n0 + n) * K + k0 + 8 * c) = o; }
    LDS_WAIT(); asm volatile("" ::: "memory");
}
template <int NR>
__device__ __forceinline__ void rms_rows_to_bf16(const float* xp, const float* xs, const float* g, bf16* xn, int m0, int stride, int lane) {
    f32x4 v[NR][4];
#pragma unroll
    for (int r = 0; r < NR; ++r) { const int m = m0 + r * stride; const int mc = m < MT ? m : MT - 1;
        const GAS f32x4* xr = (const GAS f32x4*)(mc < MP ? xp + (size_t)mc * DM : xs + (size_t)(mc - MP) * DM) + lane;
#pragma unroll
        for (int j = 0; j < 4; ++j) v[r][j] = __builtin_nontemporal_load(xr + 64 * j); }
    const GAS f32x4* gr = (const GAS f32x4*)g + lane;
    f32x4 gg[4];
#pragma unroll
    for (int j = 0; j < 4; ++j) gg[j] = gr[64 * j];
#pragma unroll
    for (int r = 0; r < NR; ++r) { const int m = m0 + r * stride;
        float s = 0.f;
#pragma unroll
        for (int j = 0; j < 4; ++j) s += (v[r][j].x * v[r][j].x + v[r][j].y * v[r][j].y) + (v[r][j].z * v[r][j].z + v[r][j].w * v[r][j].w);
        const float rstd = 1.0f / sqrtf(wave_sum(s) * (1.f / DM) + NORM_EPS);
        if (m < MT) { GAS v2u* o8 = (GAS v2u*)(xn + (size_t)m * DM) + lane;
#pragma unroll
            for (int j = 0; j < 4; ++j) { v2u w; w.x = cvtpk(v[r][j].x * rstd * gg[j].x, v[r][j].y * rstd * gg[j].y); w.y = cvtpk(v[r][j].z * rstd * gg[j].z, v[r][j].w * rstd * gg[j].w); o8[64 * j] = w; } } }
}

__device__ __forceinline__ void build_tables(LAS unsigned char* lds, const float* rel_bias, const float* conv_w, const float* conv_b, const bf16* gw, int g, int tid) {
    LAS float* bt = (LAS float*)(lds + BT_OFF);
    for (int i = tid; i < 3 * 8 * 192; i += 512) { const int g = i / 1536, h = (i / 192) & 7, idx = i % 192, j = idx - 31; const int dil = g == 0 ? 1 : (g == 1 ? 4 : 16);
        bt[i] = (j >= 0 && j <= 128) ? rel_bias[t5_bucket(j * dil) * 8 + h] * LOG2E : NEGV; }
    LAS float* ts = (LAS float*)(lds + TS_OFF);
    for (int i = tid; i < 8 * TS_STRIDE; i += 512) { const int h = i / TS_STRIDE, idx = i % TS_STRIDE, dl = idx - 8; float v = NEGV;
        if (dl >= 0 && dl <= 2055) { const int m = (dl <= 128 ? 1 : 0) + (((dl & 3) == 0 && dl <= 512) ? 1 : 0) + (((dl & 15) == 0 && dl <= 2048) ? 1 : 0);
            if (m > 0) v = (m == 1 ? 0.f : (m == 2 ? 1.f : 1.5849625007211562f)) + rel_bias[t5_bucket(dl) * 8 + h] * LOG2E; }
        ts[i] = v; }
    LAS float* cw = (LAS float*)(lds + CW_OFF);
    for (int i = tid; i < 4 * 512; i += 512) cw[i] = conv_w[i];
    LAS float* cb = (LAS float*)(lds + CB_OFF);
    for (int i = tid; i < 512; i += 512) cb[i] = conv_b[i];
    for (int i = tid; i < 1024; i += 512) { const int mat = i >> 9, orow = (i >> 3) & 63, chn = i & 7;
        const v4u v = *(const GAS v4u*)((const GAS bf16*)gw + ((size_t)(mat * 8 + g) * 64 + orow) * 64 + chn * 8);
        *(LAS v4u*)(lds + GWL_OFF + mat * 8192 + orow * 128 + 16 * (chn ^ ((orow >> 1) & 7))) = v; }
}

template <int NT>
__device__ __forceinline__ void pa_body(const GAS bf16* proj, GAS bf16* po, GAS float* plse, const LAS float* tb0, LAS unsigned char* stg, int rowq, unsigned offk0, unsigned ostep, unsigned ostepq, int lane, const bf16x8 E0, const bf16x8 E1) {
    const int hi = lane >> 5, kv = lane & 31;
    bf16x8 qf[4];
    { const GAS bf16* pq = proj + (size_t)rowq * NIN + hi * 8;
#pragma unroll
      for (int ks = 0; ks < 4; ++ks) qf[ks] = *(const GAS bf16x8*)(pq + 16 * ks); }
    v4u kr[NT][4];
#pragma unroll
    for (int j = 0; j < NT; ++j)
#pragma unroll
        for (int i = 0; i < 4; ++i) { const int row = 8 * i + (lane >> 3); const unsigned ch = (unsigned)((lane & 7) ^ ((row >> 1) & 7));
            kr[j][i] = *(const GAS v4u*)(proj + (offk0 + (unsigned)j * ostep + (unsigned)i * (ostep >> 2) + 512u + 8u * ch)); }
    LAS unsigned char* wr = stg + 16 * lane;
    const LAS unsigned char* rd0 = stg + kv * 128;
    const int sw = (kv >> 1) & 7;
    const f32x16 zero = zero16();
    f32x16 p[NT];
#pragma unroll
    for (int j = 0; j < NT; ++j) {
#pragma unroll
        for (int i = 0; i < 4; ++i) *(LAS v4u*)(wr + i * 1024) = kr[j][i];
        f32x16 a = zero;
#pragma unroll
        for (int ks = 0; ks < 4; ++ks) a = MFMA32(*(const LAS bf16x8*)(rd0 + 16 * ((2 * ks + hi) ^ sw)), qf[ks], a);
        p[j] = a;
    }
    __builtin_amdgcn_sched_barrier(0);
    constexpr int NV1 = NT < 2 ? NT : 2;
    v4u vr[NT][4];
#pragma unroll
    for (int j = 0; j < NV1; ++j)
#pragma unroll
        for (int i = 0; i < 4; ++i) { const int row = 8 * i + (lane >> 3); const unsigned ch = (unsigned)((lane & 7) ^ ((row >> 1) & 7));
            vr[j][i] = *(const GAS v4u*)(proj + (offk0 + (unsigned)j * ostep + (unsigned)i * (ostep >> 2) + 1024u + 8u * ch)); }
    float m = NEGV;
#pragma unroll
    for (int j = 0; j < NT; ++j) { const LAS float* tb = tb0 - 32 * (j + 5 - NT);
#pragma unroll
        for (int r = 0; r < 16; ++r) { p[j][r] += tb[27 - ((r & 3) + 8 * (r >> 2))]; m = fmaxf(m, p[j][r]); } }
    m = fmaxf(lo_half(m), hi_half(m));
    float l = 0.f;
    bf16x8 pb[NT][2];
#pragma unroll
    for (int j = 0; j < NT; ++j) {
#pragma unroll
        for (int r = 0; r < 16; ++r) { const float e = ex2(p[j][r] - m); p[j][r] = e; l += e; }
        pb[j][0] = pack_step<0>(p[j]); pb[j][1] = pack_step<1>(p[j]);
    }
    l = lo_half(l) + hi_half(l);
    __builtin_amdgcn_sched_barrier(0);
#pragma unroll
    for (int j = NV1; j < NT; ++j)
#pragma unroll
        for (int i = 0; i < 4; ++i) { const int row = 8 * i + (lane >> 3); const unsigned ch = (unsigned)((lane & 7) ^ ((row >> 1) & 7));
            vr[j][i] = *(const GAS v4u*)(proj + (offk0 + (unsigned)j * ostep + (unsigned)i * (ostep >> 2) + 1024u + 8u * ch)); }
    f32x16 o0 = zero, o1 = zero;
#pragma unroll
    for (int j = 0; j < NT; ++j) {
#pragma unroll
        for (int i = 0; i < 4; ++i) *(LAS v4u*)(wr + i * 1024) = vr[j][i];
        const bf16x8 v0 = *(const LAS bf16x8*)(rd0 + 16 * ((0 + hi) ^ sw)), v1 = *(const LAS bf16x8*)(rd0 + 16 * ((2 + hi) ^ sw)), v2 = *(const LAS bf16x8*)(rd0 + 16 * ((4 + hi) ^ sw)), v3 = *(const LAS bf16x8*)(rd0 + 16 * ((6 + hi) ^ sw));
        f32x16 x0 = MFMA32(v0, E0, zero); x0 = MFMA32(v1, E1, x0);
        f32x16 x1 = MFMA32(v2, E0, zero); x1 = MFMA32(v3, E1, x1);
        o0 = MFMA32(pack_step<0>(x0), pb[j][0], o0); o1 = MFMA32(pack_step<0>(x1), pb[j][0], o1);
        o0 = MFMA32(pack_step<1>(x0), pb[j][1], o0); o1 = MFMA32(pack_step<1>(x1), pb[j][1], o1);
    }
    const float inv = __builtin_amdgcn_rcpf(l);
    { LAS unsigned char* wq = stg + kv * 128 + 8 * hi;
#pragma unroll
      for (int rg = 0; rg < 4; ++rg) {
        v2u w0, w1;
        w0.x = cvtpk(o0[4 * rg] * inv, o0[4 * rg + 1] * inv); w0.y = cvtpk(o0[4 * rg + 2] * inv, o0[4 * rg + 3] * inv);
        w1.x = cvtpk(o1[4 * rg] * inv, o1[4 * rg + 1] * inv); w1.y = cvtpk(o1[4 * rg + 2] * inv, o1[4 * rg + 3] * inv);
        *(LAS v2u*)(wq + 16 * (rg ^ sw)) = w0; *(LAS v2u*)(wq + 16 * ((4 + rg) ^ sw)) = w1;
      } }
#pragma unroll
    for (int i = 0; i < 4; ++i) { const int row = 8 * i + (lane >> 3); const unsigned ch = (unsigned)((lane & 7) ^ ((row >> 1) & 7));
        const v4u v = *(const LAS v4u*)(stg + i * 1024 + 16 * lane);
        *(GAS v4u*)(po + ((unsigned)i * ostepq + 8u * ch)) = v; }
    if (hi == 0) *plse = m + log2f(l);
}
__device__ __forceinline__ void pa_task(const bf16* proj, bf16* ob, float* lse, const LAS float* btab, LAS unsigned char* stg, int id, int lane_in, const int DUMMY = 0) {
    int lane = lane_in; asm volatile("" : "+v"(lane));
    const bf16x8 E0 = make_E(0, lane), E1 = make_E(1, lane);
    const int g = id >> 13, rem = id & 8191, bh = rem >> 6, k64 = (rem + 21 * (id >> 11)) & 63, b = bh >> 3, h = bh & 7;
    int d, c, ti;
    if (g == 0) { d = 1; c = 0; ti = k64; } else if (g == 1) { d = 4; c = k64 >> 4; ti = k64 & 15; } else { d = 16; c = k64 >> 2; ti = k64 & 3; }
    const int q = lane & 31, hi = lane >> 5, i0 = ti * 32;
    const int nt = ti < 4 ? ti + 1 : 5;
    int rowq = b * SEQ + d * (i0 + q) + c;
    int rowk0 = b * SEQ + d * (i0 - 32 * (nt - 1) + (lane >> 3)) + c;
    int dd = d;
    if (DUMMY == 1) { rowq &= 63; rowk0 &= 63; dd = 0; }
    const GAS bf16* pj = (const GAS bf16*)proj + h * 64;
    const int rowq8 = (DUMMY == 1) ? ((lane >> 3) & 63) : b * SEQ + d * (i0 + (lane >> 3)) + c;
    GAS bf16* po = (GAS bf16*)ob + ((size_t)g * MT + rowq8) * ATT + h * 64;
    GAS float* pl = (GAS float*)lse + ((size_t)g * MT + rowq) * 8 + h;
    const LAS float* tb0 = btab + (g * 8 + h) * 192 + (159 - 27 + q - 4 * hi);
    const unsigned ostepq = (unsigned)(8 * dd) * (unsigned)ATT;
    const unsigned offk0 = (unsigned)rowk0 * (unsigned)NIN, ostep = (unsigned)(32 * dd) * (unsigned)NIN;
    if (nt == 5) pa_body<5>(pj, po, pl, tb0, stg, rowq, offk0, ostep, ostepq, lane, E0, E1);
    else if (nt == 4) pa_body<4>(pj, po, pl, tb0, stg, rowq, offk0, ostep, ostepq, lane, E0, E1);
    else if (nt == 3) pa_body<3>(pj, po, pl, tb0, stg, rowq, offk0, ostep, ostepq, lane, E0, E1);
    else if (nt == 2) pa_body<2>(pj, po, pl, tb0, stg, rowq, offk0, ostep, ostepq, lane, E0, E1);
    else pa_body<1>(pj, po, pl, tb0, stg, rowq, offk0, ostep, ostepq, lane, E0, E1);
}

struct SaHalf { f32x4 x[8]; };
__device__ __forceinline__ void sa_load(SaHalf& t, const float* c, int b, int h, int tile, int lane) {
    const int pbase = tile < 24 ? 64 * tile : 1536 + 32 * (tile - 24), strd = tile < 24 ? 16 : 8;
    const GAS float* p0 = (const GAS float*)c + ((size_t)b * NCACHE * NH + h) * HD + 4 * (lane & 15);
#pragma unroll
    for (int i = 0; i < 8; ++i) { const int r = 4 * i + (lane >> 4); const int prow = pbase + strd * (r >> 3) + (r & 7);
        t.x[i] = __builtin_nontemporal_load((const GAS f32x4*)(p0 + (size_t)prow * (NH * HD))); }
}
__device__ __forceinline__ void sa_stage(const SaHalf& t, LAS unsigned char* stg, int lane, bf16x8 (&f)[4]) {
#pragma unroll
    for (int i = 0; i < 8; ++i) { const int r = 4 * i + (lane >> 4); v2u w; w.x = cvtpk(t.x[i][0], t.x[i][1]); w.y = cvtpk(t.x[i][2], t.x[i][3]);
        *(LAS v2u*)(stg + r * 128 + 16 * (((lane & 15) >> 1) ^ ((r >> 1) & 7)) + 8 * (lane & 1)) = w; }
    const int kv = lane & 31, hi = lane >> 5, sw = (kv >> 1) & 7;
#pragma unroll
    for (int ks = 0; ks < 4; ++ks) f[ks] = *(const LAS bf16x8*)(stg + kv * 128 + 16 * ((2 * ks + hi) ^ sw));
}
__device__ __forceinline__ void sa_step(const bf16x8 (&kf)[4], const bf16x8 (&vf)[4], const bf16x8 (&qf)[4], const LAS float* ts, int dbase, int strd, float& m, float& l, f32x16& o0, f32x16& o1, const bf16x8 E0, const bf16x8 E1) {
    const f32x16 zero = zero16();
    f32x16 a = zero;
#pragma unroll
    for (int ks = 0; ks < 4; ++ks) a = MFMA32(kf[ks], qf[ks], a);
#pragma unroll
    for (int r = 0; r < 16; ++r) { int dl = dbase - strd * (r >> 2) - (r & 3); dl = dl < -1 ? -1 : dl; a[r] += ts[dl]; }
    float mx = a[0];
#pragma unroll
    for (int r = 1; r < 16; ++r) mx = fmaxf(mx, a[r]);
    mx = fmaxf(lo_half(mx), hi_half(mx));
    const float mn = fmaxf(fmaxf(m, mx), -1e20f);
    const float sc = ex2(m - mn);
    float ls = 0.f;
#pragma unroll
    for (int r = 0; r < 16; ++r) { const float e = ex2(a[r] - mn); a[r] = e; ls += e; }
    ls = lo_half(ls) + hi_half(ls);
    l = l * sc + ls; m = mn;
#pragma unroll
    for (int r = 0; r < 16; ++r) { o0[r] *= sc; o1[r] *= sc; }
    f32x16 x0 = MFMA32(vf[0], E0, zero); x0 = MFMA32(vf[1], E1, x0);
    f32x16 x1 = MFMA32(vf[2], E0, zero); x1 = MFMA32(vf[3], E1, x1);
    { const bf16x8 pb = pack_step<0>(a); o0 = MFMA32(pack_step<0>(x0), pb, o0); o1 = MFMA32(pack_step<0>(x1), pb, o1); }
    { const bf16x8 pb = pack_step<1>(a); o0 = MFMA32(pack_step<1>(x0), pb, o0); o1 = MFMA32(pack_step<1>(x1), pb, o1); }
}
__device__ __forceinline__ void sa_task(const bf16* proj, const float* ck, const float* cv, bf16* obs, float* lses, const LAS float* tabS, LAS unsigned char* stg, int id, int lane_in) {
    int lane = lane_in; asm volatile("" : "+v"(lane));
    const bf16x8 E0 = make_E(0, lane), E1 = make_E(1, lane);
    const int h = id & 7, seg = (id >> 3) & 3, b = id >> 5;
    const int q = lane & 31, hi = lane >> 5, t = q & 7;
    const int rowq = MP + b * DECT + t;
    const GAS bf16* pq = (const GAS bf16*)proj + (size_t)rowq * NIN + h * 64 + hi * 8;
    bf16x8 qf[4];
#pragma unroll
    for (int ks = 0; ks < 4; ++ks) qf[ks] = *(const GAS bf16x8*)(pq + 16 * ks);
    const int T0 = seg == 0 ? 0 : 1 + 10 * seg, T1 = 11 + 10 * seg, T1c = T1 < 40 ? T1 : 40;
    float m = NEGV, l = 0.f; f32x16 o0 = zero16(), o1 = zero16();
    const LAS float* ts = tabS + h * TS_STRIDE + 8;
    SaHalf kx, vx;
    sa_load(kx, ck, b, h, T0, lane); sa_load(vx, cv, b, h, T0, lane);
#pragma unroll 1
    for (int tile = T0; tile < T1c; ++tile) {
        const int pbase = tile < 24 ? 64 * tile : 1536 + 32 * (tile - 24), strd = tile < 24 ? 16 : 8;
        bf16x8 kf[4], vf[4];
        sa_stage(kx, stg, lane, kf); sa_stage(vx, stg, lane, vf);
        __builtin_amdgcn_sched_barrier(0);
        { const int tn = tile + 1 < T1c ? tile + 1 : tile; sa_load(kx, ck, b, h, tn, lane); sa_load(vx, cv, b, h, tn, lane); }
        __builtin_amdgcn_sched_barrier(0);
        sa_step(kf, vf, qf, ts, NCACHE + t - pbase - 4 * hi, strd, m, l, o0, o1, E0, E1);
    }
    if (T1 > 40) {
        const int rk = MP + b * DECT + (q & 7);
        const GAS bf16* pk = (const GAS bf16*)proj + (size_t)rk * NIN + 512 + h * 64 + hi * 8;
        bf16x8 kf[4], vf[4];
#pragma unroll
        for (int ks = 0; ks < 4; ++ks) { kf[ks] = *(const GAS bf16x8*)(pk + 16 * ks); vf[ks] = *(const GAS bf16x8*)(pk + 512 + 16 * ks); }
        sa_step(kf, vf, qf, ts, NCACHE + t - 2048 - 4 * hi, 8, m, l, o0, o1, E0, E1);
    }
    if (q < 8) {
        const float ll = fmaxf(l, 1e-30f), inv = 1.0f / ll;
        GAS bf16* po = (GAS bf16*)obs + ((size_t)seg * MS + b * DECT + t) * ATT + h * 64 + 4 * hi;
#pragma unroll
        for (int rg = 0; rg < 4; ++rg) {
            v2u w0, w1;
            w0.x = cvtpk(o0[4 * rg] * inv, o0[4 * rg + 1] * inv); w0.y = cvtpk(o0[4 * rg + 2] * inv, o0[4 * rg + 3] * inv);
            w1.x = cvtpk(o1[4 * rg] * inv, o1[4 * rg + 1] * inv); w1.y = cvtpk(o1[4 * rg + 2] * inv, o1[4 * rg + 3] * inv);
            *(GAS v2u*)(po + 8 * rg) = w0; *(GAS v2u*)(po + 32 + 8 * rg) = w1;
        }
        if (hi == 0) ((GAS float*)lses)[((size_t)seg * MS + b * DECT + t) * 8 + h] = m + log2f(ll);
    }
}

struct RgIo { const bf16* proj; const unsigned char* wsb; const float* sh; const float* gab; const float* gxb; const float* lam; const bf16* gw; bf16* mixed; bf16* y2; float* suma; float* sumh; float* out; };
struct RgX { v4u x[4][4]; bf16x8 g[4]; };
template <bool SAMPLE, int PART>
__device__ __forceinline__ void rg_xload(RgX& X, const unsigned char* wsb, int rowbase, int tt0, int bs0, int g, int lane) {
    const int tok = lane & 31, hi = lane >> 5;
    const int tq = SAMPLE ? (tok & 7) : (tt0 + tok);
    const GAS unsigned char* pb = (const GAS unsigned char*)wsb;
    const unsigned o0 = (unsigned)WS_PROJ + ((unsigned)(rowbase + tok) * (unsigned)NIN + (unsigned)(1536 + g * 64 + hi * 8)) * 2u;
    const unsigned os = (unsigned)WS_XRS + ((unsigned)((SAMPLE ? bs0 + (tok >> 3) : DECB) * 3) * (unsigned)LRU + (unsigned)(g * 64 + hi * 8)) * 2u;
#pragma unroll
    for (int j = (PART == 0 ? 0 : 3); j < (PART == 0 ? 3 : 4); ++j) { const int tj = tq - 3 + j; const unsigned oj = tj >= 0 ? o0 - (unsigned)((3 - j) * NIN * 2) : os + (unsigned)((3 + tj) * LRU * 2);
#pragma unroll
        for (int ks = 0; ks < 4; ++ks) X.x[ks][j] = *(const GAS v4u*)(pb + (oj + 32u * ks)); }
    if (PART == 1) {
#pragma unroll
        for (int ks = 0; ks < 4; ++ks) X.g[ks] = *(const GAS bf16x8*)(pb + (o0 + 1024u + 32u * ks));
    }
}
__device__ __forceinline__ void rg_conv(const RgX& X, int g, int lane, const LAS float* cw, const LAS float* cb, bf16x8 (&af)[4]) {
    const int hi = lane >> 5;
#pragma unroll
    for (int ks = 0; ks < 4; ++ks) {
        const int cg = g * 64 + 16 * ks + 8 * hi;
        f32x4 a0 = *(const LAS f32x4*)(cb + cg), a1 = *(const LAS f32x4*)(cb + cg + 4);
#pragma unroll
        for (int j = 0; j < 4; ++j) {
            const v4u xw = X.x[ks][j];
            const f32x4 x0 = (f32x4){bflo(xw.x), bfhi(xw.x), bflo(xw.y), bfhi(xw.y)}, x1 = (f32x4){bflo(xw.z), bfhi(xw.z), bflo(xw.w), bfhi(xw.w)};
            const f32x4 w0 = *(const LAS f32x4*)(cw + j * 512 + cg), w1 = *(const LAS f32x4*)(cw + j * 512 + cg + 4);
            a0 += w0 * x0; a1 += w1 * x1;
        }
        af[ks] = pack8f(a0, a1);
        __builtin_amdgcn_sched_barrier(0);
    }
}
struct RgConst { float ba, bx, clam; };
__device__ __forceinline__ RgConst rg_load_consts(const RgIo& io, int g, int nb, int lane) {
    RgConst rc; const int ch = g * 64 + 32 * nb + (lane & 31); rc.ba = ((const GAS float*)io.gab)[ch]; rc.bx = ((const GAS float*)io.gxb)[ch];
    rc.clam = -8.0f * log1pf(expf(-((const GAS float*)io.lam)[ch])) * LOG2E;
    return rc;
}
template <bool SAMPLE, int NB>
__device__ __forceinline__ void rgc_block(const RgIo& io, const LAS unsigned char* gwl, const bf16x8 (&af)[4], const bf16x8 gf0, const bf16x8 gf1, int g, int bs0, int lane,
                                          const bf16x8 E0, const bf16x8 E1, const bf16x8 F0, const bf16x8 F1, const RgConst rc, float& ch_, float& cp_, f32x16& Z1, f32x16& Z2) {
    const int hi = lane >> 5, cl = lane & 31, ch = g * 64 + 32 * NB + cl;
    const f32x16 zero = zero16();
    f32x16 R = zero, I = zero;
    { const int orow = 32 * NB + cl, sw = (orow >> 1) & 7; const LAS unsigned char* pa = gwl + orow * 128; const LAS unsigned char* px = pa + 8192;
#pragma unroll
      for (int ks = 0; ks < 4; ++ks) { const int pos = 16 * ((2 * ks + hi) ^ sw); R = MFMA32(af[ks], *(const LAS bf16x8*)(pa + pos), R); I = MFMA32(af[ks], *(const LAS bf16x8*)(px + pos), I); } }
    f32x16 XC = MFMA32(af[2 * NB], E0, zero); XC = MFMA32(af[2 * NB + 1], E1, XC);
    __builtin_amdgcn_sched_barrier(0);
    f32x16 A, U;
#pragma unroll
    for (int r = 0; r < 16; ++r) {
        const float rr = __builtin_amdgcn_rcpf(1.0f + ex2(-(R[r] + rc.ba) * LOG2E));
        const float ii = __builtin_amdgcn_rcpf(1.0f + ex2(-(I[r] + rc.bx) * LOG2E));
        const float a = ex2(rr * rc.clam);
        A[r] = a; U[r] = __builtin_amdgcn_sqrtf(__builtin_fmaf(-a, a, 1.0f)) * (ii * XC[r]);
    }
    __builtin_amdgcn_sched_barrier(0);
    f32x16 Gt = MFMA32(gf0, E0, zero); Gt = MFMA32(gf1, E1, Gt);
    f32x16 O1, O2;
#pragma unroll
    for (int grp = 0; grp < 4; ++grp) {
        if (SAMPLE) { ch_ = ((const GAS float*)io.sh)[(size_t)(bs0 + grp) * LRU + ch]; cp_ = 0.f; }
        float h0 = ch_, p0 = cp_, hv0[4], hv1[4], pv0[4], pv1[4];
#pragma unroll
        for (int kk = 0; kk < 4; ++kk) { h0 = A[4 * grp + kk] * h0 + U[4 * grp + kk]; p0 *= A[4 * grp + kk]; hv0[kk] = h0; pv0[kk] = p0; }
        float h1 = lo_half(h0), p1 = lo_half(p0);
#pragma unroll
        for (int kk = 0; kk < 4; ++kk) { h1 = A[4 * grp + kk] * h1 + U[4 * grp + kk]; p1 *= A[4 * grp + kk]; hv1[kk] = h1; pv1[kk] = p1; }
        ch_ = hi_half(h1); cp_ = hi_half(p1);
        if (SAMPLE) { if (hi == 0) ((GAS float*)io.out)[OFF_NHS + (size_t)(bs0 + grp) * LRU + ch] = ch_; }
#pragma unroll
        for (int kk = 0; kk < 4; ++kk) { const float x = Gt[4 * grp + kk];
            const float gl = x * __builtin_amdgcn_rcpf(1.0f + ex2(-2.3022081984f * (x + 0.044715f * x * x * x)));
            O1[4 * grp + kk] = (hi ? hv1[kk] : hv0[kk]) * gl; O2[4 * grp + kk] = (hi ? pv1[kk] : pv0[kk]) * gl; }
    }
    __builtin_amdgcn_sched_barrier(0);
    Z1 = MFMA32(pack_step<0>(O1), F0, zero); Z1 = MFMA32(pack_step<1>(O1), F1, Z1);
    Z2 = MFMA32(pack_step<0>(O2), F0, zero); Z2 = MFMA32(pack_step<1>(O2), F1, Z2);
}
template <int NB>
__device__ __forceinline__ void rgc_store(const RgIo& io, LAS unsigned char* stg, const f32x16& Z1, const f32x16& Z2, int g, int rowbase, int lane) {
    const int hi = lane >> 5, cl = lane & 31, sw = (cl >> 1) & 7;
    LAS unsigned char* wq = stg + cl * 128 + 8 * hi;
#pragma unroll
    for (int rg = 0; rg < 4; ++rg) { v2u w; w.x = cvtpk(Z1[4 * rg], Z1[4 * rg + 1]); w.y = cvtpk(Z1[4 * rg + 2], Z1[4 * rg + 3]); *(LAS v2u*)(wq + 16 * (rg ^ sw)) = w;
        v2u y; y.x = cvtpk(Z2[4 * rg], Z2[4 * rg + 1]); y.y = cvtpk(Z2[4 * rg + 2], Z2[4 * rg + 3]); *(LAS v2u*)(wq + 16 * ((4 + rg) ^ sw)) = y; }
    GAS bf16* p1 = (GAS bf16*)io.mixed + (ATT + g * 64 + 32 * NB); GAS bf16* p2 = (GAS bf16*)io.y2 + (g * 64 + 32 * NB);
#pragma unroll
    for (int i = 0; i < 4; ++i) { const int row = 8 * i + (lane >> 3); const int ch = (lane & 7) ^ ((row >> 1) & 7);
        const v4u v = *(const LAS v4u*)(stg + i * 1024 + 16 * lane);
        GAS bf16* dst = (ch < 4) ? p1 + ((unsigned)(rowbase + row) * (unsigned)DM + 8u * ch) : p2 + ((unsigned)(rowbase + row) * (unsigned)LRU + 8u * (ch - 4));
        *(GAS v4u*)dst = v; }
}
template <bool SAMPLE>
__device__ __forceinline__ void rgc_task(const RgIo& io, const LAS float* cw, const LAS float* cb, const LAS unsigned char* gwl, LAS unsigned char* stg, int g, int bc, int lane_in) {
    int lane = lane_in; asm volatile("" : "+v"(lane));
    const bf16x8 E0 = make_E(0, lane), E1 = make_E(1, lane), F0 = make_F(0, lane), F1 = make_F(1, lane);
    const int c = SAMPLE ? 0 : (bc & 15), bu = SAMPLE ? 0 : (bc >> 4);
    const int hi = lane >> 5, cl = lane & 31;
    const RgConst rc0 = rg_load_consts(io, g, 0, lane), rc1 = rg_load_consts(io, g, 1, lane);
    const int row0 = SAMPLE ? MP + bc * 32 : bu * SEQ + 128 * c;
    constexpr int NTL = SAMPLE ? 1 : 4;
    float ch0 = 0.f, ch1 = 0.f, cp0 = 1.f, cp1 = 1.f;
    RgX X;
    rg_xload<SAMPLE, 1>(X, io.wsb, row0, 128 * c, SAMPLE ? bc * 4 : 0, g, lane);
#pragma unroll 1
    for (int k = 0; k < NTL; ++k) {
        const int rowbase = row0 + 32 * k, bs0 = SAMPLE ? bc * 4 : 0;
        rg_xload<SAMPLE, 0>(X, io.wsb, rowbase, 128 * c + 32 * k, bs0, g, lane);
        bf16x8 af[4];
        rg_conv(X, g, lane, cw, cb, af);
        const bf16x8 g0 = X.g[0], g1 = X.g[1], g2 = X.g[2], g3 = X.g[3];
        __builtin_amdgcn_sched_barrier(0);
        f32x16 Z1, Z2;
        rgc_block<SAMPLE, 0>(io, gwl, af, g0, g1, g, bs0, lane, E0, E1, F0, F1, rc0, ch0, cp0, Z1, Z2);
        rgc_store<0>(io, stg, Z1, Z2, g, rowbase, lane);
        __builtin_amdgcn_sched_barrier(0);
        rgc_block<SAMPLE, 1>(io, gwl, af, g2, g3, g, bs0, lane, E0, E1, F0, F1, rc1, ch1, cp1, Z1, Z2);
        __builtin_amdgcn_sched_barrier(0);
        if (!SAMPLE) { if (k + 1 < NTL) rg_xload<SAMPLE, 1>(X, io.wsb, rowbase + 32, 128 * c + 32 * k + 32, 0, g, lane); }
        __builtin_amdgcn_sched_barrier(0);
        rgc_store<1>(io, stg, Z1, Z2, g, rowbase, lane);
    }
    if (!SAMPLE) {
        if (hi == 0) { const size_t o = ((size_t)bu * 16 + c) * LRU + g * 64 + cl;
            ((GAS float*)io.suma)[o] = cp0; ((GAS float*)io.sumh)[o] = ch0; ((GAS float*)io.suma)[o + 32] = cp1; ((GAS float*)io.sumh)[o + 32] = ch1; }
        if (c == 15) {
#pragma unroll
            for (int j = 0; j < 3; ++j) { const unsigned short xv = ((const GAS bf16*)io.proj)[(size_t)(bu * SEQ + SEQ - 3 + j) * NIN + 1536 + g * 64 + lane];
                ((GAS float*)io.out)[OFF_NCP + ((size_t)bu * 3 + j) * LRU + g * 64 + lane] = __uint_as_float((unsigned)xv << 16); }
        }
    } else {
#pragma unroll
        for (int sq = 0; sq < 4; ++sq) {
            const int bb = bc * 4 + sq;
#pragma unroll
            for (int j = 0; j < 3; ++j) { const unsigned short xv = ((const GAS bf16*)io.proj)[(size_t)(MP + bb * DECT + 5 + j) * NIN + 1536 + g * 64 + lane];
                ((GAS float*)io.out)[OFF_NCS + ((size_t)bb * 3 + j) * LRU + g * 64 + lane] = __uint_as_float((unsigned)xv << 16); }
        }
    }
}

struct RgRaw { v4u x[4]; v4u h; };
__device__ __forceinline__ void rgp_load(RgRaw& R, const unsigned char* wsb, int rowbase, int tt0, int g, int lane) {
    const GAS unsigned char* pb = (const GAS unsigned char*)wsb;
#pragma unroll
    for (int i = 0; i < 4; ++i) { const int r = 8 * i + (lane >> 3); const unsigned ch = (unsigned)((lane & 7) ^ ((r >> 1) & 7));
        R.x[i] = *(const GAS v4u*)(pb + ((unsigned)WS_PROJ + ((unsigned)(rowbase + r) * (unsigned)NIN + (unsigned)(1536 + g * 64) + 8u * ch) * 2u)); }
    { const int hr = (lane >> 3) < 3 ? (lane >> 3) : 2;
      const unsigned off = (tt0 - 3 + hr >= 0) ? (unsigned)WS_PROJ + ((unsigned)(rowbase - 3 + hr) * (unsigned)NIN + (unsigned)(1536 + g * 64 + 8 * (lane & 7))) * 2u
                                               : (unsigned)WS_XRS + ((unsigned)((DECB * 3 + hr) * LRU + g * 64 + 8 * (lane & 7))) * 2u;
      R.h = *(const GAS v4u*)(pb + off); }
}
__device__ __forceinline__ void rgp_load_gate(v4u (&G)[4], const unsigned char* wsb, int rowbase, int g, int lane) {
    const GAS unsigned char* pb = (const GAS unsigned char*)wsb;
#pragma unroll
    for (int i = 0; i < 4; ++i) { const int r = 8 * i + (lane >> 3); const unsigned ch = (unsigned)((lane & 7) ^ ((r >> 1) & 7));
        G[i] = *(const GAS v4u*)(pb + ((unsigned)WS_PROJ + ((unsigned)(rowbase + r) * (unsigned)NIN + (unsigned)(2048 + g * 64) + 8u * ch) * 2u)); }
}
__device__ __forceinline__ void rgp_task(const RgIo& io, const LAS float* cw, const LAS float* cb, const LAS unsigned char* gwl, LAS unsigned char* stg, LAS unsigned char* hal, int g, int bc, int lane_in) {
    int lane = lane_in; asm volatile("" : "+v"(lane));
    const bf16x8 E0 = make_E(0, lane), E1 = make_E(1, lane), F0 = make_F(0, lane), F1 = make_F(1, lane);
    const int c = bc & 15, bu = bc >> 4;
    const int hi = lane >> 5, cl = lane & 31;
    const RgConst rc0 = rg_load_consts(io, g, 0, lane), rc1 = rg_load_consts(io, g, 1, lane);
    const int row0 = bu * SEQ + 128 * c;
    float ch0 = 0.f, ch1 = 0.f, cp0 = 1.f, cp1 = 1.f;
    RgRaw R;
    rgp_load(R, io.wsb, row0, 128 * c, g, lane);
#pragma unroll 1
    for (int k = 0; k < 4; ++k) {
        const int rowbase = row0 + 32 * k;
        RgX X;
        v4u GR[4]; rgp_load_gate(GR, io.wsb, rowbase, g, lane);
#pragma unroll
        for (int i = 0; i < 4; ++i) *(LAS v4u*)(stg + i * 1024 + 16 * lane) = R.x[i];
        *(LAS v4u*)(hal + 16 * lane) = R.h;
#pragma unroll
        for (int j = 0; j < 4; ++j) { const int rr = cl - 3 + j; const LAS unsigned char* rp = rr >= 0 ? stg + rr * 128 : hal + (rr + 3) * 128; const int sw = rr >= 0 ? ((rr >> 1) & 7) : 0;
#pragma unroll
            for (int ks = 0; ks < 4; ++ks) X.x[ks][j] = *(const LAS v4u*)(rp + 16 * ((2 * ks + hi) ^ sw)); }
#pragma unroll
        for (int i = 0; i < 4; ++i) *(LAS v4u*)(stg + i * 1024 + 16 * lane) = GR[i];
        { const int sw = (cl >> 1) & 7;
#pragma unroll
          for (int ks = 0; ks < 4; ++ks) X.g[ks] = *(const LAS bf16x8*)(stg + cl * 128 + 16 * ((2 * ks + hi) ^ sw)); }
        bf16x8 af[4];
        rg_conv(X, g, lane, cw, cb, af);
        const bf16x8 g0 = X.g[0], g1 = X.g[1], g2 = X.g[2], g3 = X.g[3];
        __builtin_amdgcn_sched_barrier(0);
        { const int kn = k < 3 ? k + 1 : k; rgp_load(R, io.wsb, row0 + 32 * kn, 128 * c + 32 * kn, g, lane); }
        __builtin_amdgcn_sched_barrier(0);
        f32x16 Z1, Z2;
        rgc_block<false, 0>(io, gwl, af, g0, g1, g, 0, lane, E0, E1, F0, F1, rc0, ch0, cp0, Z1, Z2);
        rgc_store<0>(io, stg, Z1, Z2, g, rowbase, lane);
        __builtin_amdgcn_sched_barrier(0);
        rgc_block<false, 1>(io, gwl, af, g2, g3, g, 0, lane, E0, E1, F0, F1, rc1, ch1, cp1, Z1, Z2);
        __builtin_amdgcn_sched_barrier(0);
        rgc_store<1>(io, stg, Z1, Z2, g, rowbase, lane);
    }
    if (hi == 0) { const size_t o = ((size_t)bu * 16 + c) * LRU + g * 64 + cl;
        ((GAS float*)io.suma)[o] = cp0; ((GAS float*)io.sumh)[o] = ch0; ((GAS float*)io.suma)[o + 32] = cp1; ((GAS float*)io.sumh)[o + 32] = ch1; }
    if (c == 15) {
#pragma unroll
        for (int j = 0; j < 3; ++j) { const unsigned short xv = ((const GAS bf16*)io.proj)[(size_t)(bu * SEQ + SEQ - 3 + j) * NIN + 1536 + g * 64 + lane];
            ((GAS float*)io.out)[OFF_NCP + ((size_t)bu * 3 + j) * LRU + g * 64 + lane] = __uint_as_float((unsigned)xv << 16); }
    }
}

template <int NP> struct CmbIn { float ls[NP]; v4u o[NP]; v4u y1, y2; };
template <int NP>
__device__ __forceinline__ void combine_load(CmbIn<NP>& in, const bf16* ob, const float* lse, size_t pstride_rows, size_t row, const bf16* y2_row, const bf16* mixed_row, int lane) {
    const int h = lane >> 3;
#pragma unroll
    for (int p = 0; p < NP; ++p) { in.ls[p] = ((const GAS float*)lse)[(p * pstride_rows + row) * 8 + h]; in.o[p] = *(const GAS v4u*)((const GAS bf16*)ob + (p * pstride_rows + row) * ATT + 8 * lane); }
    in.y1 = *(const GAS v4u*)((const GAS bf16*)mixed_row + ATT + 8 * lane);
    in.y2 = *(const GAS v4u*)((const GAS bf16*)y2_row + 8 * lane);
}
template <int NP>
__device__ __forceinline__ void combine_finish(const CmbIn<NP>& in, const f32x4 g0, const f32x4 g1, const f32x4 r0, const f32x4 r1, const float (&hin8)[8], bf16* mixed_row, int lane) {
    float mx = NEGV;
#pragma unroll
    for (int p = 0; p < NP; ++p) mx = fmaxf(mx, in.ls[p]);
    float acc[8], wsum = 0.f;
#pragma unroll
    for (int i = 0; i < 8; ++i) acc[i] = 0.f;
#pragma unroll
    for (int p = 0; p < NP; ++p) { const float wgt = ex2(in.ls[p] - mx); wsum += wgt; const v4u o = in.o[p];
        acc[0] += wgt * bflo(o.x); acc[1] += wgt * bfhi(o.x); acc[2] += wgt * bflo(o.y); acc[3] += wgt * bfhi(o.y);
        acc[4] += wgt * bflo(o.z); acc[5] += wgt * bfhi(o.z); acc[6] += wgt * bflo(o.w); acc[7] += wgt * bfhi(o.w); }
    const v4u y1 = in.y1, y2 = in.y2;
    float rn[8];
    rn[0] = bflo(y1.x) + bflo(y2.x) * hin8[0]; rn[1] = bfhi(y1.x) + bfhi(y2.x) * hin8[1]; rn[2] = bflo(y1.y) + bflo(y2.y) * hin8[2]; rn[3] = bfhi(y1.y) + bfhi(y2.y) * hin8[3];
    rn[4] = bflo(y1.z) + bflo(y2.z) * hin8[4]; rn[5] = bfhi(y1.z) + bfhi(y2.z) * hin8[5]; rn[6] = bflo(y1.w) + bflo(y2.w) * hin8[6]; rn[7] = bfhi(y1.w) + bfhi(y2.w) * hin8[7];
    const float iw = 1.0f / wsum; float ss = 0.f, sr = 0.f;
#pragma unroll
    for (int i = 0; i < 8; ++i) { acc[i] *= iw; ss += acc[i] * acc[i]; sr += rn[i] * rn[i]; }
    const float rstd = 1.0f / sqrtf(wave_sum(ss) * (1.0f / ATT) + NORM_EPS);
    const float rstdr = 1.0f / sqrtf(wave_sum(sr) * (1.0f / LRU) + NORM_EPS);
    v4u w; w.x = cvtpk(acc[0] * rstd * g0[0], acc[1] * rstd * g0[1]); w.y = cvtpk(acc[2] * rstd * g0[2], acc[3] * rstd * g0[3]);
    w.z = cvtpk(acc[4] * rstd * g1[0], acc[5] * rstd * g1[1]); w.w = cvtpk(acc[6] * rstd * g1[2], acc[7] * rstd * g1[3]);
    *(GAS v4u*)((GAS bf16*)mixed_row + 8 * lane) = w;
    v4u z; z.x = cvtpk(rn[0] * rstdr * r0[0], rn[1] * rstdr * r0[1]); z.y = cvtpk(rn[2] * rstdr * r0[2], rn[3] * rstdr * r0[3]);
    z.z = cvtpk(rn[4] * rstdr * r1[0], rn[5] * rstdr * r1[1]); z.w = cvtpk(rn[6] * rstdr * r1[2], rn[7] * rstdr * r1[3]);
    *(GAS v4u*)((GAS bf16*)mixed_row + ATT + 8 * lane) = z;
}
template <int NP>
__device__ __forceinline__ void combine_row(const bf16* ob, const float* lse, size_t pstride_rows, size_t row, const float* attg, const float* rnng, const bf16* y2_row, const float (&hin8)[8], bf16* mixed_row, int lane) {
    CmbIn<NP> in; combine_load<NP>(in, ob, lse, pstride_rows, row, y2_row, mixed_row, lane);
    const f32x4 g0 = *(const GAS f32x4*)((const GAS float*)attg + 8 * lane), g1 = *(const GAS f32x4*)((const GAS float*)attg + 8 * lane + 4);
    const f32x4 r0 = *(const GAS f32x4*)((const GAS float*)rnng + 8 * lane), r1 = *(const GAS f32x4*)((const GAS float*)rnng + 8 * lane + 4);
    combine_finish<NP>(in, g0, g1, r0, r1, hin8, mixed_row, lane);
}
__device__ __forceinline__ void combine_run(const bf16* ob, const float* lse, const float* attg, const float* rnng, const bf16* y2, const float* suma, const float* sumh, bf16* mixed, float* out, int run, int lane) {
    const int row0 = run * 16, b = row0 >> 11, c = (row0 >> 7) & 15;
    float hin[8];
#pragma unroll
    for (int i = 0; i < 8; ++i) hin[i] = 0.f;
    const GAS float* pa = (const GAS float*)suma + (size_t)b * 16 * LRU + 8 * lane; const GAS float* ph = (const GAS float*)sumh + (size_t)b * 16 * LRU + 8 * lane;
#pragma unroll 1
    for (int c0 = 0; c0 < c; c0 += 8) {
        f32x4 a0[8], a1[8], h0[8], h1[8];
#pragma unroll
        for (int u = 0; u < 8; ++u) { const int cc = c0 + u < 16 ? c0 + u : 15;
            a0[u] = *(const GAS f32x4*)(pa + cc * LRU); a1[u] = *(const GAS f32x4*)(pa + cc * LRU + 4); h0[u] = *(const GAS f32x4*)(ph + cc * LRU); h1[u] = *(const GAS f32x4*)(ph + cc * LRU + 4); }
#pragma unroll
        for (int u = 0; u < 8; ++u) { if (c0 + u < c) {
#pragma unroll
            for (int i = 0; i < 4; ++i) { hin[i] = a0[u][i] * hin[i] + h0[u][i]; hin[4 + i] = a1[u][i] * hin[4 + i] + h1[u][i]; } } }
    }
    for (int r = 0; r < 16; ++r) { const size_t row = (size_t)row0 + r;
        combine_row<3>(ob, lse, (size_t)MT, row, attg, rnng, y2 + row * LRU, hin, mixed + row * DM, lane); }
    if ((row0 & (SEQ - 1)) == SEQ - 16) {
        const f32x4 a0 = *(const GAS f32x4*)(pa + 15 * LRU), a1 = *(const GAS f32x4*)(pa + 15 * LRU + 4), h0 = *(const GAS f32x4*)(ph + 15 * LRU), h1 = *(const GAS f32x4*)(ph + 15 * LRU + 4);
        f32x4 o0, o1;
#pragma unroll
        for (int i = 0; i < 4; ++i) { o0[i] = a0[i] * hin[i] + h0[i]; o1[i] = a1[i] * hin[4 + i] + h1[i]; }
        GAS float* po = (GAS float*)out + OFF_NHP + (size_t)b * LRU + 8 * lane; *(GAS f32x4*)po = o0; *(GAS f32x4*)(po + 4) = o1;
    }
}

template <int NR>
__device__ __forceinline__ void final_norm_rows(const bf16* xb, float* y, const float* g, int m0, int stride, int lane) {
    v4u v[NR][2];
#pragma unroll
    for (int r = 0; r < NR; ++r) { const int m = m0 + r * stride; const int mc = m < MP ? m : MP - 1; const GAS v4u* xr = (const GAS v4u*)(xb + (size_t)mc * DM) + lane;
        v[r][0] = xr[0]; v[r][1] = xr[64]; }
    const GAS f32x4* gr = (const GAS f32x4*)g + 2 * lane;
    const f32x4 g0 = gr[0], g1 = gr[1], g2 = gr[128], g3 = gr[129];
#pragma unroll
    for (int r = 0; r < NR; ++r) { const int m = m0 + r * stride;
        f32x4 a0 = {bflo(v[r][0].x), bfhi(v[r][0].x), bflo(v[r][0].y), bfhi(v[r][0].y)}, a1 = {bflo(v[r][0].z), bfhi(v[r][0].z), bflo(v[r][0].w), bfhi(v[r][0].w)};
        f32x4 a2 = {bflo(v[r][1].x), bfhi(v[r][1].x), bflo(v[r][1].y), bfhi(v[r][1].y)}, a3 = {bflo(v[r][1].z), bfhi(v[r][1].z), bflo(v[r][1].w), bfhi(v[r][1].w)};
        const f32x4 q = a0 * a0 + a1 * a1 + a2 * a2 + a3 * a3;
        const float rstd = 1.0f / sqrtf(wave_sum((q[0] + q[1]) + (q[2] + q[3])) * (1.f / DM) + NORM_EPS);
        if (m < MP) { GAS f32x4* yr = (GAS f32x4*)(y + (size_t)m * DM) + 2 * lane;
            __builtin_nontemporal_store(a0 * rstd * g0, yr); __builtin_nontemporal_store(a1 * rstd * g1, yr + 1); __builtin_nontemporal_store(a2 * rstd * g2, yr + 128); __builtin_nontemporal_store(a3 * rstd * g3, yr + 129); } }
}
__device__ __forceinline__ void final_norm_sample_row(const bf16* xb, float* y, const float* slab, const float* g, int rs, int lane) {
    GAS f32x4* yr = (GAS f32x4*)(y + (size_t)(MP + rs) * DM) + lane; const GAS f32x4* gr = (const GAS f32x4*)g + lane;
    const GAS v2u* xr = (const GAS v2u*)(xb + (size_t)(MP + rs) * DM) + lane;
    f32x4 v[4];
#pragma unroll
    for (int j = 0; j < 4; ++j) { const v2u w = xr[64 * j]; v[j] = (f32x4){bflo(w.x), bfhi(w.x), bflo(w.y), bfhi(w.y)}; }
#pragma unroll 4
    for (int s = 0; s < 16; ++s) { const GAS f32x4* sp = (const GAS f32x4*)(slab + ((size_t)s * MS + rs) * DM) + lane;
#pragma unroll
        for (int j = 0; j < 4; ++j) v[j] += sp[64 * j]; }
    float sm = 0.f;
#pragma unroll
    for (int j = 0; j < 4; ++j) sm += (v[j].x * v[j].x + v[j].y * v[j].y) + (v[j].z * v[j].z + v[j].w * v[j].w);
    const float rstd = 1.0f / sqrtf(wave_sum(sm) * (1.f / DM) + NORM_EPS);
#pragma unroll
    for (int j = 0; j < 4; ++j) yr[64 * j] = v[j] * rstd * gr[64 * j];
}

#ifndef REP_P0
#define REP_P0 1
#endif
#ifndef REP_BAR
#define REP_BAR 0
#endif
#ifndef REP_PA
#define REP_PA 1
#endif
#ifndef PA_DUMMY
#define PA_DUMMY 0
#endif
#ifndef REP_SA
#define REP_SA 1
#endif
#ifndef REP_RG
#define REP_RG 1
#endif
#ifndef REP_CMB
#define REP_CMB 1
#endif
#ifndef REP_P1
#define REP_P1 1
#endif
#ifndef REP_P4
#define REP_P4 1
#endif
#ifndef REP_P5
#define REP_P5 1
#endif

#ifdef SK_PA
#define DO_PA(x)
#else
#define DO_PA(x) x
#endif
#ifdef SK_RA
#define DO_RA(x)
#else
#define DO_RA(x) x
#endif
#ifdef SK_SA
#define DO_SA(x)
#else
#define DO_SA(x) x
#endif
#ifdef SK_RB
#define DO_RB(x)
#else
#define DO_RB(x) x
#endif
#ifdef SK_RBS
#define DO_RBS(x)
#else
#define DO_RBS(x) x
#endif
#ifdef SK_GEMM
#define DO_GEMM if (0)
#else
#define DO_GEMM
#endif

struct Args { const float* in[23]; float* out; unsigned char* ws; };
constexpr int NWAVES = 8;
__global__ void __launch_bounds__(NWAVES * 64, 2) hymba_fwd(Args args) {
    extern __shared__ __attribute__((aligned(16))) unsigned char lds_raw[];
    LAS unsigned char* lds = (LAS unsigned char*)lds_raw;
    volatile LAS unsigned* MISC = (volatile LAS unsigned*)(lds + MISC_OFF);
    const int tid = threadIdx.x, lane = tid & 63, wave = __builtin_amdgcn_readfirstlane(tid >> 6);
    const int G = gridDim.x; const int bx = blockIdx.x; const int vcu = (G % 8 == 0) ? (bx % 8) * (G / 8) + bx / 8 : bx;
    const int gw = vcu * NWAVES + wave, NGW = G * NWAVES;
    unsigned char* ws = args.ws;
    gu32* ctl = (gu32*)(ws + WS_CTL);
    const float* x_prompt = args.in[0]; const float* x_sample = args.in[1]; const float* cache_k = args.in[2]; const float* cache_v = args.in[3];
    const float* state_conv = args.in[4]; const float* state_h = args.in[5]; const float* norm1_g = args.in[6]; const float* w_in = args.in[7];
    const float* rel_bias = args.in[8]; const float* conv_w = args.in[9]; const float* conv_b = args.in[10]; const float* gate_a_w = args.in[11];
    const float* gate_a_b = args.in[12]; const float* gate_x_w = args.in[13]; const float* gate_x_b = args.in[14]; const float* lru_lambda = args.in[15];
    const float* att_out_g = args.in[16]; const float* rnn_out_g = args.in[17]; const float* w_out = args.in[18]; const float* norm2_g = args.in[19];
    const float* w_mlp_in = args.in[20]; const float* w_mlp_out = args.in[21]; const float* final_g = args.in[22];
    float* out = args.out;
    bf16* Win_t = (bf16*)(ws + WS_WIN); bf16* Wout_t = (bf16*)(ws + WS_WOUT); bf16* W1_t = (bf16*)(ws + WS_W1); bf16* W2_t = (bf16*)(ws + WS_W2); bf16* GW = (bf16*)(ws + WS_GW);
    float* SS1 = (float*)(ws + WS_SS1); float* SUMA = (float*)(ws + WS_SUMA); float* SUMH = (float*)(ws + WS_SUMH); bf16* Y2B = (bf16*)(ws + WS_Y2); float* SLAB = (float*)(ws + WS_SLAB);
    float* LSE = (float*)(ws + WS_LSE); float* LSES = (float*)(ws + WS_LSES); bf16* OBS = (bf16*)(ws + WS_OBS); bf16* OB = (bf16*)(ws + WS_OB);
    bf16* XN = (bf16*)(ws + WS_XN); bf16* PROJ = (bf16*)(ws + WS_PROJ); bf16* MIXED = (bf16*)(ws + WS_MIXED); bf16* X1B = (bf16*)(ws + WS_X1B); bf16* HB = (bf16*)(ws + WS_HB);

    for (int u = tid; u < (LDS_BYTES - LDSCTL_OFF) / 4; u += NWAVES * 64) ((LAS unsigned*)(lds + LDSCTL_OFF))[u] = 0u;
    __syncthreads();
    XcdBarrier bar = xcd_barrier_post((unsigned*)(ctl + CW_BAR), MISC + 8);

    for (int rep_ = 0; rep_ < REP_P0; ++rep_) {
        int lane0 = lane; asm volatile("" : "+v"(lane0));
        LAS float* scr = (LAS float*)(lds + RING_OFF + wave * 16384);
        constexpr int I_IN = (DM / 64) * (NIN / 32), I_O = (DM / 64) * (DM / 32), I_1 = (DM / 64) * (FF / 32), I_2 = (FF / 64) * (DM / 32);
        constexpr int NITEMS = I_IN + I_O + I_1 + I_2;
        for (int it = gw; it < NITEMS; it += NGW) {
            int r = it;
            if (r < I_IN) { p0_transpose_item(w_in, nullptr, DM, NIN, Win_t, scr, r, lane0); continue; } r -= I_IN;
            if (r < I_O) { p0_transpose_item(w_out, nullptr, DM, DM, Wout_t, scr, r, lane0); continue; } r -= I_O;
            if (r < I_1) { p0_transpose_item(w_mlp_in, norm2_g, DM, FF, W1_t, scr, r, lane0); continue; } r -= I_1;
            p0_transpose_item(w_mlp_out, nullptr, FF, DM, W2_t, scr, r, lane0);
        }
        for (int idx = gw * 64 + lane0; idx < 2 * 8 * 64 * 64; idx += NGW * 64) {
            const int mat = idx >> 15, g = (idx >> 12) & 7, o = (idx >> 6) & 63, i = idx & 63;
            const float v = (mat ? gate_x_w : gate_a_w)[g * 4096 + i * 64 + o];
            GW[idx] = (bf16)(cvtpk(v, v) & 0xffffu);
        }
        for (int idx = gw * 64 + lane0; idx < (DECB + 1) * 3 * LRU; idx += NGW * 64) { const float v = idx < DECB * 3 * LRU ? state_conv[idx] : 0.f; ((bf16*)(ws + WS_XRS))[idx] = (bf16)(cvtpk(v, v) & 0xffffu); }
        for (int m0 = gw; m0 < MT; m0 += 4 * NGW) rms_rows_to_bf16<4>(x_prompt, x_sample, norm1_g, XN, m0, NGW, lane0);
    }
    xcd_barrier(bar);

    {
        pg8::Gemm g{XN, Win_t, MT, NIN, DM}; pg8::StaticOrder S; S.init(MT, NIN, G, bx);
        pg8::EpiInProj E{PROJ, out, QSCALE};
        for (int rep_ = 0; rep_ < REP_P1; ++rep_) { DO_GEMM pg8::gemm_phase<pg8::EpiInProj, pg8::StaticOrder, true, true>(lds + RING_OFF, g, S, E); }
    }
    xcd_barrier(bar);

    {
        const int rgg = vcu & 7;
        build_tables(lds, rel_bias, conv_w, conv_b, GW, rgg, tid);
        __syncthreads();
        const LAS float* btab = (const LAS float*)(lds + BT_OFF); const LAS float* tabS = (const LAS float*)(lds + TS_OFF);
        const LAS float* cw = (const LAS float*)(lds + CW_OFF); const LAS float* cb = (const LAS float*)(lds + CB_OFF);
        const RgIo io{PROJ, ws, state_h, gate_a_b, gate_x_b, lru_lambda, GW, MIXED, Y2B, SUMA, SUMH, out};
        const int sagrp = gw % 3;
#define SA_PASS() do { for (int rep_ = 0; rep_ < REP_SA; ++rep_) for (int id = gw; id < 4096; id += NGW) sa_task(PROJ, cache_k, cache_v, OBS, LSES, tabS, lds + STG_OFF + wave * 4096, id, lane); } while (0)
#define PA_PASS(lo, hi) do { for (int rep_ = 0; rep_ < REP_PA; ++rep_) for (int id = gw + (lo) * NGW; id < 24576 && id < (hi); id += NGW) \
        pa_task(PROJ, rep_ ? (bf16*)HB : OB, rep_ ? (float*)(HB + (size_t)MT * 2048) : LSE, btab, lds + STG_OFF + wave * 4096, id, lane, rep_ ? PA_DUMMY : 0); } while (0)
        if (sagrp == 0) SA_PASS();
        PA_PASS(0, gw + 6 * NGW);
        if (sagrp == 1) SA_PASS();
        PA_PASS(6, 24576);
        { const LAS unsigned char* gwl = lds + GWL_OFF;
          for (int rep_ = 0; rep_ < REP_RG; ++rep_) { for (int bc = (vcu >> 3) * NWAVES + wave; bc < 256; bc += (G >> 3) * NWAVES) rgp_task(io, cw, cb, gwl, lds + STG_OFF + wave * 4096, lds + HAL_OFF + wave * 1024, rgg, bc, lane);
              if (wave == NWAVES - 1) for (int bc = vcu >> 3; bc < 32; bc += (G >> 3)) rgc_task<true>(io, cw, cb, gwl, lds + STG_OFF + wave * 4096, rgg, bc, lane); } }
        if (sagrp == 2) SA_PASS();
#undef SA_PASS
#undef PA_PASS
    }
    xcd_barrier(bar);

    for (int rep_ = 0; rep_ < REP_BAR; ++rep_) xcd_barrier(bar);
    for (int rep_ = 0; rep_ < REP_CMB; ++rep_) {
        int lane3 = lane; asm volatile("" : "+v"(lane3));
        for (int run = gw; run < MP / 16; run += NGW) combine_run(OB, LSE, att_out_g, rnn_out_g, Y2B, SUMA, SUMH, MIXED, out, run, lane3);
        const float hz[8] = {0.f, 0.f, 0.f, 0.f, 0.f, 0.f, 0.f, 0.f};
        for (int rs = gw; rs < MS; rs += NGW) combine_row<4>(OBS, LSES, (size_t)MS, (size_t)rs, att_out_g, rnn_out_g, Y2B + (size_t)(MP + rs) * LRU, hz, MIXED + (size_t)(MP + rs) * DM, lane3);
    }
    xcd_barrier(bar);

    {
        pg8::Gemm g{MIXED, Wout_t, MT, DM, DM}; pg8::StaticOrder S; S.init(MT, DM, G, bx);
        pg8::EpiWout E{x_prompt, x_sample, X1B, SS1};
        for (int rep_ = 0; rep_ < REP_P4; ++rep_) { DO_GEMM pg8::gemm_phase<pg8::EpiWout, pg8::StaticOrder, true, true>(lds + RING_OFF, g, S, E); }
    }
    xcd_barrier(bar);

    {
        pg8::Gemm g{X1B, W1_t, MT, FF, DM}; pg8::StaticOrder S; S.init(MT, FF, G, bx);
        pg8::EpiUp E{HB, SS1};
        for (int rep_ = 0; rep_ < REP_P5; ++rep_) { DO_GEMM pg8::gemm_phase<pg8::EpiUp, pg8::StaticOrder, true, true>(lds + RING_OFF, g, S, E); }
    }
    xcd_barrier(bar);

    {
        { pg8::Gemm g{HB, W2_t, MP, DM, FF}; pg8::StaticOrder S; S.init(MP, DM, G, bx);
          pg8::EpiDown E{X1B};
          DO_GEMM pg8::gemm_phase<pg8::EpiDown, pg8::StaticOrder, true, true>(lds + RING_OFF, g, S, E); }
        __syncthreads();
        { pg8::Gemm g2{(const bf16*)(args.ws + WS_HB), (const bf16*)(args.ws + WS_W2), MT, DM, 256, FF}; const pg8::SplitKOrder S2{(int)gridDim.x, (int)blockIdx.x, 16};
          pg8::EpiSlab E2{(float*)(args.ws + WS_SLAB)};
          DO_GEMM pg8::gemm_phase<pg8::EpiSlab, pg8::SplitKOrder, true, true>(lds + RING_OFF, g2, S2, E2); }
    }
    xcd_barrier(bar);

    int lane7 = lane; asm volatile("" : "+v"(lane7));
    for (int m0 = gw; m0 < MP; m0 += 4 * NGW) final_norm_rows<4>(X1B, out + OFF_Y, final_g, m0, NGW, lane7);
    for (int rs = NGW - 1 - gw; rs < MS; rs += NGW) final_norm_sample_row(X1B, out + OFF_Y, SLAB, final_g, rs, lane7);
}

extern "C" void kernel_launch(void* const* d_in, const int* in_sizes, int n_in, void* d_out, int out_size, void* d_ws, size_t ws_size, hipStream_t stream) {
    static int grid = 0;
    if (grid == 0) {
        if (n_in != 23 || in_sizes[0] != MP * DM || (size_t)out_size != OUT_TOTAL || ws_size < WS_END) {
            fprintf(stderr, "kernel_launch: shape mismatch: n_in %d in0 %d out %d ws %zu (need %zu); nothing launched\n", n_in, n_in > 0 ? in_sizes[0] : -1, out_size, ws_size, (size_t)WS_END); grid = -1; return; }
        int dev = 0, cus = 0, per_cu = 0;
        if (hipGetDevice(&dev) != hipSuccess || hipDeviceGetAttribute(&cus, hipDeviceAttributeMultiprocessorCount, dev) != hipSuccess) { fprintf(stderr, "kernel_launch: device query failed\n"); grid = -1; return; }
        if (hipFuncSetAttribute((const void*)hymba_fwd, hipFuncAttributeMaxDynamicSharedMemorySize, LDS_BYTES) != hipSuccess) { fprintf(stderr, "kernel_launch: hipFuncSetAttribute failed\n"); grid = -1; return; }
        if (hipOccupancyMaxActiveBlocksPerMultiprocessor(&per_cu, (const void*)hymba_fwd, NWAVES * 64, LDS_BYTES) != hipSuccess || per_cu < 1)
            fprintf(stderr, "kernel_launch: note: occupancy query reports %d workgroups per CU\n", per_cu);
        (void)hipGetLastError();
        grid = cus;
    }
    if (grid < 0) return;
    if (hipMemsetAsync((char*)d_ws + WS_CTL, 0, CTL_ZERO_BYTES, stream) != hipSuccess) { fprintf(stderr, "kernel_launch: memset failed\n"); return; }
    Args a{};
    for (int i = 0; i < 23; ++i) a.in[i] = (const float*)d_in[i];
    a.out = (float*)d_out; a.ws = (unsigned char*)d_ws;
    hipLaunchKernelGGL(hymba_fwd, dim3(grid), dim3(NWAVES * 64), LDS_BYTES, stream, a);
    const hipError_t le = hipPeekAtLastError();
    if (le != hipSuccess) fprintf(stderr, "kernel_launch: launch failed: %s\n", hipGetErrorName(le));
}
```

```cpp
#include <hip/hip_runtime.h>
#include <cstdio>
#include <cstdint>

constexpr int DM = 1024, NB = 16, SEQ = 2048, DECB = 128, DECT = 8, NH = 8, HD = 64, ATT = 512, LRU = 512, FF = 4096, NIN = 2560;
constexpr int MP = NB * SEQ;
constexpr int MS = DECB * DECT;
constexpr int MT = MP + MS;
constexpr int NCACHE = 2048;
constexpr float NORM_EPS = 1e-6f;
constexpr float NEGV = -1e30f;
constexpr float LOG2E = 1.4426950408889634f;
constexpr float QSCALE = 0.125f * LOG2E;
constexpr size_t OFF_Y = 0;
constexpr size_t OFF_NKP = (size_t)MT * DM;
constexpr size_t OFF_NVP = OFF_NKP + (size_t)MP * ATT;
constexpr size_t OFF_NCP = OFF_NVP + (size_t)MP * ATT;
constexpr size_t OFF_NHP = OFF_NCP + (size_t)NB * 3 * LRU;
constexpr size_t OFF_NKS = OFF_NHP + (size_t)NB * LRU;
constexpr size_t OFF_NVS = OFF_NKS + (size_t)MS * ATT;
constexpr size_t OFF_NCS = OFF_NVS + (size_t)MS * ATT;
constexpr size_t OFF_NHS = OFF_NCS + (size_t)DECB * 3 * LRU;
constexpr size_t OUT_TOTAL = OFF_NHS + (size_t)DECB * LRU;
static_assert(OUT_TOTAL == 69500928, "output size");

namespace pg8 {
#define PG8_LAS __attribute__((address_space(3)))
typedef unsigned short bf16_t;
typedef short bf16x8 __attribute__((ext_vector_type(8)));
typedef float f32x4 __attribute__((ext_vector_type(4)));
typedef unsigned u32x4 __attribute__((ext_vector_type(4)));
constexpr int BM = 256, BK = 64, HALF = 128, HTB = HALF * BK * 2  , STAGE_BYTES = 8 * HTB, NXCD = 8, WGM = 8;

__host__ __device__ __forceinline__ int lds_byte(int r, int c) { const int st = (r >> 4) * 2 + (c >> 5), rr = r & 15, cc = c & 31, ob = rr * 64 + cc * 2; return st * 1024 + (ob ^ (((ob >> 9) & 1) << 5)); }
__host__ __device__ __forceinline__ void stage_rc(int b, int& R, int& C) { const int st = b / 1024, sb = b % 1024, swz = sb ^ (((sb >> 9) & 1) << 5); R = (st >> 1) * 16 + swz / 64; C = (st & 1) * 32 + (swz % 64) / 2; }
__host__ __device__ __forceinline__ int perm32(int rho) { const int n = rho >> 4, i = rho & 15; return 8 * (i >> 2) + 4 * n + (i & 3); }

struct Unit { int pm, pn; int ko = 0; };
struct Gemm { const bf16_t* A; const bf16_t* Bt; int M, N, K; int ld = 0; };

struct StaticOrder {
    int nM, nN, nwg, G, c;
    __host__ __device__ void init(int M, int N, int G_, int c_) { nM = M / BM; nN = N / BM; nwg = nM * nN; G = G_; c = c_; }
    __host__ __device__ bool next(int i, Unit& u) const {
        const long L = (long)i * G + c; if (L >= nwg) return false;
        int wgid = (int)L; { const int q = nwg / NXCD, r = nwg % NXCD, xcd = wgid % NXCD, off = wgid / NXCD; wgid = (xcd < r ? xcd * (q + 1) : r * (q + 1) + (xcd - r) * q) + off; }
        const int nig = WGM * nN, gid = wgid / nig, fm = gid * WGM, gsz = (nM - fm) < WGM ? (nM - fm) : WGM;
        u.pm = fm + ((wgid % nig) % gsz); u.pn = (wgid % nig) / gsz; return true;
    }
    __device__ __forceinline__ void a_ready(const Unit&) const {}
    __device__ __forceinline__ void done(const Unit&) const {}
};

__device__ __forceinline__ unsigned cvt_pk_bf16(float lo, float hi) { unsigned r; asm volatile("v_cvt_pk_bf16_f32 %0, %1, %2" : "=v"(r) : "v"(lo), "v"(hi)); return r; }
__device__ __forceinline__ u32x4 pack8(const f32x4 v0, const f32x4 v1) { u32x4 w; w.x = cvt_pk_bf16(v0[0], v0[1]); w.y = cvt_pk_bf16(v0[2], v0[3]); w.z = cvt_pk_bf16(v1[0], v1[1]); w.w = cvt_pk_bf16(v1[2], v1[3]); return w; }

struct EpiInProj {
    static constexpr bool PERM = true, AFTER_DRAIN = false;
    bf16_t* proj; float* out; float qscale;
    __device__ __forceinline__ void operator()(const f32x4 (&acc)[2][2][4][2], const Unit& u, int wr, int wc, int fr, int fq) const {
        const int row0 = u.pm * BM + wr * 64 + fr, col0 = u.pn * BM + wc * 32 + 8 * fq;
        const int kind = u.pn >> 1;
        const float sc = (kind == 0) ? qscale : 1.f;
        float* fdst = nullptr;
        if (kind == 1 || kind == 2) {
            const bool smp = u.pm >= (MP / BM);
            const size_t off = smp ? (kind == 1 ? OFF_NKS : OFF_NVS) : (kind == 1 ? OFF_NKP : OFF_NVP);
            const int frow = smp ? row0 - MP : row0;
            fdst = out + off + (size_t)frow * ATT + (col0 - kind * ATT);
        }
#pragma unroll
        for (int ai = 0; ai < 2; ++ai)
#pragma unroll
            for (int m = 0; m < 4; ++m) { bf16_t* rowp = proj + (size_t)(row0 + ai * HALF + m * 16) * NIN + col0;
#pragma unroll
                for (int bj = 0; bj < 2; ++bj) { const f32x4 v0 = acc[ai][bj][m][0] * sc, v1 = acc[ai][bj][m][1] * sc;
                    *(u32x4*)(rowp + bj * HALF) = pack8(v0, v1);
                    if (fdst) { float* fp = fdst + (size_t)(ai * HALF + m * 16) * ATT + bj * HALF; __builtin_nontemporal_store(v0, (f32x4*)fp); __builtin_nontemporal_store(v1, (f32x4*)(fp + 4)); } } }
    }
};
struct EpiWout {
    static constexpr bool PERM = true, AFTER_DRAIN = false;
    const float* xp; const float* xs; bf16_t* x1b; float* ss1;
    __device__ __forceinline__ void operator()(const f32x4 (&acc)[2][2][4][2], const Unit& u, int wr, int wc, int fr, int fq) const {
        const int row0 = u.pm * BM + wr * 64 + fr, col0 = u.pn * BM + wc * 32 + 8 * fq;
        const float* xin = (u.pm >= (MP / BM)) ? xs + (size_t)(row0 - MP) * DM : xp + (size_t)row0 * DM;
#pragma unroll
        for (int ai = 0; ai < 2; ++ai)
#pragma unroll
            for (int m = 0; m < 4; ++m) { const int dr = ai * HALF + m * 16; const float* xr = xin + (size_t)dr * DM + col0; bf16_t* br = x1b + (size_t)(row0 + dr) * DM + col0;
                float ss = 0.f;
#pragma unroll
                for (int bj = 0; bj < 2; ++bj) { const f32x4 a0 = *(const f32x4*)(xr + bj * HALF), a1 = *(const f32x4*)(xr + bj * HALF + 4);
                    const f32x4 v0 = acc[ai][bj][m][0] + a0, v1 = acc[ai][bj][m][1] + a1;
                    *(u32x4*)(br + bj * HALF) = pack8(v0, v1);
                    ss += (v0[0] * v0[0] + v0[1] * v0[1]) + (v0[2] * v0[2] + v0[3] * v0[3]) + (v1[0] * v1[0] + v1[1] * v1[1]) + (v1[2] * v1[2] + v1[3] * v1[3]); }
                ss += __shfl_xor(ss, 16); ss += __shfl_xor(ss, 32);
                if (fq == 0) ss1[(size_t)(row0 + dr) * 16 + u.pn * 4 + wc] = ss; }
    }
};
struct EpiUp {
    static constexpr bool PERM = true, AFTER_DRAIN = false;
    bf16_t* hb; const float* ss1;
    __device__ __forceinline__ void operator()(const f32x4 (&acc)[2][2][4][2], const Unit& u, int wr, int wc, int fr, int fq) const {
        const int row0 = u.pm * BM + wr * 64 + fr, col0 = u.pn * BM + wc * 32 + 8 * fq;
        float rs2[2];
#pragma unroll
        for (int t = 0; t < 2; ++t) { const int r = row0 + (fq >> 1) * HALF + (2 * (fq & 1) + t) * 16; const f32x4* sp = (const f32x4*)(ss1 + (size_t)r * 16);
            const f32x4 s0 = sp[0], s1 = sp[1], s2 = sp[2], s3 = sp[3]; const f32x4 s = (s0 + s1) + (s2 + s3);
            rs2[t] = 1.0f / sqrtf(((s[0] + s[1]) + (s[2] + s[3])) * (1.0f / DM) + NORM_EPS); }
        float rstd[8];
#pragma unroll
        for (int e = 0; e < 8; ++e) rstd[e] = __shfl((e & 1) ? rs2[1] : rs2[0], (e >> 1) * 16 + fr);
#pragma unroll
        for (int ai = 0; ai < 2; ++ai)
#pragma unroll
            for (int m = 0; m < 4; ++m) { bf16_t* rowp = hb + (size_t)(row0 + ai * HALF + m * 16) * FF + col0; const float rs = rstd[ai * 4 + m];
#pragma unroll
                for (int bj = 0; bj < 2; ++bj) { f32x4 v0 = acc[ai][bj][m][0] * rs, v1 = acc[ai][bj][m][1] * rs;
#pragma unroll
                    for (int i = 0; i < 4; ++i) { const float a = fmaxf(v0[i], 0.f), b = fmaxf(v1[i], 0.f); v0[i] = a * a; v1[i] = b * b; }
                    *(u32x4*)(rowp + bj * HALF) = pack8(v0, v1); } }
    }
};
struct EpiDown {
    static constexpr bool PERM = true, AFTER_DRAIN = false;
    bf16_t* xb;
    __device__ __forceinline__ void operator()(const f32x4 (&acc)[2][2][4][2], const Unit& u, int wr, int wc, int fr, int fq) const {
        const int row0 = u.pm * BM + wr * 64 + fr, col0 = u.pn * BM + wc * 32 + 8 * fq;
#pragma unroll
        for (int ai = 0; ai < 2; ++ai)
#pragma unroll
            for (int m = 0; m < 4; ++m) { bf16_t* yr = xb + (size_t)(row0 + ai * HALF + m * 16) * DM + col0;
#pragma unroll
                for (int bj = 0; bj < 2; ++bj) { const u32x4 w = *(const u32x4*)(yr + bj * HALF);
                    const f32x4 a0 = {__uint_as_float(w.x << 16), __uint_as_float(w.x & 0xffff0000u), __uint_as_float(w.y << 16), __uint_as_float(w.y & 0xffff0000u)};
                    const f32x4 a1 = {__uint_as_float(w.z << 16), __uint_as_float(w.z & 0xffff0000u), __uint_as_float(w.w << 16), __uint_as_float(w.w & 0xffff0000u)};
                    *(u32x4*)(yr + bj * HALF) = pack8(acc[ai][bj][m][0] + a0, acc[ai][bj][m][1] + a1); } }
    }
};

struct EpiSlab {
    static constexpr bool PERM = false, AFTER_DRAIN = false;
    float* slab;
    __device__ __forceinline__ void operator()(const f32x4 (&acc)[2][2][4][2], const Unit& u, int wr, int wc, int fr, int fq) const {
        const int row0 = (u.pm - MP / BM) * BM + wr * 64 + fr, col0 = u.pn * BM + wc * 32 + 4 * fq;
        float* base = slab + (size_t)(u.ko >> 8) * MS * DM;
#pragma unroll
        for (int ai = 0; ai < 2; ++ai)
#pragma unroll
            for (int m = 0; m < 4; ++m) { float* yr = base + (size_t)(row0 + ai * HALF + m * 16) * DM + col0;
#pragma unroll
                for (int bj = 0; bj < 2; ++bj) { *(f32x4*)(yr + bj * HALF) = acc[ai][bj][m][0]; *(f32x4*)(yr + bj * HALF + 16) = acc[ai][bj][m][1]; } }
    }
};
struct SplitKOrder {
    int G, c, KS;
    __device__ __forceinline__ bool next(int i, Unit& u) const { const int L = i * G + c; if (L >= 16 * KS) return false; u.pn = L & 3; u.ko = ((L >> 2) % KS) * 256; u.pm = MP / BM + L / (4 * KS); return true; }
    __device__ __forceinline__ void a_ready(const Unit&) const {}
    __device__ __forceinline__ void done(const Unit&) const {}
};

template <class Epi, class Sched, bool ALIGN_EPI = false, bool SP2 = false, int AUXA = 0>
__device__ __forceinline__ void gemm_phase(PG8_LAS unsigned char* lds, const Gemm g, const Sched& S, const Epi& E) {
    int tid_ = threadIdx.x; asm volatile("" : "+v"(tid_));
    const int tid = tid_, wid = __builtin_amdgcn_readfirstlane(tid >> 6), lane = tid & 63, wr = wid >> 2, wc = wid & 3, fr = lane & 15, fq = lane >> 4;
    const int nt = g.K / BK, K = g.ld ? g.ld : g.K;
    unsigned voffA[2], voffB[2];
#pragma unroll
    for (int i = 0; i < 2; ++i) { int R, C; stage_rc(tid * 16 + i * 8192, R, C); const int Rb = Epi::PERM ? ((R & ~31) + perm32(R & 31)) : R;
        voffA[i] = (unsigned)(R * K + C) * 2u; voffB[i] = (unsigned)(Rb * K + C) * 2u; }
    const size_t kstep = (size_t)(BK * 2);
    const size_t hstep = (size_t)HALF * K * 2;
    const size_t tstep = 2 * hstep;
    const unsigned ldsw = (unsigned)wid * 1024u;
    const int aoff = lds_byte(wr * 64 + fr, fq * 8), boff = lds_byte(wc * 32 + fr, fq * 8);
#define PG8_SA(b, h) (((b) * 2 + (h)) * HTB)
#define PG8_SB(b, h) ((4 + (b) * 2 + (h)) * HTB)
#define PG8_STAGE(bufoff, gbase, voff) do { _Pragma("unroll") for (int _i = 0; _i < 2; ++_i) \
        __builtin_amdgcn_global_load_lds((const unsigned*)((const char*)(gbase) + (voff)[_i]), (PG8_LAS unsigned*)(lds + (bufoff) + ldsw + _i * 8192), 16, 0, 0); } while (0)
#define PG8_STAGEA(bufoff, gbase, voff) do { _Pragma("unroll") for (int _i = 0; _i < 2; ++_i) \
        __builtin_amdgcn_global_load_lds((const unsigned*)((const char*)(gbase) + (voff)[_i]), (PG8_LAS unsigned*)(lds + (bufoff) + ldsw + _i * 8192), 16, 0, AUXA); } while (0)
#define PG8_LDA(dst, b, h) do { _Pragma("unroll") for (int m = 0; m < 4; ++m) _Pragma("unroll") for (int k = 0; k < 2; ++k) dst[m][k] = *(const PG8_LAS bf16x8*)(lds + PG8_SA(b, h) + aoff + m * 2048 + k * 1024); } while (0)
#define PG8_LDB(dst, b, h) do { _Pragma("unroll") for (int n = 0; n < 2; ++n) _Pragma("unroll") for (int k = 0; k < 2; ++k) dst[n][k] = *(const PG8_LAS bf16x8*)(lds + PG8_SB(b, h) + boff + n * 2048 + k * 1024); } while (0)
#define PG8_MMA(ai, bj, At, Bt) do { __builtin_amdgcn_s_setprio(1); _Pragma("unroll") for (int m = 0; m < 4; ++m) _Pragma("unroll") for (int n = 0; n < 2; ++n) _Pragma("unroll") for (int k = 0; k < 2; ++k) \
        acc[ai][bj][m][n] = __builtin_amdgcn_mfma_f32_16x16x32_bf16(Bt[n][k], At[m][k], acc[ai][bj][m][n], 0, 0, 0); __builtin_amdgcn_s_setprio(0); } while (0)
#define PG8_WAIT_V(n) asm volatile("s_waitcnt vmcnt(" #n ")" ::: "memory")
#define PG8_WAIT_L(n) asm volatile("s_waitcnt lgkmcnt(" #n ")" ::: "memory")
#define PG8_BAR __builtin_amdgcn_s_barrier()
#define PG8_SCHED __builtin_amdgcn_sched_barrier(0)
    Unit cur, nxt; int ui = 0;
    if (!S.next(0, cur)) return;
    f32x4 acc[2][2][4][2];
#pragma unroll
    for (int a = 0; a < 2; ++a)
#pragma unroll
        for (int b = 0; b < 2; ++b)
#pragma unroll
            for (int m = 0; m < 4; ++m)
#pragma unroll
                for (int n = 0; n < 2; ++n) acc[a][b][m][n] = (f32x4){0.f, 0.f, 0.f, 0.f};
    bf16x8 At[4][2], B0[2][2], B1[2][2];
    const char* cA = (const char*)g.A + (size_t)cur.pm * tstep + (size_t)cur.ko * 2; const char* cB = (const char*)g.Bt + (size_t)cur.pn * tstep + (size_t)cur.ko * 2;
    S.a_ready(cur);
    if constexpr (SP2) {
        PG8_STAGE(PG8_SB(0, 0), cB, voffB); PG8_STAGE(PG8_SB(0, 1), cB + hstep, voffB); PG8_STAGEA(PG8_SA(0, 0), cA, voffA); PG8_STAGEA(PG8_SA(0, 1), cA + hstep, voffA);
        if (wr == 1) PG8_BAR;
        PG8_WAIT_V(2); PG8_BAR;
        PG8_STAGE(PG8_SB(1, 0), cB + kstep, voffB); PG8_STAGEA(PG8_SA(1, 0), cA + kstep, voffA); PG8_STAGE(PG8_SB(1, 1), cB + hstep + kstep, voffB);
        PG8_WAIT_V(6); PG8_BAR;
    } else {
        PG8_STAGE(PG8_SB(0, 0), cB, voffB); PG8_STAGEA(PG8_SA(0, 0), cA, voffA); PG8_STAGE(PG8_SB(0, 1), cB + hstep, voffB); PG8_STAGEA(PG8_SA(0, 1), cA + hstep, voffA);
        if (wr == 1) PG8_BAR;
        PG8_WAIT_V(4); PG8_BAR;
        PG8_STAGE(PG8_SB(1, 0), cB + kstep, voffB); PG8_STAGEA(PG8_SA(1, 0), cA + kstep, voffA); PG8_STAGE(PG8_SB(1, 1), cB + hstep + kstep, voffB);
        PG8_WAIT_V(6); PG8_BAR;
    }
    for (;;) {
        const bool has_next = S.next(ui + 1, nxt);
        const char* nA = has_next ? (const char*)g.A + (size_t)nxt.pm * tstep + (size_t)nxt.ko * 2 : cA; const char* nB = has_next ? (const char*)g.Bt + (size_t)nxt.pn * tstep + (size_t)nxt.ko * 2 : cB;
        for (int t = 0; t < nt; t += 2) {
            const bool last = (t == nt - 2);
            const char* a1 = cA + (size_t)(t + 1) * kstep;
            const char* a2 = last ? nA : cA + (size_t)(t + 2) * kstep; const char* b2 = last ? nB : cB + (size_t)(t + 2) * kstep;
            const char* a3 = a2 + kstep; const char* b3 = b2 + kstep;
            if (last && has_next) S.a_ready(nxt);
            if constexpr (SP2) {
            PG8_LDB(B0, 0, 0); PG8_LDB(B1, 0, 1); PG8_SCHED; PG8_LDA(At, 0, 0); PG8_STAGEA(PG8_SA(1, 1), a1 + hstep, voffA);
            PG8_WAIT_V(8); PG8_WAIT_L(0); PG8_BAR; PG8_MMA(0, 0, At, B0); PG8_MMA(0, 1, At, B1); PG8_BAR; PG8_SCHED;
            PG8_LDA(At, 0, 1); PG8_STAGE(PG8_SB(0, 0), b2, voffB); PG8_STAGE(PG8_SB(0, 1), b2 + hstep, voffB); PG8_STAGEA(PG8_SA(0, 0), a2, voffA);
            PG8_WAIT_V(8); PG8_WAIT_L(0); PG8_BAR; PG8_MMA(1, 0, At, B0); PG8_MMA(1, 1, At, B1); PG8_BAR; PG8_SCHED;
            PG8_LDB(B0, 1, 0); PG8_LDB(B1, 1, 1); PG8_SCHED; PG8_LDA(At, 1, 0); PG8_STAGEA(PG8_SA(0, 1), a2 + hstep, voffA);
            PG8_WAIT_V(8); PG8_WAIT_L(0); PG8_BAR; PG8_MMA(0, 0, At, B0); PG8_MMA(0, 1, At, B1); PG8_BAR; PG8_SCHED;
            PG8_LDA(At, 1, 1); PG8_STAGE(PG8_SB(1, 0), b3, voffB); PG8_STAGE(PG8_SB(1, 1), b3 + hstep, voffB); PG8_STAGEA(PG8_SA(1, 0), a3, voffA);
            PG8_WAIT_V(8); PG8_WAIT_L(0); PG8_BAR; PG8_MMA(1, 0, At, B0); PG8_MMA(1, 1, At, B1); PG8_BAR; PG8_SCHED;
            } else {
            PG8_LDB(B0, 0, 0); PG8_SCHED; PG8_LDA(At, 0, 0); PG8_STAGEA(PG8_SA(1, 1), a1 + hstep, voffA);
            PG8_WAIT_L(8); PG8_BAR; PG8_WAIT_L(0); PG8_MMA(0, 0, At, B0); PG8_BAR; PG8_SCHED;
            PG8_LDB(B1, 0, 1); PG8_STAGE(PG8_SB(0, 0), b2, voffB);
            PG8_BAR; PG8_WAIT_L(0); PG8_MMA(0, 1, At, B1); PG8_BAR;
            PG8_LDA(At, 0, 1); PG8_STAGEA(PG8_SA(0, 0), a2, voffA);
            PG8_BAR; PG8_WAIT_L(0); PG8_MMA(1, 0, At, B0); PG8_BAR; PG8_SCHED;
            PG8_STAGE(PG8_SB(0, 1), b2 + hstep, voffB);
            PG8_WAIT_V(6); PG8_BAR; PG8_MMA(1, 1, At, B1); PG8_BAR;
            PG8_LDB(B0, 1, 0); PG8_SCHED; PG8_LDA(At, 1, 0); PG8_STAGEA(PG8_SA(0, 1), a2 + hstep, voffA);
            PG8_WAIT_L(8); PG8_BAR; PG8_WAIT_L(0); PG8_MMA(0, 0, At, B0); PG8_BAR; PG8_SCHED;
            PG8_LDB(B1, 1, 1); PG8_STAGE(PG8_SB(1, 0), b3, voffB);
            PG8_BAR; PG8_WAIT_L(0); PG8_MMA(0, 1, At, B1); PG8_BAR;
            PG8_LDA(At, 1, 1); PG8_STAGEA(PG8_SA(1, 0), a3, voffA);
            PG8_BAR; PG8_WAIT_L(0); PG8_MMA(1, 0, At, B0); PG8_BAR; PG8_SCHED;
            PG8_STAGE(PG8_SB(1, 1), b3 + hstep, voffB);
            PG8_WAIT_V(6); PG8_BAR; PG8_MMA(1, 1, At, B1); PG8_BAR;
            }
        }
        if constexpr (ALIGN_EPI) { if (wr == 0) PG8_BAR; }
        if constexpr (!Epi::AFTER_DRAIN) { E(acc, cur, wr, wc, fr, fq); S.done(cur); }
        if (!has_next) break;
#pragma unroll
        for (int a = 0; a < 2; ++a)
#pragma unroll
            for (int b = 0; b < 2; ++b)
#pragma unroll
                for (int m = 0; m < 4; ++m)
#pragma unroll
                    for (int n = 0; n < 2; ++n) acc[a][b][m][n] = (f32x4){0.f, 0.f, 0.f, 0.f};
        cur = nxt; cA = nA; cB = nB; ++ui;
        if constexpr (ALIGN_EPI) { if (wr == 1) PG8_BAR; }
    }
    PG8_WAIT_V(0);
    if constexpr (!ALIGN_EPI) { if (wr == 0) PG8_BAR; }
    PG8_BAR;
    if constexpr (Epi::AFTER_DRAIN) { E.fused(acc, cur, wr, wc, fr, fq, lds, wid, lane); S.done(cur); }
#undef PG8_SA
#undef PG8_SB
#undef PG8_STAGE
#undef PG8_STAGEA
#undef PG8_LDA
#undef PG8_LDB
#undef PG8_MMA
#undef PG8_WAIT_V
#undef PG8_WAIT_L
#undef PG8_BAR
#undef PG8_SCHED
}
}

constexpr size_t MiB = 1u << 20;
constexpr size_t WS_CTL = 0, CTL_ZERO_BYTES = 64 * 1024;
constexpr size_t WS_WIN = 1 * MiB;
constexpr size_t WS_WOUT = 8 * MiB;
constexpr size_t WS_W1 = 10 * MiB;
constexpr size_t WS_W2 = 18 * MiB;
constexpr size_t WS_GW = 26 * MiB;
constexpr size_t WS_SS1 = 27 * MiB;
constexpr size_t WS_SUMA = 30 * MiB, WS_SUMH = 31 * MiB;
constexpr size_t WS_LSE = 32 * MiB;
constexpr size_t WS_LSES = 36 * MiB;
constexpr size_t WS_OBS = 37 * MiB;
constexpr size_t WS_XRS = 43 * MiB;
constexpr size_t WS_XN = 64 * MiB;
constexpr size_t WS_PROJ = 132 * MiB;
constexpr size_t WS_OB = 300 * MiB;
constexpr size_t WS_MIXED = 400 * MiB;
constexpr size_t WS_X1B = 468 * MiB;
constexpr size_t WS_HB = 536 * MiB;
constexpr size_t WS_Y2 = 804 * MiB;
constexpr size_t WS_SLAB = 840 * MiB;
constexpr size_t WS_END = 904 * MiB;
static_assert(WS_WIN + (size_t)NIN * DM * 2 <= WS_WOUT && WS_SS1 + (size_t)MT * 16 * 4 <= WS_SUMA && WS_LSE + (size_t)3 * MT * 8 * 4 <= WS_LSES && WS_OBS + (size_t)4 * MS * 512 * 2 <= WS_XN, "ws map 1");
static_assert(WS_XN + (size_t)MT * DM * 2 <= WS_PROJ && WS_PROJ + (size_t)MT * NIN * 2 <= WS_OB && WS_OB + (size_t)3 * MT * 512 * 2 <= WS_MIXED && WS_MIXED + (size_t)MT * DM * 2 <= WS_X1B && WS_X1B + (size_t)MT * DM * 2 <= WS_HB && WS_HB + (size_t)MT * FF * 2 <= WS_Y2 && WS_Y2 + (size_t)MT * LRU * 2 <= WS_SLAB && WS_SLAB + (size_t)16 * MS * DM * 4 <= WS_END, "ws map 2");
constexpr int CW_BAR = 4096;

constexpr int RING_OFF = 0, RING_BYTES = 131072;
constexpr int LDSCTL_OFF = RING_BYTES, MISC_OFF = LDSCTL_OFF + 320;
constexpr int GWL_OFF = LDSCTL_OFF + 1024;
constexpr int HAL_OFF = GWL_OFF + 16384;
constexpr int LDS_BYTES = HAL_OFF + 8192;
constexpr int BT_OFF = 0;
constexpr int TS_OFF = 18432;
constexpr int TS_STRIDE = 2112;
constexpr int CW_OFF = TS_OFF + 8 * TS_STRIDE * 4;
constexpr int CB_OFF = CW_OFF + 8192;
constexpr int STG_OFF = CB_OFF + 2048;
static_assert(STG_OFF + 8 * 4096 <= RING_BYTES, "P2 LDS scratch");

#define GAS __attribute__((address_space(1)))
#define LAS __attribute__((address_space(3)))
typedef unsigned short bf16;
typedef unsigned v4u __attribute__((ext_vector_type(4)));
typedef unsigned v2u __attribute__((ext_vector_type(2)));
typedef float f32x4 __attribute__((ext_vector_type(4)));
typedef float f32x16 __attribute__((ext_vector_type(16)));
typedef short bf16x8 __attribute__((ext_vector_type(8)));
typedef GAS unsigned gu32;
#define RLX_AGENT __ATOMIC_RELAXED, __HIP_MEMORY_SCOPE_AGENT
#define LDS_WAIT() asm volatile("s_waitcnt lgkmcnt(0)" ::: "memory")
#define VM_WAIT() asm volatile("s_waitcnt vmcnt(0)" ::: "memory")
#define MFMA32(a, b, c) __builtin_amdgcn_mfma_f32_32x32x16_bf16((a), (b), (c), 0, 0, 0)
__device__ __forceinline__ unsigned cvtpk(float lo, float hi) { typedef float f2_t __attribute__((ext_vector_type(2))); typedef __bf16 b2_t __attribute__((ext_vector_type(2))); f2_t v = {lo, hi}; b2_t b = __builtin_convertvector(v, b2_t); return __builtin_bit_cast(unsigned, b); }
__device__ __forceinline__ float bflo(unsigned w) { return __uint_as_float(w << 16); }
__device__ __forceinline__ float bfhi(unsigned w) { return __uint_as_float(w & 0xffff0000u); }
__device__ __forceinline__ bf16x8 pack8f(const f32x4 a, const f32x4 b) { v4u p; p.x = cvtpk(a[0], a[1]); p.y = cvtpk(a[2], a[3]); p.z = cvtpk(b[0], b[1]); p.w = cvtpk(b[2], b[3]); return __builtin_bit_cast(bf16x8, p); }
template <int S> __device__ __forceinline__ bf16x8 pack_step(const f32x16& x) { v4u p; p.x = cvtpk(x[8 * S], x[8 * S + 1]); p.y = cvtpk(x[8 * S + 2], x[8 * S + 3]); p.z = cvtpk(x[8 * S + 4], x[8 * S + 5]); p.w = cvtpk(x[8 * S + 6], x[8 * S + 7]); return __builtin_bit_cast(bf16x8, p); }
__device__ __forceinline__ float lo_half(float x) { auto rr = __builtin_amdgcn_permlane32_swap(__float_as_uint(x), __float_as_uint(x), false, false); return __uint_as_float(rr[0]); }
__device__ __forceinline__ float hi_half(float x) { auto rr = __builtin_amdgcn_permlane32_swap(__float_as_uint(x), __float_as_uint(x), false, false); return __uint_as_float(rr[1]); }
__device__ __forceinline__ float ex2(float x) { return __builtin_amdgcn_exp2f(x); }
__device__ __forceinline__ f32x16 zero16() { f32x16 z;
#pragma unroll
    for (int i = 0; i < 16; ++i) z[i] = 0.f; return z; }
__device__ __forceinline__ bf16x8 make_E(int s, int lane) { const int kk = (lane & 31) - 16 * s - 8 * (lane >> 5); bf16x8 e;
#pragma unroll
    for (int i = 0; i < 8; ++i) e[i] = (i == kk) ? (short)0x3F80 : (short)0; return e; }
__device__ __forceinline__ bf16x8 make_F(int s, int lane) { const int j = lane & 31, hb = lane >> 5; const bool on = ((j >> 4) == s) && (((j >> 2) & 1) == hb); const int kk = ((j >> 3) & 1) * 4 + (j & 3); bf16x8 e;
#pragma unroll
    for (int i = 0; i < 8; ++i) e[i] = (on && i == kk) ? (short)0x3F80 : (short)0; return e; }
__device__ __forceinline__ float wave_sum(float v) {
#pragma unroll
    for (int o = 1; o < 64; o <<= 1) v += __shfl_xor(v, o);
    return v;
}
__device__ __forceinline__ int t5_bucket(int dist) {
    if (dist < 16) return dist;
    const float df = (float)dist;
    int large = 16 + (int)(logf(df / 16.0f) / 4.852030263919617f * 16.0f);
    return large < 31 ? large : 31;
}

typedef short v4i16_t __attribute__((ext_vector_type(4)));
__device__ __forceinline__ bf16x8 vt_frag(const LAS unsigned char* img, int s, int nb, int lane) {
    const int hi = lane >> 5, a = (lane >> 4) & 1, q = (lane & 15) >> 2, p = lane & 3;
    const int r0 = 16 * s + 4 * hi + q, c16 = 4 * nb + 2 * a + (p >> 1), sw = (r0 >> 1) & 7;
    const LAS unsigned char* p0 = img + r0 * 128 + 16 * (c16 ^ sw) + 8 * (p & 1);
    const LAS unsigned char* p1 = img + (r0 + 8) * 128 + 16 * (c16 ^ sw ^ 4) + 8 * (p & 1);
    const v4i16_t lo = __builtin_amdgcn_ds_read_tr16_b64_v4i16((LAS v4i16_t*)p0), hh = __builtin_amdgcn_ds_read_tr16_b64_v4i16((LAS v4i16_t*)p1);
    return __builtin_shufflevector(lo, hh, 0, 1, 2, 3, 4, 5, 6, 7);
}
__device__ __forceinline__ int lane_id_now() { int l; asm volatile("v_mbcnt_lo_u32_b32 %0, -1, 0\n\tv_mbcnt_hi_u32_b32 %0, -1, %0" : "=v"(l)); return l; }
#define XB_TMO      128
#define XB_XCNT(j)  (256  + 64 * (j))
#define XB_XSUB(j)  (1280 + 64 * (j))
#define XB_XGEN(j)  (2304 + 64 * (j))
#define XB_TOP      3328
#define XB_TOPGEN   3392
#define XCD_BAR_WORDS 3456
#define XB_SPIN_CAP (1u << 18)

__device__ __forceinline__ unsigned xb_ld(unsigned* p)              { return __hip_atomic_load(p, __ATOMIC_RELAXED, __HIP_MEMORY_SCOPE_AGENT); }
__device__ __forceinline__ unsigned xb_add(unsigned* p, unsigned v) { return __hip_atomic_fetch_add(p, v, __ATOMIC_RELAXED, __HIP_MEMORY_SCOPE_AGENT); }
__device__ __forceinline__ unsigned xb_xcc_id() { return (unsigned)__builtin_amdgcn_s_getreg((3 << 11) | 20) & 0xFu; }
#define XB_SPIN(cond, bar) do { unsigned _sp = 0; while (cond) { __builtin_amdgcn_s_sleep(1); \
    if ((++_sp & 255u) == 0u) { if (xb_ld(&(bar)[XB_TMO])) break; if (_sp > XB_SPIN_CAP) { atomicAdd(&(bar)[XB_TMO], 1u); break; } } } } while (0)

struct XcdBarrier {
    unsigned* bar; unsigned x;
    volatile LAS unsigned* st;
};

__device__ __forceinline__ XcdBarrier xcd_barrier_post(unsigned* bar, volatile LAS unsigned* st) {
    XcdBarrier b; b.bar = bar; b.x = xb_xcc_id(); b.st = st;
    if (threadIdx.x == 0) (void)xb_add(&bar[XB_XCNT(b.x)], 1u);
    return b;
}
__device__ __forceinline__ void xcd_barrier_complete(unsigned* bar, unsigned x, unsigned& nloc, unsigned& nx) {
    const unsigned G = gridDim.x * gridDim.y * gridDim.z;
    unsigned sum, cnt, mine, sp = 0u;
    for (;;) {
        sum = 0u; cnt = 0u; mine = 0u;
#pragma unroll
        for (unsigned j = 0; j < 16; ++j) { const unsigned c = xb_ld(&bar[XB_XCNT(j)]); sum += c; cnt += (c > 0u) ? 1u : 0u; mine = (j == x) ? c : mine; }
        if (sum == G) break;
        __builtin_amdgcn_s_sleep(1);
        if ((++sp & 255u) == 0u) { if (xb_ld(&bar[XB_TMO])) break; if (sp > XB_SPIN_CAP) { atomicAdd(&bar[XB_TMO], 1u); break; } }
    }
    nloc = mine > 0u ? mine : 1u; nx = cnt > 0u ? cnt : 1u;
}

__device__ __forceinline__ void xcd_barrier(const XcdBarrier& b) {
    asm volatile("s_waitcnt vmcnt(0)" ::: "memory");
    __syncthreads();
    if (threadIdx.x == 0) {
        unsigned* bar = b.bar;
        __builtin_amdgcn_s_waitcnt(0);
        unsigned nloc = b.st[0], nx = b.st[1];
        if (nloc == 0u) { xcd_barrier_complete(bar, b.x, nloc, nx); b.st[0] = nloc; b.st[1] = nx; }
        const unsigned old = xb_add(&bar[XB_XSUB(b.x)], 1u);
        const unsigned gen = old / nloc;
        if (old + 1u == (gen + 1u) * nloc) {
            __builtin_amdgcn_fence(__ATOMIC_RELEASE, "agent");
            asm volatile("s_waitcnt vmcnt(0)" ::: "memory");
            const unsigned og = xb_add(&bar[XB_TOP], 1u);
            const unsigned tg = og / nx;
            if (og + 1u == (tg + 1u) * nx) xb_add(&bar[XB_TOPGEN], 1u);
            else XB_SPIN(xb_ld(&bar[XB_TOPGEN]) == tg, bar);
            __builtin_amdgcn_fence(__ATOMIC_ACQUIRE, "agent");
            xb_add(&bar[XB_XGEN(b.x)], 1u);
            asm volatile("s_waitcnt vmcnt(0)" ::: "memory");
        } else {
            XB_SPIN(xb_ld(&bar[XB_XGEN(b.x)]) == gen, bar);
            __builtin_amdgcn_fence(__ATOMIC_ACQUIRE, "agent");
            asm volatile("s_waitcnt vmcnt(0)" ::: "memory");
        }
    }
    __syncthreads();
}

__device__ __forceinline__ void p0_transpose_item(const float* W, const float* gain, int K, int N, bf16* WT, LAS float* scr, int item, int lane) {
    const int nblk = N / 32, kb = item / nblk, nb = item % nblk, k0 = 64 * kb, n0 = 32 * nb;
    const GAS float* wp = (const GAS float*)W + (size_t)(k0 + (lane >> 5)) * N + n0 + (lane & 31);
    float v[32];
#pragma unroll
    for (int i = 0; i < 32; ++i) v[i] = __builtin_nontemporal_load(wp + (size_t)(2 * i) * N);
    if (gain) {
#pragma unroll
        for (int i = 0; i < 32; ++i) v[i] *= ((const GAS float*)gain)[k0 + 2 * i + (lane >> 5)];
    }
#pragma unroll
    for (int i = 0; i < 32; ++i) scr[(2 * i + (lane >> 5)) * 33 + (lane & 31)] = v[i];
    LDS_WAIT(); asm volatile("" ::: "memory");
    const int c = lane & 7;
#pragma unroll
    for (int j = 0; j < 4; ++j) { const int n = (lane >> 3) + 8 * j; const LAS float* s = scr + (8 * c) * 33 + n;
        v4u o; o.x = cvtpk(s[0 * 33], s[1 * 33]); o.y = cvtpk(s[2 * 33], s[3 * 33]); o.z = cvtpk(s[4 * 33], s[5 * 33]); o.w = cvtpk(s[6 * 33], s[7 * 33]);
        *(GAS v4u*)(WT + (size_t)(n0 + n) * K + k0 + 8 * c) = o; }
    LDS_WAIT(); asm volatile("" ::: "memory");
}
template <int NR>
__device__ __forceinline__ void rms_rows_to_bf16(const float* xp, const float* xs, const float* g, bf16* xn, int m0, int stride, int lane) {
    f32x4 v[NR][4];
#pragma unroll
    for (int r = 0; r < NR; ++r) { const int m = m0 + r * stride; const int mc = m < MT ? m : MT - 1;
        const GAS f32x4* xr = (const GAS f32x4*)(mc < MP ? xp + (size_t)mc * DM : xs + (size_t)(mc - MP) * DM) + lane;
#pragma unroll
        for (int j = 0; j < 4; ++j) v[r][j] = __builtin_nontemporal_load(xr + 64 * j); }
    const GAS f32x4* gr = (const GAS f32x4*)g + lane;
    f32x4 gg[4];
#pragma unroll
    for (int j = 0; j < 4; ++j) gg[j] = gr[64 * j];
#pragma unroll
    for (int r = 0; r < NR; ++r) { const int m = m0 + r * stride;
        float s = 0.f;
#pragma unroll
        for (int j = 0; j < 4; ++j) s += (v[r][j].x * v[r][j].x + v[r][j].y * v[r][j].y) + (v[r][j].z * v[r][j].z + v[r][j].w * v[r][j].w);
        const float rstd = 1.0f / sqrtf(wave_sum(s) * (1.f / DM) + NORM_EPS);
        if (m < MT) { GAS v2u* o8 = (GAS v2u*)(xn + (size_t)m * DM) + lane;
#pragma unroll
            for (int j = 0; j < 4; ++j) { v2u w; w.x = cvtpk(v[r][j].x * rstd * gg[j].x, v[r][j].y * rstd * gg[j].y); w.y = cvtpk(v[r][j].z * rstd * gg[j].z, v[r][j].w * rstd * gg[j].w); o8[64 * j] = w; } } }
}

__device__ __forceinline__ void build_tables(LAS unsigned char* lds, const float* rel_bias, const float* conv_w, const float* conv_b, const bf16* gw, int g, int tid) {
    LAS float* bt = (LAS float*)(lds + BT_OFF);
    for (int i = tid; i < 3 * 8 * 192; i += 512) { const int g = i / 1536, h = (i / 192) & 7, idx = i % 192, j = idx - 31; const int dil = g == 0 ? 1 : (g == 1 ? 4 : 16);
        bt[i] = (j >= 0 && j <= 128) ? rel_bias[t5_bucket(j * dil) * 8 + h] * LOG2E : NEGV; }
    LAS float* ts = (LAS float*)(lds + TS_OFF);
    for (int i = tid; i < 8 * TS_STRIDE; i += 512) { const int h = i / TS_STRIDE, idx = i % TS_STRIDE, dl = idx - 8; float v = NEGV;
        if (dl >= 0 && dl <= 2055) { const int m = (dl <= 128 ? 1 : 0) + (((dl & 3) == 0 && dl <= 512) ? 1 : 0) + (((dl & 15) == 0 && dl <= 2048) ? 1 : 0);
            if (m > 0) v = (m == 1 ? 0.f : (m == 2 ? 1.f : 1.5849625007211562f)) + rel_bias[t5_bucket(dl) * 8 + h] * LOG2E; }
        ts[i] = v; }
    LAS float* cw = (LAS float*)(lds + CW_OFF);
    for (int i = tid; i < 4 * 512; i += 512) cw[i] = conv_w[i];
    LAS float* cb = (LAS float*)(lds + CB_OFF);
    for (int i = tid; i < 512; i += 512) cb[i] = conv_b[i];
    for (int i = tid; i < 1024; i += 512) { const int mat = i >> 9, orow = (i >> 3) & 63, chn = i & 7;
        const v4u v = *(const GAS v4u*)((const GAS bf16*)gw + ((size_t)(mat * 8 + g) * 64 + orow) * 64 + chn * 8);
        *(LAS v4u*)(lds + GWL_OFF + mat * 8192 + orow * 128 + 16 * (chn ^ ((orow >> 1) & 7))) = v; }
}

#ifndef PA_NVE
#define PA_NVE 2
#endif
template <int NT>
__device__ __forceinline__ void pa_body(const GAS bf16* proj, GAS bf16* po, GAS float* plse, const LAS float* tb0, LAS unsigned char* stg, int rowq, unsigned offk0, unsigned ostep, unsigned ostepq, int lane, const bf16x8 E0, const bf16x8 E1) {
    const int hi = lane >> 5, kv = lane & 31;
    bf16x8 qf[4];
    { const GAS bf16* pq = proj + (size_t)rowq * NIN + hi * 8;
#pragma unroll
      for (int ks = 0; ks < 4; ++ks) qf[ks] = *(const GAS bf16x8*)(pq + 16 * ks); }
    constexpr int NVE = NT < PA_NVE ? NT : PA_NVE;
    v4u kr[NT][4];
#pragma unroll
    for (int j = 0; j < NT; ++j)
#pragma unroll
        for (int i = 0; i < 4; ++i) { const int row = 8 * i + (lane >> 3); const unsigned ch = (unsigned)((lane & 7) ^ ((row >> 1) & 7));
            kr[j][i] = *(const GAS v4u*)(proj + (offk0 + (unsigned)j * ostep + (unsigned)i * (ostep >> 2) + 512u + 8u * ch)); }
    LAS unsigned char* wr = stg + 16 * lane;
    const LAS unsigned char* rd0 = stg + kv * 128;
    const int sw = (kv >> 1) & 7;
    const f32x16 zero = zero16();
    f32x16 p[NT];
#pragma unroll
    for (int j = 0; j < NT; ++j) {
#pragma unroll
        for (int i = 0; i < 4; ++i) *(LAS v4u*)(wr + i * 1024) = kr[j][i];
        if (j < NVE) {
#pragma unroll
            for (int i = 0; i < 4; ++i) { const int row = 8 * i + (lane >> 3); const unsigned ch = (unsigned)((lane & 7) ^ ((row >> 1) & 7));
                kr[j][i] = *(const GAS v4u*)(proj + (offk0 + (unsigned)j * ostep + (unsigned)i * (ostep >> 2) + 1024u + 8u * ch)); } }
        f32x16 a = zero;
#pragma unroll
        for (int ks = 0; ks < 4; ++ks) a = MFMA32(*(const LAS bf16x8*)(rd0 + 16 * ((2 * ks + hi) ^ sw)), qf[ks], a);
        p[j] = a;
    }
    float m = NEGV;
#pragma unroll
    for (int j = 0; j < NT; ++j) { const LAS float* tb = tb0 - 32 * (j + 5 - NT);
#pragma unroll
        for (int r = 0; r < 16; ++r) { p[j][r] += tb[27 - ((r & 3) + 8 * (r >> 2))]; m = fmaxf(m, p[j][r]); } }
    m = fmaxf(lo_half(m), hi_half(m));
    float l = 0.f;
    bf16x8 pb[NT][2];
#pragma unroll
    for (int j = 0; j < NT; ++j) {
#pragma unroll
        for (int r = 0; r < 16; ++r) { const float e = ex2(p[j][r] - m); p[j][r] = e; l += e; }
        pb[j][0] = pack_step<0>(p[j]); pb[j][1] = pack_step<1>(p[j]);
    }
    l = lo_half(l) + hi_half(l);
    __builtin_amdgcn_sched_barrier(0);
#pragma unroll
    for (int j = NVE; j < NT; ++j)
#pragma unroll
        for (int i = 0; i < 4; ++i) { const int row = 8 * i + (lane >> 3); const unsigned ch = (unsigned)((lane & 7) ^ ((row >> 1) & 7));
            kr[j][i] = *(const GAS v4u*)(proj + (offk0 + (unsigned)j * ostep + (unsigned)i * (ostep >> 2) + 1024u + 8u * ch)); }
    f32x16 o0 = zero, o1 = zero;
#pragma unroll
    for (int j = 0; j < NT; ++j) {
#pragma unroll
        for (int i = 0; i < 4; ++i) *(LAS v4u*)(wr + i * 1024) = kr[j][i];
        const bf16x8 v0 = *(const LAS bf16x8*)(rd0 + 16 * ((0 + hi) ^ sw)), v1 = *(const LAS bf16x8*)(rd0 + 16 * ((2 + hi) ^ sw)), v2 = *(const LAS bf16x8*)(rd0 + 16 * ((4 + hi) ^ sw)), v3 = *(const LAS bf16x8*)(rd0 + 16 * ((6 + hi) ^ sw));
        f32x16 x0 = MFMA32(v0, E0, zero); x0 = MFMA32(v1, E1, x0);
        f32x16 x1 = MFMA32(v2, E0, zero); x1 = MFMA32(v3, E1, x1);
        o0 = MFMA32(pack_step<0>(x0), pb[j][0], o0); o1 = MFMA32(pack_step<0>(x1), pb[j][0], o1);
        o0 = MFMA32(pack_step<1>(x0), pb[j][1], o0); o1 = MFMA32(pack_step<1>(x1), pb[j][1], o1);
    }
    const float inv = __builtin_amdgcn_rcpf(l);
    { LAS unsigned char* wq = stg + kv * 128 + 8 * hi;
#pragma unroll
      for (int rg = 0; rg < 4; ++rg) {
        v2u w0, w1;
        w0.x = cvtpk(o0[4 * rg] * inv, o0[4 * rg + 1] * inv); w0.y = cvtpk(o0[4 * rg + 2] * inv, o0[4 * rg + 3] * inv);
        w1.x = cvtpk(o1[4 * rg] * inv, o1[4 * rg + 1] * inv); w1.y = cvtpk(o1[4 * rg + 2] * inv, o1[4 * rg + 3] * inv);
        *(LAS v2u*)(wq + 16 * (rg ^ sw)) = w0; *(LAS v2u*)(wq + 16 * ((4 + rg) ^ sw)) = w1;
      } }
#pragma unroll
    for (int i = 0; i < 4; ++i) { const int row = 8 * i + (lane >> 3); const unsigned ch = (unsigned)((lane & 7) ^ ((row >> 1) & 7));
        const v4u v = *(const LAS v4u*)(stg + i * 1024 + 16 * lane);
        *(GAS v4u*)(po + ((unsigned)i * ostepq + 8u * ch)) = v; }
    if (hi == 0) *plse = m + log2f(l);
}
__device__ __forceinline__ void pa_task(const bf16* proj, bf16* ob, float* lse, const LAS float* btab, LAS unsigned char* stg, int id, int lane_in, const int DUMMY = 0) {
    int lane = lane_in; asm volatile("" : "+v"(lane));
    const bf16x8 E0 = make_E(0, lane), E1 = make_E(1, lane);
    const int g = id >> 13, rem = id & 8191, bh = rem >> 6, k64 = (rem + 21 * (id >> 11)) & 63, b = bh >> 3, h = bh & 7;
    int d, c, ti;
    if (g == 0) { d = 1; c = 0; ti = k64; } else if (g == 1) { d = 4; c = k64 >> 4; ti = k64 & 15; } else { d = 16; c = k64 >> 2; ti = k64 & 3; }
    const int q = lane & 31, hi = lane >> 5, i0 = ti * 32;
    const int nt = ti < 4 ? ti + 1 : 5;
    int rowq = b * SEQ + d * (i0 + q) + c;
    int rowk0 = b * SEQ + d * (i0 - 32 * (nt - 1) + (lane >> 3)) + c;
    int dd = d;
    if (DUMMY == 1) { rowq &= 63; rowk0 &= 63; dd = 0; }
    const GAS bf16* pj = (const GAS bf16*)proj + h * 64;
    const int rowq8 = (DUMMY == 1) ? ((lane >> 3) & 63) : b * SEQ + d * (i0 + (lane >> 3)) + c;
    GAS bf16* po = (GAS bf16*)ob + ((size_t)g * MT + rowq8) * ATT + h * 64;
    GAS float* pl = (GAS float*)lse + ((size_t)g * MT + rowq) * 8 + h;
    const LAS float* tb0 = btab + (g * 8 + h) * 192 + (159 - 27 + q - 4 * hi);
    const unsigned ostepq = (unsigned)(8 * dd) * (unsigned)ATT;
    const unsigned offk0 = (unsigned)rowk0 * (unsigned)NIN, ostep = (unsigned)(32 * dd) * (unsigned)NIN;
    if (nt == 5) pa_body<5>(pj, po, pl, tb0, stg, rowq, offk0, ostep, ostepq, lane, E0, E1);
    else if (nt == 4) pa_body<4>(pj, po, pl, tb0, stg, rowq, offk0, ostep, ostepq, lane, E0, E1);
    else if (nt == 3) pa_body<3>(pj, po, pl, tb0, stg, rowq, offk0, ostep, ostepq, lane, E0, E1);
    else if (nt == 2) pa_body<2>(pj, po, pl, tb0, stg, rowq, offk0, ostep, ostepq, lane, E0, E1);
    else pa_body<1>(pj, po, pl, tb0, stg, rowq, offk0, ostep, ostepq, lane, E0, E1);
}

struct SaHalf { f32x4 x[8]; };
__device__ __forceinline__ void sa_load(SaHalf& t, const float* c, int b, int h, int tile, int lane) {
    const int pbase = tile < 24 ? 64 * tile : 1536 + 32 * (tile - 24), strd = tile < 24 ? 16 : 8;
    const GAS float* p0 = (const GAS float*)c + ((size_t)b * NCACHE * NH + h) * HD + 4 * (lane & 15);
#pragma unroll
    for (int i = 0; i < 8; ++i) { const int r = 4 * i + (lane >> 4); const int prow = pbase + strd * (r >> 3) + (r & 7);
        t.x[i] = __builtin_nontemporal_load((const GAS f32x4*)(p0 + (size_t)prow * (NH * HD))); }
}
__device__ __forceinline__ void sa_stage(const SaHalf& t, LAS unsigned char* stg, int lane, bf16x8 (&f)[4]) {
#pragma unroll
    for (int i = 0; i < 8; ++i) { const int r = 4 * i + (lane >> 4); v2u w; w.x = cvtpk(t.x[i][0], t.x[i][1]); w.y = cvtpk(t.x[i][2], t.x[i][3]);
        *(LAS v2u*)(stg + r * 128 + 16 * (((lane & 15) >> 1) ^ ((r >> 1) & 7)) + 8 * (lane & 1)) = w; }
    const int kv = lane & 31, hi = lane >> 5, sw = (kv >> 1) & 7;
#pragma unroll
    for (int ks = 0; ks < 4; ++ks) f[ks] = *(const LAS bf16x8*)(stg + kv * 128 + 16 * ((2 * ks + hi) ^ sw));
}
__device__ __forceinline__ void sa_step(const bf16x8 (&kf)[4], const bf16x8 (&vf)[4], const bf16x8 (&qf)[4], const LAS float* ts, int dbase, int strd, float& m, float& l, f32x16& o0, f32x16& o1, const bf16x8 E0, const bf16x8 E1) {
    const f32x16 zero = zero16();
    f32x16 a = zero;
#pragma unroll
    for (int ks = 0; ks < 4; ++ks) a = MFMA32(kf[ks], qf[ks], a);
#pragma unroll
    for (int r = 0; r < 16; ++r) { int dl = dbase - strd * (r >> 2) - (r & 3); dl = dl < -1 ? -1 : dl; a[r] += ts[dl]; }
    float mx = a[0];
#pragma unroll
    for (int r = 1; r < 16; ++r) mx = fmaxf(mx, a[r]);
    mx = fmaxf(lo_half(mx), hi_half(mx));
    const float mn = fmaxf(fmaxf(m, mx), -1e20f);
    const float sc = ex2(m - mn);
    float ls = 0.f;
#pragma unroll
    for (int r = 0; r < 16; ++r) { const float e = ex2(a[r] - mn); a[r] = e; ls += e; }
    ls = lo_half(ls) + hi_half(ls);
    l = l * sc + ls; m = mn;
#pragma unroll
    for (int r = 0; r < 16; ++r) { o0[r] *= sc; o1[r] *= sc; }
    f32x16 x0 = MFMA32(vf[0], E0, zero); x0 = MFMA32(vf[1], E1, x0);
    f32x16 x1 = MFMA32(vf[2], E0, zero); x1 = MFMA32(vf[3], E1, x1);
    { const bf16x8 pb = pack_step<0>(a); o0 = MFMA32(pack_step<0>(x0), pb, o0); o1 = MFMA32(pack_step<0>(x1), pb, o1); }
    { const bf16x8 pb = pack_step<1>(a); o0 = MFMA32(pack_step<1>(x0), pb, o0); o1 = MFMA32(pack_step<1>(x1), pb, o1); }
}
__device__ __forceinline__ void sa_task(const bf16* proj, const float* ck, const float* cv, bf16* obs, float* lses, const LAS float* tabS, LAS unsigned char* stg, int id, int lane_in) {
    int lane = lane_in; asm volatile("" : "+v"(lane));
    const bf16x8 E0 = make_E(0, lane), E1 = make_E(1, lane);
    const int h = id & 7, seg = (id >> 3) & 3, b = id >> 5;
    const int q = lane & 31, hi = lane >> 5, t = q & 7;
    const int rowq = MP + b * DECT + t;
    const GAS bf16* pq = (const GAS bf16*)proj + (size_t)rowq * NIN + h * 64 + hi * 8;
    bf16x8 qf[4];
#pragma unroll
    for (int ks = 0; ks < 4; ++ks) qf[ks] = *(const GAS bf16x8*)(pq + 16 * ks);
    const int T0 = seg == 0 ? 0 : 1 + 10 * seg, T1 = 11 + 10 * seg, T1c = T1 < 40 ? T1 : 40;
    float m = NEGV, l = 0.f; f32x16 o0 = zero16(), o1 = zero16();
    const LAS float* ts = tabS + h * TS_STRIDE + 8;
    SaHalf kx, vx;
    sa_load(kx, ck, b, h, T0, lane); sa_load(vx, cv, b, h, T0, lane);
#pragma unroll 1
    for (int tile = T0; tile < T1c; ++tile) {
        const int pbase = tile < 24 ? 64 * tile : 1536 + 32 * (tile - 24), strd = tile < 24 ? 16 : 8;
        bf16x8 kf[4], vf[4];
        sa_stage(kx, stg, lane, kf); sa_stage(vx, stg, lane, vf);
        __builtin_amdgcn_sched_barrier(0);
        { const int tn = tile + 1 < T1c ? tile + 1 : tile; sa_load(kx, ck, b, h, tn, lane); sa_load(vx, cv, b, h, tn, lane); }
        __builtin_amdgcn_sched_barrier(0);
        sa_step(kf, vf, qf, ts, NCACHE + t - pbase - 4 * hi, strd, m, l, o0, o1, E0, E1);
    }
    if (T1 > 40) {
        const int rk = MP + b * DECT + (q & 7);
        const GAS bf16* pk = (const GAS bf16*)proj + (size_t)rk * NIN + 512 + h * 64 + hi * 8;
        bf16x8 kf[4], vf[4];
#pragma unroll
        for (int ks = 0; ks < 4; ++ks) { kf[ks] = *(const GAS bf16x8*)(pk + 16 * ks); vf[ks] = *(const GAS bf16x8*)(pk + 512 + 16 * ks); }
        sa_step(kf, vf, qf, ts, NCACHE + t - 2048 - 4 * hi, 8, m, l, o0, o1, E0, E1);
    }
    if (q < 8) {
        const float ll = fmaxf(l, 1e-30f), inv = 1.0f / ll;
        GAS bf16* po = (GAS bf16*)obs + ((size_t)seg * MS + b * DECT + t) * ATT + h * 64 + 4 * hi;
#pragma unroll
        for (int rg = 0; rg < 4; ++rg) {
            v2u w0, w1;
            w0.x = cvtpk(o0[4 * rg] * inv, o0[4 * rg + 1] * inv); w0.y = cvtpk(o0[4 * rg + 2] * inv, o0[4 * rg + 3] * inv);
            w1.x = cvtpk(o1[4 * rg] * inv, o1[4 * rg + 1] * inv); w1.y = cvtpk(o1[4 * rg + 2] * inv, o1[4 * rg + 3] * inv);
            *(GAS v2u*)(po + 8 * rg) = w0; *(GAS v2u*)(po + 32 + 8 * rg) = w1;
        }
        if (hi == 0) ((GAS float*)lses)[((size_t)seg * MS + b * DECT + t) * 8 + h] = m + log2f(ll);
    }
}

struct RgIo { const bf16* proj; const unsigned char* wsb; const float* sh; const float* gab; const float* gxb; const float* lam; const bf16* gw; bf16* mixed; bf16* y2; float* suma; float* sumh; float* out; };
struct RgX { v4u x[4][4]; bf16x8 g[4]; };
template <bool SAMPLE, int PART>
__device__ __forceinline__ void rg_xload(RgX& X, const unsigned char* wsb, int rowbase, int tt0, int bs0, int g, int lane) {
    const int tok = lane & 31, hi = lane >> 5;
    const int tq = SAMPLE ? (tok & 7) : (tt0 + tok);
    const GAS unsigned char* pb = (const GAS unsigned char*)wsb;
    const unsigned o0 = (unsigned)WS_PROJ + ((unsigned)(rowbase + tok) * (unsigned)NIN + (unsigned)(1536 + g * 64 + hi * 8)) * 2u;
    const unsigned os = (unsigned)WS_XRS + ((unsigned)((SAMPLE ? bs0 + (tok >> 3) : DECB) * 3) * (unsigned)LRU + (unsigned)(g * 64 + hi * 8)) * 2u;
#pragma unroll
    for (int j = (PART == 0 ? 0 : 3); j < (PART == 0 ? 3 : 4); ++j) { const int tj = tq - 3 + j; const unsigned oj = tj >= 0 ? o0 - (unsigned)((3 - j) * NIN * 2) : os + (unsigned)((3 + tj) * LRU * 2);
#pragma unroll
        for (int ks = 0; ks < 4; ++ks) X.x[ks][j] = *(const GAS v4u*)(pb + (oj + 32u * ks)); }
    if (PART == 1) {
#pragma unroll
        for (int ks = 0; ks < 4; ++ks) X.g[ks] = *(const GAS bf16x8*)(pb + (o0 + 1024u + 32u * ks));
    }
}
__device__ __forceinline__ void rg_conv(const RgX& X, int g, int lane, const LAS float* cw, const LAS float* cb, bf16x8 (&af)[4]) {
    const int hi = lane >> 5;
#pragma unroll
    for (int ks = 0; ks < 4; ++ks) {
        const int cg = g * 64 + 16 * ks + 8 * hi;
        f32x4 a0 = *(const LAS f32x4*)(cb + cg), a1 = *(const LAS f32x4*)(cb + cg + 4);
#pragma unroll
        for (int j = 0; j < 4; ++j) {
            const v4u xw = X.x[ks][j];
            const f32x4 x0 = (f32x4){bflo(xw.x), bfhi(xw.x), bflo(xw.y), bfhi(xw.y)}, x1 = (f32x4){bflo(xw.z), bfhi(xw.z), bflo(xw.w), bfhi(xw.w)};
            const f32x4 w0 = *(const LAS f32x4*)(cw + j * 512 + cg), w1 = *(const LAS f32x4*)(cw + j * 512 + cg + 4);
            a0 += w0 * x0; a1 += w1 * x1;
        }
        af[ks] = pack8f(a0, a1);
        __builtin_amdgcn_sched_barrier(0);
    }
}
struct RgConst { float ba, bx, clam; };
__device__ __forceinline__ RgConst rg_load_consts(const RgIo& io, int g, int nb, int lane) {
    RgConst rc; const int ch = g * 64 + 32 * nb + (lane & 31); rc.ba = ((const GAS float*)io.gab)[ch]; rc.bx = ((const GAS float*)io.gxb)[ch];
    rc.clam = -8.0f * log1pf(expf(-((const GAS float*)io.lam)[ch])) * LOG2E;
    return rc;
}
template <bool SAMPLE, int NB>
__device__ __forceinline__ void rgc_block(const RgIo& io, const LAS unsigned char* gwl, const bf16x8 (&af)[4], const bf16x8 gf0, const bf16x8 gf1, int g, int bs0, int lane,
                                          const bf16x8 E0, const bf16x8 E1, const bf16x8 F0, const bf16x8 F1, const RgConst rc, float& ch_, float& cp_, f32x16& Z1, f32x16& Z2) {
    const int hi = lane >> 5, cl = lane & 31, ch = g * 64 + 32 * NB + cl;
    const f32x16 zero = zero16();
    f32x16 R = zero, I = zero;
    { const int orow = 32 * NB + cl, sw = (orow >> 1) & 7; const LAS unsigned char* pa = gwl + orow * 128; const LAS unsigned char* px = pa + 8192;
#pragma unroll
      for (int ks = 0; ks < 4; ++ks) { const int pos = 16 * ((2 * ks + hi) ^ sw); R = MFMA32(af[ks], *(const LAS bf16x8*)(pa + pos), R); I = MFMA32(af[ks], *(const LAS bf16x8*)(px + pos), I); } }
    f32x16 XC = MFMA32(af[2 * NB], E0, zero); XC = MFMA32(af[2 * NB + 1], E1, XC);
    __builtin_amdgcn_sched_barrier(0);
    f32x16 A, U;
#pragma unroll
    for (int r = 0; r < 16; ++r) {
        const float rr = __builtin_amdgcn_rcpf(1.0f + ex2(-(R[r] + rc.ba) * LOG2E));
        const float ii = __builtin_amdgcn_rcpf(1.0f + ex2(-(I[r] + rc.bx) * LOG2E));
        const float a = ex2(rr * rc.clam);
        A[r] = a; U[r] = __builtin_amdgcn_sqrtf(__builtin_fmaf(-a, a, 1.0f)) * (ii * XC[r]);
    }
    __builtin_amdgcn_sched_barrier(0);
    f32x16 Gt = MFMA32(gf0, E0, zero); Gt = MFMA32(gf1, E1, Gt);
    f32x16 O1, O2;
#pragma unroll
    for (int grp = 0; grp < 4; ++grp) {
        if (SAMPLE) { ch_ = ((const GAS float*)io.sh)[(size_t)(bs0 + grp) * LRU + ch]; cp_ = 0.f; }
        float h0 = ch_, p0 = cp_, hv0[4], hv1[4], pv0[4], pv1[4];
#pragma unroll
        for (int kk = 0; kk < 4; ++kk) { h0 = A[4 * grp + kk] * h0 + U[4 * grp + kk]; p0 *= A[4 * grp + kk]; hv0[kk] = h0; pv0[kk] = p0; }
        float h1 = lo_half(h0), p1 = lo_half(p0);
#pragma unroll
        for (int kk = 0; kk < 4; ++kk) { h1 = A[4 * grp + kk] * h1 + U[4 * grp + kk]; p1 *= A[4 * grp + kk]; hv1[kk] = h1; pv1[kk] = p1; }
        ch_ = hi_half(h1); cp_ = hi_half(p1);
        if (SAMPLE) { if (hi == 0) ((GAS float*)io.out)[OFF_NHS + (size_t)(bs0 + grp) * LRU + ch] = ch_; }
#pragma unroll
        for (int kk = 0; kk < 4; ++kk) { const float x = Gt[4 * grp + kk];
            const float gl = x * __builtin_amdgcn_rcpf(1.0f + ex2(-2.3022081984f * (x + 0.044715f * x * x * x)));
            O1[4 * grp + kk] = (hi ? hv1[kk] : hv0[kk]) * gl; O2[4 * grp + kk] = (hi ? pv1[kk] : pv0[kk]) * gl; }
    }
    __builtin_amdgcn_sched_barrier(0);
    Z1 = MFMA32(pack_step<0>(O1), F0, zero); Z1 = MFMA32(pack_step<1>(O1), F1, Z1);
    Z2 = MFMA32(pack_step<0>(O2), F0, zero); Z2 = MFMA32(pack_step<1>(O2), F1, Z2);
}
template <int NB>
__device__ __forceinline__ void rgc_store(const RgIo& io, LAS unsigned char* stg, const f32x16& Z1, const f32x16& Z2, int g, int rowbase, int lane) {
    const int hi = lane >> 5, cl = lane & 31, sw = (cl >> 1) & 7;
    LAS unsigned char* wq = stg + cl * 128 + 8 * hi;
#pragma unroll
    for (int rg = 0; rg < 4; ++rg) { v2u w; w.x = cvtpk(Z1[4 * rg], Z1[4 * rg + 1]); w.y = cvtpk(Z1[4 * rg + 2], Z1[4 * rg + 3]); *(LAS v2u*)(wq + 16 * (rg ^ sw)) = w;
        v2u y; y.x = cvtpk(Z2[4 * rg], Z2[4 * rg + 1]); y.y = cvtpk(Z2[4 * rg + 2], Z2[4 * rg + 3]); *(LAS v2u*)(wq + 16 * ((4 + rg) ^ sw)) = y; }
    GAS bf16* p1 = (GAS bf16*)io.mixed + (ATT + g * 64 + 32 * NB); GAS bf16* p2 = (GAS bf16*)io.y2 + (g * 64 + 32 * NB);
#pragma unroll
    for (int i = 0; i < 4; ++i) { const int row = 8 * i + (lane >> 3); const int ch = (lane & 7) ^ ((row >> 1) & 7);
        const v4u v = *(const LAS v4u*)(stg + i * 1024 + 16 * lane);
        GAS bf16* dst = (ch < 4) ? p1 + ((unsigned)(rowbase + row) * (unsigned)DM + 8u * ch) : p2 + ((unsigned)(rowbase + row) * (unsigned)LRU + 8u * (ch - 4));
        *(GAS v4u*)dst = v; }
}
template <bool SAMPLE>
__device__ __forceinline__ void rgc_task(const RgIo& io, const LAS float* cw, const LAS float* cb, const LAS unsigned char* gwl, LAS unsigned char* stg, int g, int bc, int lane_in) {
    int lane = lane_in; asm volatile("" : "+v"(lane));
    const bf16x8 E0 = make_E(0, lane), E1 = make_E(1, lane), F0 = make_F(0, lane), F1 = make_F(1, lane);
    const int c = SAMPLE ? 0 : (bc & 15), bu = SAMPLE ? 0 : (bc >> 4);
    const int hi = lane >> 5, cl = lane & 31;
    const RgConst rc0 = rg_load_consts(io, g, 0, lane), rc1 = rg_load_consts(io, g, 1, lane);
    const int row0 = SAMPLE ? MP + bc * 32 : bu * SEQ + 128 * c;
    constexpr int NTL = SAMPLE ? 1 : 4;
    float ch0 = 0.f, ch1 = 0.f, cp0 = 1.f, cp1 = 1.f;
    RgX X;
    rg_xload<SAMPLE, 1>(X, io.wsb, row0, 128 * c, SAMPLE ? bc * 4 : 0, g, lane);
#pragma unroll 1
    for (int k = 0; k < NTL; ++k) {
        const int rowbase = row0 + 32 * k, bs0 = SAMPLE ? bc * 4 : 0;
        rg_xload<SAMPLE, 0>(X, io.wsb, rowbase, 128 * c + 32 * k, bs0, g, lane);
        bf16x8 af[4];
        rg_conv(X, g, lane, cw, cb, af);
        const bf16x8 g0 = X.g[0], g1 = X.g[1], g2 = X.g[2], g3 = X.g[3];
        __builtin_amdgcn_sched_barrier(0);
        f32x16 Z1, Z2;
        rgc_block<SAMPLE, 0>(io, gwl, af, g0, g1, g, bs0, lane, E0, E1, F0, F1, rc0, ch0, cp0, Z1, Z2);
        rgc_store<0>(io, stg, Z1, Z2, g, rowbase, lane);
        __builtin_amdgcn_sched_barrier(0);
        rgc_block<SAMPLE, 1>(io, gwl, af, g2, g3, g, bs0, lane, E0, E1, F0, F1, rc1, ch1, cp1, Z1, Z2);
        __builtin_amdgcn_sched_barrier(0);
        if (!SAMPLE) { if (k + 1 < NTL) rg_xload<SAMPLE, 1>(X, io.wsb, rowbase + 32, 128 * c + 32 * k + 32, 0, g, lane); }
        __builtin_amdgcn_sched_barrier(0);
        rgc_store<1>(io, stg, Z1, Z2, g, rowbase, lane);
    }
    if (!SAMPLE) {
        if (hi == 0) { const size_t o = ((size_t)bu * 16 + c) * LRU + g * 64 + cl;
            ((GAS float*)io.suma)[o] = cp0; ((GAS float*)io.sumh)[o] = ch0; ((GAS float*)io.suma)[o + 32] = cp1; ((GAS float*)io.sumh)[o + 32] = ch1; }
        if (c == 15) {
#pragma unroll
            for (int j = 0; j < 3; ++j) { const unsigned short xv = ((const GAS bf16*)io.proj)[(size_t)(bu * SEQ + SEQ - 3 + j) * NIN + 1536 + g * 64 + lane];
                ((GAS float*)io.out)[OFF_NCP + ((size_t)bu * 3 + j) * LRU + g * 64 + lane] = __uint_as_float((unsigned)xv << 16); }
        }
    } else {
#pragma unroll
        for (int sq = 0; sq < 4; ++sq) {
            const int bb = bc * 4 + sq;
#pragma unroll
            for (int j = 0; j < 3; ++j) { const unsigned short xv = ((const GAS bf16*)io.proj)[(size_t)(MP + bb * DECT + 5 + j) * NIN + 1536 + g * 64 + lane];
                ((GAS float*)io.out)[OFF_NCS + ((size_t)bb * 3 + j) * LRU + g * 64 + lane] = __uint_as_float((unsigned)xv << 16); }
        }
    }
}

struct RgRaw { v4u x[4]; v4u h; };
__device__ __forceinline__ void rgp_load(RgRaw& R, const unsigned char* wsb, int rowbase, int tt0, int g, int lane) {
    const GAS unsigned char* pb = (const GAS unsigned char*)wsb;
#pragma unroll
    for (int i = 0; i < 4; ++i) { const int r = 8 * i + (lane >> 3); const unsigned ch = (unsigned)((lane & 7) ^ ((r >> 1) & 7));
        R.x[i] = *(const GAS v4u*)(pb + ((unsigned)WS_PROJ + ((unsigned)(rowbase + r) * (unsigned)NIN + (unsigned)(1536 + g * 64) + 8u * ch) * 2u)); }
    { const int hr = (lane >> 3) < 3 ? (lane >> 3) : 2;
      const unsigned off = (tt0 - 3 + hr >= 0) ? (unsigned)WS_PROJ + ((unsigned)(rowbase - 3 + hr) * (unsigned)NIN + (unsigned)(1536 + g * 64 + 8 * (lane & 7))) * 2u
                                               : (unsigned)WS_XRS + ((unsigned)((DECB * 3 + hr) * LRU + g * 64 + 8 * (lane & 7))) * 2u;
      R.h = *(const GAS v4u*)(pb + off); }
}
__device__ __forceinline__ void rgp_load_gate(v4u (&G)[4], const unsigned char* wsb, int rowbase, int g, int lane) {
    const GAS unsigned char* pb = (const GAS unsigned char*)wsb;
#pragma unroll
    for (int i = 0; i < 4; ++i) { const int r = 8 * i + (lane >> 3); const unsigned ch = (unsigned)((lane & 7) ^ ((r >> 1) & 7));
        G[i] = *(const GAS v4u*)(pb + ((unsigned)WS_PROJ + ((unsigned)(rowbase + r) * (unsigned)NIN + (unsigned)(2048 + g * 64) + 8u * ch) * 2u)); }
}
__device__ __forceinline__ void rgp_task(const RgIo& io, const LAS float* cw, const LAS float* cb, const LAS unsigned char* gwl, LAS unsigned char* stg, LAS unsigned char* hal, int g, int bc, int lane_in) {
    int lane = lane_in; asm volatile("" : "+v"(lane));
    const bf16x8 E0 = make_E(0, lane), E1 = make_E(1, lane), F0 = make_F(0, lane), F1 = make_F(1, lane);
    const int c = bc & 15, bu = bc >> 4;
    const int hi = lane >> 5, cl = lane & 31;
    const RgConst rc0 = rg_load_consts(io, g, 0, lane), rc1 = rg_load_consts(io, g, 1, lane);
    const int row0 = bu * SEQ + 128 * c;
    float ch0 = 0.f, ch1 = 0.f, cp0 = 1.f, cp1 = 1.f;
    RgRaw R;
    rgp_load(R, io.wsb, row0, 128 * c, g, lane);
#pragma unroll 1
    for (int k = 0; k < 4; ++k) {
        const int rowbase = row0 + 32 * k;
        RgX X;
        v4u GR[4]; rgp_load_gate(GR, io.wsb, rowbase, g, lane);
#pragma unroll
        for (int i = 0; i < 4; ++i) *(LAS v4u*)(stg + i * 1024 + 16 * lane) = R.x[i];
        *(LAS v4u*)(hal + 16 * lane) = R.h;
#pragma unroll
        for (int j = 0; j < 4; ++j) { const int rr = cl - 3 + j; const LAS unsigned char* rp = rr >= 0 ? stg + rr * 128 : hal + (rr + 3) * 128; const int sw = rr >= 0 ? ((rr >> 1) & 7) : 0;
#pragma unroll
            for (int ks = 0; ks < 4; ++ks) X.x[ks][j] = *(const LAS v4u*)(rp + 16 * ((2 * ks + hi) ^ sw)); }
#pragma unroll
        for (int i = 0; i < 4; ++i) *(LAS v4u*)(stg + i * 1024 + 16 * lane) = GR[i];
        { const int sw = (cl >> 1) & 7;
#pragma unroll
          for (int ks = 0; ks < 4; ++ks) X.g[ks] = *(const LAS bf16x8*)(stg + cl * 128 + 16 * ((2 * ks + hi) ^ sw)); }
        bf16x8 af[4];
        rg_conv(X, g, lane, cw, cb, af);
        const bf16x8 g0 = X.g[0], g1 = X.g[1], g2 = X.g[2], g3 = X.g[3];
        __builtin_amdgcn_sched_barrier(0);
        { const int kn = k < 3 ? k + 1 : k; rgp_load(R, io.wsb, row0 + 32 * kn, 128 * c + 32 * kn, g, lane); }
        __builtin_amdgcn_sched_barrier(0);
        f32x16 Z1, Z2;
        rgc_block<false, 0>(io, gwl, af, g0, g1, g, 0, lane, E0, E1, F0, F1, rc0, ch0, cp0, Z1, Z2);
        rgc_store<0>(io, stg, Z1, Z2, g, rowbase, lane);
        __builtin_amdgcn_sched_barrier(0);
        rgc_block<false, 1>(io, gwl, af, g2, g3, g, 0, lane, E0, E1, F0, F1, rc1, ch1, cp1, Z1, Z2);
        __builtin_amdgcn_sched_barrier(0);
        rgc_store<1>(io, stg, Z1, Z2, g, rowbase, lane);
    }
    if (hi == 0) { const size_t o = ((size_t)bu * 16 + c) * LRU + g * 64 + cl;
        ((GAS float*)io.suma)[o] = cp0; ((GAS float*)io.sumh)[o] = ch0; ((GAS float*)io.suma)[o + 32] = cp1; ((GAS float*)io.sumh)[o + 32] = ch1; }
    if (c == 15) {
#pragma unroll
        for (int j = 0; j < 3; ++j) { const unsigned short xv = ((const GAS bf16*)io.proj)[(size_t)(bu * SEQ + SEQ - 3 + j) * NIN + 1536 + g * 64 + lane];
            ((GAS float*)io.out)[OFF_NCP + ((size_t)bu * 3 + j) * LRU + g * 64 + lane] = __uint_as_float((unsigned)xv << 16); }
    }
}

template <int NP> struct CmbIn { float ls[NP]; v4u o[NP]; v4u y1, y2; };
template <int NP>
__device__ __forceinline__ void combine_load(CmbIn<NP>& in, const bf16* ob, const float* lse, size_t pstride_rows, size_t row, const bf16* y2_row, const bf16* mixed_row, int lane) {
    const int h = lane >> 3;
#pragma unroll
    for (int p = 0; p < NP; ++p) { in.ls[p] = ((const GAS float*)lse)[(p * pstride_rows + row) * 8 + h]; in.o[p] = *(const GAS v4u*)((const GAS bf16*)ob + (p * pstride_rows + row) * ATT + 8 * lane); }
    in.y1 = *(const GAS v4u*)((const GAS bf16*)mixed_row + ATT + 8 * lane);
    in.y2 = *(const GAS v4u*)((const GAS bf16*)y2_row + 8 * lane);
}
template <int NP>
__device__ __forceinline__ void combine_finish(const CmbIn<NP>& in, const f32x4 g0, const f32x4 g1, const f32x4 r0, const f32x4 r1, const float (&hin8)[8], bf16* mixed_row, int lane) {
    float mx = NEGV;
#pragma unroll
    for (int p = 0; p < NP; ++p) mx = fmaxf(mx, in.ls[p]);
    float acc[8], wsum = 0.f;
#pragma unroll
    for (int i = 0; i < 8; ++i) acc[i] = 0.f;
#pragma unroll
    for (int p = 0; p < NP; ++p) { const float wgt = ex2(in.ls[p] - mx); wsum += wgt; const v4u o = in.o[p];
        acc[0] += wgt * bflo(o.x); acc[1] += wgt * bfhi(o.x); acc[2] += wgt * bflo(o.y); acc[3] += wgt * bfhi(o.y);
        acc[4] += wgt * bflo(o.z); acc[5] += wgt * bfhi(o.z); acc[6] += wgt * bflo(o.w); acc[7] += wgt * bfhi(o.w); }
    const v4u y1 = in.y1, y2 = in.y2;
    float rn[8];
    rn[0] = bflo(y1.x) + bflo(y2.x) * hin8[0]; rn[1] = bfhi(y1.x) + bfhi(y2.x) * hin8[1]; rn[2] = bflo(y1.y) + bflo(y2.y) * hin8[2]; rn[3] = bfhi(y1.y) + bfhi(y2.y) * hin8[3];
    rn[4] = bflo(y1.z) + bflo(y2.z) * hin8[4]; rn[5] = bfhi(y1.z) + bfhi(y2.z) * hin8[5]; rn[6] = bflo(y1.w) + bflo(y2.w) * hin8[6]; rn[7] = bfhi(y1.w) + bfhi(y2.w) * hin8[7];
    const float iw = 1.0f / wsum; float ss = 0.f, sr = 0.f;
#pragma unroll
    for (int i = 0; i < 8; ++i) { acc[i] *= iw; ss += acc[i] * acc[i]; sr += rn[i] * rn[i]; }
    const float rstd = 1.0f / sqrtf(wave_sum(ss) * (1.0f / ATT) + NORM_EPS);
    const float rstdr = 1.0f / sqrtf(wave_sum(sr) * (1.0f / LRU) + NORM_EPS);
    v4u w; w.x = cvtpk(acc[0] * rstd * g0[0], acc[1] * rstd * g0[1]); w.y = cvtpk(acc[2] * rstd * g0[2], acc[3] * rstd * g0[3]);
    w.z = cvtpk(acc[4] * rstd * g1[0], acc[5] * rstd * g1[1]); w.w = cvtpk(acc[6] * rstd * g1[2], acc[7] * rstd * g1[3]);
    *(GAS v4u*)((GAS bf16*)mixed_row + 8 * lane) = w;
    v4u z; z.x = cvtpk(rn[0] * rstdr * r0[0], rn[1] * rstdr * r0[1]); z.y = cvtpk(rn[2] * rstdr * r0[2], rn[3] * rstdr * r0[3]);
    z.z = cvtpk(rn[4] * rstdr * r1[0], rn[5] * rstdr * r1[1]); z.w = cvtpk(rn[6] * rstdr * r1[2], rn[7] * rstdr * r1[3]);
    *(GAS v4u*)((GAS bf16*)mixed_row + ATT + 8 * lane) = z;
}
template <int NP>
__device__ __forceinline__ void combine_row(const bf16* ob, const float* lse, size_t pstride_rows, size_t row, const float* attg, const float* rnng, const bf16* y2_row, const float (&hin8)[8], bf16* mixed_row, int lane) {
    CmbIn<NP> in; combine_load<NP>(in, ob, lse, pstride_rows, row, y2_row, mixed_row, lane);
    const f32x4 g0 = *(const GAS f32x4*)((const GAS float*)attg + 8 * lane), g1 = *(const GAS f32x4*)((const GAS float*)attg + 8 * lane + 4);
    const f32x4 r0 = *(const GAS f32x4*)((const GAS float*)rnng + 8 * lane), r1 = *(const GAS f32x4*)((const GAS float*)rnng + 8 * lane + 4);
    combine_finish<NP>(in, g0, g1, r0, r1, hin8, mixed_row, lane);
}
__device__ __forceinline__ void combine_run(const bf16* ob, const float* lse, const float* attg, const float* rnng, const bf16* y2, const float* suma, const float* sumh, bf16* mixed, float* out, int run, int lane) {
    const int row0 = run * 16, b = row0 >> 11, c = (row0 >> 7) & 15;
    float hin[8];
#pragma unroll
    for (int i = 0; i < 8; ++i) hin[i] = 0.f;
    const GAS float* pa = (const GAS float*)suma + (size_t)b * 16 * LRU + 8 * lane; const GAS float* ph = (const GAS float*)sumh + (size_t)b * 16 * LRU + 8 * lane;
#pragma unroll 1
    for (int c0 = 0; c0 < c; c0 += 8) {
        f32x4 a0[8], a1[8], h0[8], h1[8];
#pragma unroll
        for (int u = 0; u < 8; ++u) { const int cc = c0 + u < 16 ? c0 + u : 15;
            a0[u] = *(const GAS f32x4*)(pa + cc * LRU); a1[u] = *(const GAS f32x4*)(pa + cc * LRU + 4); h0[u] = *(const GAS f32x4*)(ph + cc * LRU); h1[u] = *(const GAS f32x4*)(ph + cc * LRU + 4); }
#pragma unroll
        for (int u = 0; u < 8; ++u) { if (c0 + u < c) {
#pragma unroll
            for (int i = 0; i < 4; ++i) { hin[i] = a0[u][i] * hin[i] + h0[u][i]; hin[4 + i] = a1[u][i] * hin[4 + i] + h1[u][i]; } } }
    }
    for (int r = 0; r < 16; ++r) { const size_t row = (size_t)row0 + r;
        combine_row<3>(ob, lse, (size_t)MT, row, attg, rnng, y2 + row * LRU, hin, mixed + row * DM, lane); }
    if ((row0 & (SEQ - 1)) == SEQ - 16) {
        const f32x4 a0 = *(const GAS f32x4*)(pa + 15 * LRU), a1 = *(const GAS f32x4*)(pa + 15 * LRU + 4), h0 = *(const GAS f32x4*)(ph + 15 * LRU), h1 = *(const GAS f32x4*)(ph + 15 * LRU + 4);
        f32x4 o0, o1;
#pragma unroll
        for (int i = 0; i < 4; ++i) { o0[i] = a0[i] * hin[i] + h0[i]; o1[i] = a1[i] * hin[4 + i] + h1[i]; }
        GAS float* po = (GAS float*)out + OFF_NHP + (size_t)b * LRU + 8 * lane; *(GAS f32x4*)po = o0; *(GAS f32x4*)(po + 4) = o1;
    }
}

template <int NR>
__device__ __forceinline__ void final_norm_rows(const bf16* xb, float* y, const float* g, int m0, int stride, int lane) {
    v2u v[NR][4];
#pragma unroll
    for (int r = 0; r < NR; ++r) { const int m = m0 + r * stride; const int mc = m < MP ? m : MP - 1; const GAS v2u* xr = (const GAS v2u*)(xb + (size_t)mc * DM) + lane;
#pragma unroll
        for (int j = 0; j < 4; ++j) v[r][j] = xr[64 * j]; }
    const GAS f32x4* gr = (const GAS f32x4*)g + lane;
    f32x4 gg[4];
#pragma unroll
    for (int j = 0; j < 4; ++j) gg[j] = gr[64 * j];
#pragma unroll
    for (int r = 0; r < NR; ++r) { const int m = m0 + r * stride;
        f32x4 a[4]; float s = 0.f;
#pragma unroll
        for (int j = 0; j < 4; ++j) { a[j] = (f32x4){bflo(v[r][j].x), bfhi(v[r][j].x), bflo(v[r][j].y), bfhi(v[r][j].y)}; s += (a[j].x * a[j].x + a[j].y * a[j].y) + (a[j].z * a[j].z + a[j].w * a[j].w); }
        const float rstd = 1.0f / sqrtf(wave_sum(s) * (1.f / DM) + NORM_EPS);
        if (m < MP) { GAS f32x4* yr = (GAS f32x4*)(y + (size_t)m * DM) + lane;
#pragma unroll
            for (int j = 0; j < 4; ++j) __builtin_nontemporal_store(a[j] * rstd * gg[j], yr + 64 * j); } }
}
__device__ __forceinline__ void final_norm_sample_row(const bf16* xb, float* y, const float* slab, const float* g, int rs, int lane) {
    GAS f32x4* yr = (GAS f32x4*)(y + (size_t)(MP + rs) * DM) + lane; const GAS f32x4* gr = (const GAS f32x4*)g + lane;
    const GAS v2u* xr = (const GAS v2u*)(xb + (size_t)(MP + rs) * DM) + lane;
    f32x4 v[4];
#pragma unroll
    for (int j = 0; j < 4; ++j) { const v2u w = xr[64 * j]; v[j] = (f32x4){bflo(w.x), bfhi(w.x), bflo(w.y), bfhi(w.y)}; }
#pragma unroll 4
    for (int s = 0; s < 16; ++s) { const GAS f32x4* sp = (const GAS f32x4*)(slab + ((size_t)s * MS + rs) * DM) + lane;
#pragma unroll
        for (int j = 0; j < 4; ++j) v[j] += sp[64 * j]; }
    float sm = 0.f;
#pragma unroll
    for (int j = 0; j < 4; ++j) sm += (v[j].x * v[j].x + v[j].y * v[j].y) + (v[j].z * v[j].z + v[j].w * v[j].w);
    const float rstd = 1.0f / sqrtf(wave_sum(sm) * (1.f / DM) + NORM_EPS);
#pragma unroll
    for (int j = 0; j < 4; ++j) yr[64 * j] = v[j] * rstd * gr[64 * j];
}

#ifndef REP_P0
#define REP_P0 1
#endif
#ifndef REP_BAR
#define REP_BAR 0
#endif
#ifndef REP_PA
#define REP_PA 1
#endif
#ifndef P6_AUXA
#define P6_AUXA 0
#endif
#ifndef PA_DUMMY
#define PA_DUMMY 0
#endif
#ifndef REP_SA
#define REP_SA 1
#endif
#ifndef REP_RG
#define REP_RG 1
#endif
#ifndef REP_P7
#define REP_P7 1
#endif
#ifndef REP_CMB
#define REP_CMB 1
#endif
#ifndef REP_P1
#define REP_P1 1
#endif
#ifndef REP_P4
#define REP_P4 1
#endif
#ifndef REP_P5
#define REP_P5 1
#endif

#ifdef SK_PA
#define DO_PA(x)
#else
#define DO_PA(x) x
#endif
#ifdef SK_RA
#define DO_RA(x)
#else
#define DO_RA(x) x
#endif
#ifdef SK_SA
#define DO_SA(x)
#else
#define DO_SA(x) x
#endif
#ifdef SK_RB
#define DO_RB(x)
#else
#define DO_RB(x) x
#endif
#ifdef SK_RBS
#define DO_RBS(x)
#else
#define DO_RBS(x) x
#endif
#ifdef SK_GEMM
#define DO_GEMM if (0)
#else
#define DO_GEMM
#endif

struct Args { const float* in[23]; float* out; unsigned char* ws; };
constexpr int NWAVES = 8;
__global__ void __launch_bounds__(NWAVES * 64, 2) hymba_fwd(Args args) {
    extern __shared__ __attribute__((aligned(16))) unsigned char lds_raw[];
    LAS unsigned char* lds = (LAS unsigned char*)lds_raw;
    volatile LAS unsigned* MISC = (volatile LAS unsigned*)(lds + MISC_OFF);
    const int tid = threadIdx.x, lane = tid & 63, wave = __builtin_amdgcn_readfirstlane(tid >> 6);
    const int G = gridDim.x; const int bx = blockIdx.x; const int vcu = (G % 8 == 0) ? (bx % 8) * (G / 8) + bx / 8 : bx;
    const int gw = vcu * NWAVES + wave, NGW = G * NWAVES;
    unsigned char* ws = args.ws;
    gu32* ctl = (gu32*)(ws + WS_CTL);
    const float* x_prompt = args.in[0]; const float* x_sample = args.in[1]; const float* cache_k = args.in[2]; const float* cache_v = args.in[3];
    const float* state_conv = args.in[4]; const float* state_h = args.in[5]; const float* norm1_g = args.in[6]; const float* w_in = args.in[7];
    const float* rel_bias = args.in[8]; const float* conv_w = args.in[9]; const float* conv_b = args.in[10]; const float* gate_a_w = args.in[11];
    const float* gate_a_b = args.in[12]; const float* gate_x_w = args.in[13]; const float* gate_x_b = args.in[14]; const float* lru_lambda = args.in[15];
    const float* att_out_g = args.in[16]; const float* rnn_out_g = args.in[17]; const float* w_out = args.in[18]; const float* norm2_g = args.in[19];
    const float* w_mlp_in = args.in[20]; const float* w_mlp_out = args.in[21]; const float* final_g = args.in[22];
    float* out = args.out;
    bf16* Win_t = (bf16*)(ws + WS_WIN); bf16* Wout_t = (bf16*)(ws + WS_WOUT); bf16* W1_t = (bf16*)(ws + WS_W1); bf16* W2_t = (bf16*)(ws + WS_W2); bf16* GW = (bf16*)(ws + WS_GW);
    float* SS1 = (float*)(ws + WS_SS1); float* SUMA = (float*)(ws + WS_SUMA); float* SUMH = (float*)(ws + WS_SUMH); bf16* Y2B = (bf16*)(ws + WS_Y2); float* SLAB = (float*)(ws + WS_SLAB);
    float* LSE = (float*)(ws + WS_LSE); float* LSES = (float*)(ws + WS_LSES); bf16* OBS = (bf16*)(ws + WS_OBS); bf16* OB = (bf16*)(ws + WS_OB);
    bf16* XN = (bf16*)(ws + WS_XN); bf16* PROJ = (bf16*)(ws + WS_PROJ); bf16* MIXED = (bf16*)(ws + WS_MIXED); bf16* X1B = (bf16*)(ws + WS_X1B); bf16* HB = (bf16*)(ws + WS_HB);

    for (int u = tid; u < (LDS_BYTES - LDSCTL_OFF) / 4; u += NWAVES * 64) ((LAS unsigned*)(lds + LDSCTL_OFF))[u] = 0u;
    __syncthreads();
    XcdBarrier bar = xcd_barrier_post((unsigned*)(ctl + CW_BAR), MISC + 8);

    for (int rep_ = 0; rep_ < REP_P0; ++rep_) {
        const int lane0 = lane_id_now();
        LAS float* scr = (LAS float*)(lds + RING_OFF + wave * 16384);
        constexpr int I_IN = (DM / 64) * (NIN / 32), I_O = (DM / 64) * (DM / 32), I_1 = (DM / 64) * (FF / 32), I_2 = (FF / 64) * (DM / 32);
        constexpr int NITEMS = I_IN + I_O + I_1 + I_2;
        for (int it = gw; it < NITEMS; it += NGW) {
            int r = it;
            if (r < I_IN) { p0_transpose_item(w_in, nullptr, DM, NIN, Win_t, scr, r, lane0); continue; } r -= I_IN;
            if (r < I_O) { p0_transpose_item(w_out, nullptr, DM, DM, Wout_t, scr, r, lane0); continue; } r -= I_O;
            if (r < I_1) { p0_transpose_item(w_mlp_in, norm2_g, DM, FF, W1_t, scr, r, lane0); continue; } r -= I_1;
            p0_transpose_item(w_mlp_out, nullptr, FF, DM, W2_t, scr, r, lane0);
        }
        for (int idx = gw * 64 + lane0; idx < 2 * 8 * 64 * 64; idx += NGW * 64) {
            const int mat = idx >> 15, g = (idx >> 12) & 7, o = (idx >> 6) & 63, i = idx & 63;
            const float v = (mat ? gate_x_w : gate_a_w)[g * 4096 + i * 64 + o];
            GW[idx] = (bf16)(cvtpk(v, v) & 0xffffu);
        }
        for (int idx = gw * 64 + lane0; idx < (DECB + 1) * 3 * LRU; idx += NGW * 64) { const float v = idx < DECB * 3 * LRU ? state_conv[idx] : 0.f; ((bf16*)(ws + WS_XRS))[idx] = (bf16)(cvtpk(v, v) & 0xffffu); }
        for (int m0 = gw; m0 < MT; m0 += 4 * NGW) rms_rows_to_bf16<4>(x_prompt, x_sample, norm1_g, XN, m0, NGW, lane0);
    }
    xcd_barrier(bar);

    {
        pg8::Gemm g{XN, Win_t, MT, NIN, DM}; pg8::StaticOrder S; S.init(MT, NIN, G, bx);
        pg8::EpiInProj E{PROJ, out, QSCALE};
        for (int rep_ = 0; rep_ < REP_P1; ++rep_) { DO_GEMM pg8::gemm_phase<pg8::EpiInProj, pg8::StaticOrder, true, true>(lds + RING_OFF, g, S, E); }
    }
    xcd_barrier(bar);

    {
        const int rgg = vcu & 7;
        build_tables(lds, rel_bias, conv_w, conv_b, GW, rgg, tid);
        __syncthreads();
        const LAS float* btab = (const LAS float*)(lds + BT_OFF); const LAS float* tabS = (const LAS float*)(lds + TS_OFF);
        const LAS float* cw = (const LAS float*)(lds + CW_OFF); const LAS float* cb = (const LAS float*)(lds + CB_OFF);
        const RgIo io{PROJ, ws, state_h, gate_a_b, gate_x_b, lru_lambda, GW, MIXED, Y2B, SUMA, SUMH, out};
        const int sagrp = gw % 3;
#define SA_PASS() do { for (int rep_ = 0; rep_ < REP_SA; ++rep_) for (int id = gw; id < 4096; id += NGW) sa_task(PROJ, cache_k, cache_v, OBS, LSES, tabS, lds + STG_OFF + wave * 4096, id, lane); } while (0)
#define PA_PASS(lo, hi) do { for (int rep_ = 0; rep_ < REP_PA; ++rep_) for (int id = gw + (lo) * NGW; id < 24576 && id < (hi); id += NGW) \
        pa_task(PROJ, rep_ ? (bf16*)HB : OB, rep_ ? (float*)(HB + (size_t)MT * 2048) : LSE, btab, lds + STG_OFF + wave * 4096, id, lane, rep_ ? PA_DUMMY : 0); } while (0)
        if (sagrp == 0) SA_PASS();
        PA_PASS(0, gw + 6 * NGW);
        if (sagrp == 1) SA_PASS();
        PA_PASS(6, 24576);
        { const LAS unsigned char* gwl = lds + GWL_OFF;
          for (int rep_ = 0; rep_ < REP_RG; ++rep_) { for (int bc = (vcu >> 3) * NWAVES + wave; bc < 256; bc += (G >> 3) * NWAVES) rgp_task(io, cw, cb, gwl, lds + STG_OFF + wave * 4096, lds + HAL_OFF + wave * 1024, rgg, bc, lane);
              if (wave == NWAVES - 1) for (int bc = vcu >> 3; bc < 32; bc += (G >> 3)) rgc_task<true>(io, cw, cb, gwl, lds + STG_OFF + wave * 4096, rgg, bc, lane); } }
        if (sagrp == 2) SA_PASS();
#undef SA_PASS
#undef PA_PASS
    }
    xcd_barrier(bar);

    for (int rep_ = 0; rep_ < REP_BAR; ++rep_) xcd_barrier(bar);
    for (int rep_ = 0; rep_ < REP_CMB; ++rep_) {
        const int lane3 = lane_id_now();
        for (int run = gw; run < MP / 16; run += NGW) combine_run(OB, LSE, att_out_g, rnn_out_g, Y2B, SUMA, SUMH, MIXED, out, run, lane3);
        const float hz[8] = {0.f, 0.f, 0.f, 0.f, 0.f, 0.f, 0.f, 0.f};
        for (int rs = gw; rs < MS; rs += NGW) combine_row<4>(OBS, LSES, (size_t)MS, (size_t)rs, att_out_g, rnn_out_g, Y2B + (size_t)(MP + rs) * LRU, hz, MIXED + (size_t)(MP + rs) * DM, lane3);
    }
    xcd_barrier(bar);

    {
        pg8::Gemm g{MIXED, Wout_t, MT, DM, DM}; pg8::StaticOrder S; S.init(MT, DM, G, bx);
        pg8::EpiWout E{x_prompt, x_sample, X1B, SS1};
        for (int rep_ = 0; rep_ < REP_P4; ++rep_) { DO_GEMM pg8::gemm_phase<pg8::EpiWout, pg8::StaticOrder, true, true>(lds + RING_OFF, g, S, E); }
    }
    xcd_barrier(bar);

    {
        pg8::Gemm g{X1B, W1_t, MT, FF, DM}; pg8::StaticOrder S; S.init(MT, FF, G, bx);
        pg8::EpiUp E{HB, SS1};
        for (int rep_ = 0; rep_ < REP_P5; ++rep_) { DO_GEMM pg8::gemm_phase<pg8::EpiUp, pg8::StaticOrder, true, true>(lds + RING_OFF, g, S, E); }
    }
    xcd_barrier(bar);

    {
        { pg8::Gemm g{HB, W2_t, MP, DM, FF}; pg8::StaticOrder S; S.init(MP, DM, G, bx);
          pg8::EpiDown E{X1B};
          DO_GEMM pg8::gemm_phase<pg8::EpiDown, pg8::StaticOrder, true, true>(lds + RING_OFF, g, S, E); }
        __syncthreads();
        { pg8::Gemm g2{(const bf16*)(args.ws + WS_HB), (const bf16*)(args.ws + WS_W2), MT, DM, 256, FF}; const pg8::SplitKOrder S2{(int)gridDim.x, (int)blockIdx.x, 16};
          pg8::EpiSlab E2{(float*)(args.ws + WS_SLAB)};
          DO_GEMM pg8::gemm_phase<pg8::EpiSlab, pg8::SplitKOrder, true, true>(lds + RING_OFF, g2, S2, E2); }
    }
    xcd_barrier(bar);

    for (int rep7_ = 0; rep7_ < REP_P7; ++rep7_) {
    const int lane7 = lane_id_now();
    for (int m0 = gw; m0 < MP; m0 += 8 * NGW) final_norm_rows<8>(X1B, out + OFF_Y, final_g, m0, NGW, lane7);
    for (int rs = NGW - 1 - gw; rs < MS; rs += NGW) final_norm_sample_row(X1B, out + OFF_Y, SLAB, final_g, rs, lane7);
    }
}

extern "C" void kernel_launch(void* const* d_in, const int* in_sizes, int n_in, void* d_out, int out_size, void* d_ws, size_t ws_size, hipStream_t stream) {
    static int grid = 0;
    if (grid == 0) {
        if (n_in != 23 || in_sizes[0] != MP * DM || (size_t)out_size != OUT_TOTAL || ws_size < WS_END) {
            fprintf(stderr, "kernel_launch: shape mismatch: n_in %d in0 %d out %d ws %zu (need %zu); nothing launched\n", n_in, n_in > 0 ? in_sizes[0] : -1, out_size, ws_size, (size_t)WS_END); grid = -1; return; }
        int dev = 0, cus = 0, per_cu = 0;
        if (hipGetDevice(&dev) != hipSuccess || hipDeviceGetAttribute(&cus, hipDeviceAttributeMultiprocessorCount, dev) != hipSuccess) { fprintf(stderr, "kernel_launch: device query failed\n"); grid = -1; return; }
        if (hipFuncSetAttribute((const void*)hymba_fwd, hipFuncAttributeMaxDynamicSharedMemorySize, LDS_BYTES) != hipSuccess) { fprintf(stderr, "kernel_launch: hipFuncSetAttribute failed\n"); grid = -1; return; }
        if (hipOccupancyMaxActiveBlocksPerMultiprocessor(&per_cu, (const void*)hymba_fwd, NWAVES * 64, LDS_BYTES) != hipSuccess || per_cu < 1)
            fprintf(stderr, "kernel_launch: note: occupancy query reports %d workgroups per CU\n", per_cu);
        (void)hipGetLastError();
        grid = cus;
    }
    if (grid < 0) return;
    if (hipMemsetAsync((char*)d_ws + WS_CTL, 0, CTL_ZERO_BYTES, stream) != hipSuccess) { fprintf(stderr, "kernel_launch: memset failed\n"); return; }
    Args a{};
    for (int i = 0; i < 23; ++i) a.in[i] = (const float*)d_in[i];
    a.out = (float*)d_out; a.ws = (unsigned char*)d_ws;
    hipLaunchKernelGGL(hymba_fwd, dim3(grid), dim3(NWAVES * 64), LDS_BYTES, stream, a);
    const hipError_t le = hipPeekAtLastError();
    if (le != hipSuccess) fprintf(stderr, "kernel_launch: launch failed: %s\n", hipGetErrorName(le));
}
```

```cpp
#include <hip/hip_runtime.h>
#include <cstdio>
#include <cstdint>

constexpr int DM = 1024, NB = 16, SEQ = 2048, DECB = 128, DECT = 8, NH = 8, HD = 64, ATT = 512, LRU = 512, FF = 4096, NIN = 2560;
constexpr int MP = NB * SEQ;
constexpr int MS = DECB * DECT;
constexpr int MT = MP + MS;
constexpr int NCACHE = 2048;
constexpr float NORM_EPS = 1e-6f;
constexpr float NEGV = -1e30f;
constexpr float LOG2E = 1.4426950408889634f;
constexpr float QSCALE = 0.125f * LOG2E;
constexpr size_t OFF_Y = 0;
constexpr size_t OFF_NKP = (size_t)MT * DM;
constexpr size_t OFF_NVP = OFF_NKP + (size_t)MP * ATT;
constexpr size_t OFF_NCP = OFF_NVP + (size_t)MP * ATT;
constexpr size_t OFF_NHP = OFF_NCP + (size_t)NB * 3 * LRU;
constexpr size_t OFF_NKS = OFF_NHP + (size_t)NB * LRU;
constexpr size_t OFF_NVS = OFF_NKS + (size_t)MS * ATT;
constexpr size_t OFF_NCS = OFF_NVS + (size_t)MS * ATT;
constexpr size_t OFF_NHS = OFF_NCS + (size_t)DECB * 3 * LRU;
constexpr size_t OUT_TOTAL = OFF_NHS + (size_t)DECB * LRU;
static_assert(OUT_TOTAL == 69500928, "output size");

namespace pg8 {
#define PG8_LAS __attribute__((address_space(3)))
typedef unsigned short bf16_t;
typedef short bf16x8 __attribute__((ext_vector_type(8)));
typedef float f32x4 __attribute__((ext_vector_type(4)));
typedef unsigned u32x4 __attribute__((ext_vector_type(4)));
constexpr int BM = 256, BK = 64, HALF = 128, HTB = HALF * BK * 2  , STAGE_BYTES = 8 * HTB, NXCD = 8, WGM = 8;

__host__ __device__ __forceinline__ int lds_byte(int r, int c) { const int st = (r >> 4) * 2 + (c >> 5), rr = r & 15, cc = c & 31, ob = rr * 64 + cc * 2; return st * 1024 + (ob ^ (((ob >> 9) & 1) << 5)); }
__host__ __device__ __forceinline__ void stage_rc(int b, int& R, int& C) { const int st = b / 1024, sb = b % 1024, swz = sb ^ (((sb >> 9) & 1) << 5); R = (st >> 1) * 16 + swz / 64; C = (st & 1) * 32 + (swz % 64) / 2; }
__host__ __device__ __forceinline__ int perm32(int rho) { const int n = rho >> 4, i = rho & 15; return 8 * (i >> 2) + 4 * n + (i & 3); }

struct Unit { int pm, pn; int ko = 0; };
struct Gemm { const bf16_t* A; const bf16_t* Bt; int M, N, K; int ld = 0; };

struct StaticOrder {
    int nM, nN, nwg, G, c;
    __host__ __device__ void init(int M, int N, int G_, int c_) { nM = M / BM; nN = N / BM; nwg = nM * nN; G = G_; c = c_; }
    __host__ __device__ bool next(int i, Unit& u) const {
        const long L = (long)i * G + c; if (L >= nwg) return false;
        int wgid = (int)L; { const int q = nwg / NXCD, r = nwg % NXCD, xcd = wgid % NXCD, off = wgid / NXCD; wgid = (xcd < r ? xcd * (q + 1) : r * (q + 1) + (xcd - r) * q) + off; }
        const int nig = WGM * nN, gid = wgid / nig, fm = gid * WGM, gsz = (nM - fm) < WGM ? (nM - fm) : WGM;
        u.pm = fm + ((wgid % nig) % gsz); u.pn = (wgid % nig) / gsz; return true;
    }
    __device__ __forceinline__ void a_ready(const Unit&) const {}
    __device__ __forceinline__ void done(const Unit&) const {}
};

__device__ __forceinline__ unsigned cvt_pk_bf16(float lo, float hi) { unsigned r; asm volatile("v_cvt_pk_bf16_f32 %0, %1, %2" : "=v"(r) : "v"(lo), "v"(hi)); return r; }
__device__ __forceinline__ u32x4 pack8(const f32x4 v0, const f32x4 v1) { u32x4 w; w.x = cvt_pk_bf16(v0[0], v0[1]); w.y = cvt_pk_bf16(v0[2], v0[3]); w.z = cvt_pk_bf16(v1[0], v1[1]); w.w = cvt_pk_bf16(v1[2], v1[3]); return w; }

struct EpiInProj {
    static constexpr bool PERM = true, AFTER_DRAIN = false;
    bf16_t* proj; float* out; float qscale;
    __device__ __forceinline__ void operator()(const f32x4 (&acc)[2][2][4][2], const Unit& u, int wr, int wc, int fr, int fq) const {
        const int row0 = u.pm * BM + wr * 64 + fr, col0 = u.pn * BM + wc * 32 + 8 * fq;
        const int kind = u.pn >> 1;
        const float sc = (kind == 0) ? qscale : 1.f;
        float* fdst = nullptr;
        const bool smp = u.pm >= (MP / BM);
        if (smp && (kind == 1 || kind == 2)) {
            const size_t off = smp ? (kind == 1 ? OFF_NKS : OFF_NVS) : (kind == 1 ? OFF_NKP : OFF_NVP);
            const int frow = smp ? row0 - MP : row0;
            fdst = out + off + (size_t)frow * ATT + (col0 - kind * ATT);
        }
#pragma unroll
        for (int ai = 0; ai < 2; ++ai)
#pragma unroll
            for (int m = 0; m < 4; ++m) { bf16_t* rowp = proj + (size_t)(row0 + ai * HALF + m * 16) * NIN + col0;
#pragma unroll
                for (int bj = 0; bj < 2; ++bj) { const f32x4 v0 = acc[ai][bj][m][0] * sc, v1 = acc[ai][bj][m][1] * sc;
                    *(u32x4*)(rowp + bj * HALF) = pack8(v0, v1);
                    if (fdst) { float* fp = fdst + (size_t)(ai * HALF + m * 16) * ATT + bj * HALF; *(f32x4*)fp = v0; *(f32x4*)(fp + 4) = v1; } } }
    }
};
struct EpiWout {
    static constexpr bool PERM = true, AFTER_DRAIN = false;
    const float* xp; const float* xs; bf16_t* x1b; float* ss1;
    __device__ __forceinline__ void operator()(const f32x4 (&acc)[2][2][4][2], const Unit& u, int wr, int wc, int fr, int fq) const {
        const int row0 = u.pm * BM + wr * 64 + fr, col0 = u.pn * BM + wc * 32 + 8 * fq;
        const float* xin = (u.pm >= (MP / BM)) ? xs + (size_t)(row0 - MP) * DM : xp + (size_t)row0 * DM;
#pragma unroll
        for (int ai = 0; ai < 2; ++ai)
#pragma unroll
            for (int m = 0; m < 4; ++m) { const int dr = ai * HALF + m * 16; const float* xr = xin + (size_t)dr * DM + col0; bf16_t* br = x1b + (size_t)(row0 + dr) * DM + col0;
                float ss = 0.f;
#pragma unroll
                for (int bj = 0; bj < 2; ++bj) { const f32x4 a0 = *(const f32x4*)(xr + bj * HALF), a1 = *(const f32x4*)(xr + bj * HALF + 4);
                    const f32x4 v0 = acc[ai][bj][m][0] + a0, v1 = acc[ai][bj][m][1] + a1;
                    *(u32x4*)(br + bj * HALF) = pack8(v0, v1);
                    ss += (v0[0] * v0[0] + v0[1] * v0[1]) + (v0[2] * v0[2] + v0[3] * v0[3]) + (v1[0] * v1[0] + v1[1] * v1[1]) + (v1[2] * v1[2] + v1[3] * v1[3]); }
                ss += __shfl_xor(ss, 16); ss += __shfl_xor(ss, 32);
                if (fq == 0) ss1[(size_t)(row0 + dr) * 16 + u.pn * 4 + wc] = ss; }
    }
};
struct EpiUp {
    static constexpr bool PERM = true, AFTER_DRAIN = false;
    bf16_t* hb; const float* ss1;
    __device__ __forceinline__ void operator()(const f32x4 (&acc)[2][2][4][2], const Unit& u, int wr, int wc, int fr, int fq) const {
        const int row0 = u.pm * BM + wr * 64 + fr, col0 = u.pn * BM + wc * 32 + 8 * fq;
        float rs2[2];
#pragma unroll
        for (int t = 0; t < 2; ++t) { const int r = row0 + (fq >> 1) * HALF + (2 * (fq & 1) + t) * 16; const f32x4* sp = (const f32x4*)(ss1 + (size_t)r * 16);
            const f32x4 s0 = sp[0], s1 = sp[1], s2 = sp[2], s3 = sp[3]; const f32x4 s = (s0 + s1) + (s2 + s3);
            rs2[t] = 1.0f / sqrtf(((s[0] + s[1]) + (s[2] + s[3])) * (1.0f / DM) + NORM_EPS); }
        float rstd[8];
#pragma unroll
        for (int e = 0; e < 8; ++e) rstd[e] = __shfl((e & 1) ? rs2[1] : rs2[0], (e >> 1) * 16 + fr);
#pragma unroll
        for (int ai = 0; ai < 2; ++ai)
#pragma unroll
            for (int m = 0; m < 4; ++m) { bf16_t* rowp = hb + (size_t)(row0 + ai * HALF + m * 16) * FF + col0; const float rs = rstd[ai * 4 + m];
#pragma unroll
                for (int bj = 0; bj < 2; ++bj) { f32x4 v0 = acc[ai][bj][m][0] * rs, v1 = acc[ai][bj][m][1] * rs;
#pragma unroll
                    for (int i = 0; i < 4; ++i) { const float a = fmaxf(v0[i], 0.f), b = fmaxf(v1[i], 0.f); v0[i] = a * a; v1[i] = b * b; }
                    *(u32x4*)(rowp + bj * HALF) = pack8(v0, v1); } }
    }
};
struct EpiDown {
    static constexpr bool PERM = true, AFTER_DRAIN = false;
    bf16_t* xb; bf16_t* xd;
    __device__ __forceinline__ void operator()(const f32x4 (&acc)[2][2][4][2], const Unit& u, int wr, int wc, int fr, int fq) const {
        const int row0 = u.pm * BM + wr * 64 + fr, col0 = u.pn * BM + wc * 32 + 8 * fq;
#pragma unroll
        for (int ai = 0; ai < 2; ++ai)
#pragma unroll
            for (int m = 0; m < 4; ++m) { const size_t ro = (size_t)(row0 + ai * HALF + m * 16) * DM + col0; bf16_t* yr = xd + ro;
#pragma unroll
                for (int bj = 0; bj < 2; ++bj) { const u32x4 w = *(const u32x4*)(xb + ro + bj * HALF);
                    const f32x4 a0 = {__uint_as_float(w.x << 16), __uint_as_float(w.x & 0xffff0000u), __uint_as_float(w.y << 16), __uint_as_float(w.y & 0xffff0000u)};
                    const f32x4 a1 = {__uint_as_float(w.z << 16), __uint_as_float(w.z & 0xffff0000u), __uint_as_float(w.w << 16), __uint_as_float(w.w & 0xffff0000u)};
                    *(u32x4*)(yr + bj * HALF) = pack8(acc[ai][bj][m][0] + a0, acc[ai][bj][m][1] + a1); } }
    }
};

struct EpiSlab {
    static constexpr bool PERM = false, AFTER_DRAIN = false;
    float* slab;
    __device__ __forceinline__ void operator()(const f32x4 (&acc)[2][2][4][2], const Unit& u, int wr, int wc, int fr, int fq) const {
        const int row0 = (u.pm - MP / BM) * BM + wr * 64 + fr, col0 = u.pn * BM + wc * 32 + 4 * fq;
        float* base = slab + (size_t)(u.ko >> 8) * MS * DM;
#pragma unroll
        for (int ai = 0; ai < 2; ++ai)
#pragma unroll
            for (int m = 0; m < 4; ++m) { float* yr = base + (size_t)(row0 + ai * HALF + m * 16) * DM + col0;
#pragma unroll
                for (int bj = 0; bj < 2; ++bj) { *(f32x4*)(yr + bj * HALF) = acc[ai][bj][m][0]; *(f32x4*)(yr + bj * HALF + 16) = acc[ai][bj][m][1]; } }
    }
};
struct SplitKOrder {
    int G, c, KS;
    __device__ __forceinline__ bool next(int i, Unit& u) const { const int L = i * G + c; if (L >= 16 * KS) return false; u.pn = L & 3; u.ko = ((L >> 2) % KS) * 256; u.pm = MP / BM + L / (4 * KS); return true; }
    __device__ __forceinline__ void a_ready(const Unit&) const {}
    __device__ __forceinline__ void done(const Unit&) const {}
};
struct RangeOrder {
    StaticOrder base; int L0, L1, step, c, pm_off;
    __device__ __forceinline__ bool next(int i, Unit& u) const { const int L = L0 + i * step + c; if (c < 0 || c >= step || L >= L1) return false;
        StaticOrder b = base; b.G = 1; b.c = L; if (!b.next(0, u)) return false; u.pm += pm_off; return true; }
    __device__ __forceinline__ void a_ready(const Unit&) const {}
    __device__ __forceinline__ void done(const Unit&) const {}
};


template <class Epi, class Sched, bool ALIGN_EPI = false, bool SP2 = false, int AUXA = 0>
__device__ __forceinline__ void gemm_phase(PG8_LAS unsigned char* lds, const Gemm g, const Sched& S, const Epi& E, const int wave_) {
    int tid_; asm volatile("v_mbcnt_lo_u32_b32 %0, -1, 0\n\tv_mbcnt_hi_u32_b32 %0, -1, %0" : "=v"(tid_)); tid_ += wave_ * 64;
    const int tid = tid_, wid = __builtin_amdgcn_readfirstlane(tid >> 6), lane = tid & 63, wr = wid >> 2, wc = wid & 3, fr = lane & 15, fq = lane >> 4;
    const int nt = g.K / BK, K = g.ld ? g.ld : g.K;
    unsigned voffA[2], voffB[2];
#pragma unroll
    for (int i = 0; i < 2; ++i) { int R, C; stage_rc(tid * 16 + i * 8192, R, C); const int Rb = Epi::PERM ? ((R & ~31) + perm32(R & 31)) : R;
        voffA[i] = (unsigned)(R * K + C) * 2u; voffB[i] = (unsigned)(Rb * K + C) * 2u; }
    const size_t kstep = (size_t)(BK * 2);
    const size_t hstep = (size_t)HALF * K * 2;
    const size_t tstep = 2 * hstep;
    const unsigned ldsw = (unsigned)wid * 1024u;
    const int aoff = lds_byte(wr * 64 + fr, fq * 8), boff = lds_byte(wc * 32 + fr, fq * 8);
#define PG8_SA(b, h) (((b) * 2 + (h)) * HTB)
#define PG8_SB(b, h) ((4 + (b) * 2 + (h)) * HTB)
#define PG8_STAGE(bufoff, gbase, voff) do { _Pragma("unroll") for (int _i = 0; _i < 2; ++_i) \
        __builtin_amdgcn_global_load_lds((const unsigned*)((const char*)(gbase) + (voff)[_i]), (PG8_LAS unsigned*)(lds + (bufoff) + ldsw + _i * 8192), 16, 0, 0); } while (0)
#define PG8_STAGEA(bufoff, gbase, voff) do { _Pragma("unroll") for (int _i = 0; _i < 2; ++_i) \
        __builtin_amdgcn_global_load_lds((const unsigned*)((const char*)(gbase) + (voff)[_i]), (PG8_LAS unsigned*)(lds + (bufoff) + ldsw + _i * 8192), 16, 0, AUXA); } while (0)
#define PG8_LDA(dst, b, h) do { _Pragma("unroll") for (int m = 0; m < 4; ++m) _Pragma("unroll") for (int k = 0; k < 2; ++k) dst[m][k] = *(const PG8_LAS bf16x8*)(lds + PG8_SA(b, h) + aoff + m * 2048 + k * 1024); } while (0)
#define PG8_LDB(dst, b, h) do { _Pragma("unroll") for (int n = 0; n < 2; ++n) _Pragma("unroll") for (int k = 0; k < 2; ++k) dst[n][k] = *(const PG8_LAS bf16x8*)(lds + PG8_SB(b, h) + boff + n * 2048 + k * 1024); } while (0)
#define PG8_MMA(ai, bj, At, Bt) do { __builtin_amdgcn_s_setprio(1); _Pragma("unroll") for (int m = 0; m < 4; ++m) _Pragma("unroll") for (int n = 0; n < 2; ++n) _Pragma("unroll") for (int k = 0; k < 2; ++k) \
        acc[ai][bj][m][n] = __builtin_amdgcn_mfma_f32_16x16x32_bf16(Bt[n][k], At[m][k], acc[ai][bj][m][n], 0, 0, 0); __builtin_amdgcn_s_setprio(0); } while (0)
#define PG8_WAIT_V(n) asm volatile("s_waitcnt vmcnt(" #n ")" ::: "memory")
#define PG8_WAIT_L(n) asm volatile("s_waitcnt lgkmcnt(" #n ")" ::: "memory")
#define PG8_BAR __builtin_amdgcn_s_barrier()
#define PG8_SCHED __builtin_amdgcn_sched_barrier(0)
    Unit cur, nxt; int ui = 0;
    if (!S.next(0, cur)) return;
    f32x4 acc[2][2][4][2];
#pragma unroll
    for (int a = 0; a < 2; ++a)
#pragma unroll
        for (int b = 0; b < 2; ++b)
#pragma unroll
            for (int m = 0; m < 4; ++m)
#pragma unroll
                for (int n = 0; n < 2; ++n) acc[a][b][m][n] = (f32x4){0.f, 0.f, 0.f, 0.f};
    bf16x8 At[4][2], B0[2][2], B1[2][2];
    const char* cA = (const char*)g.A + (size_t)cur.pm * tstep + (size_t)cur.ko * 2; const char* cB = (const char*)g.Bt + (size_t)cur.pn * tstep + (size_t)cur.ko * 2;
    S.a_ready(cur);
    if constexpr (SP2) {
        PG8_STAGE(PG8_SB(0, 0), cB, voffB); PG8_STAGE(PG8_SB(0, 1), cB + hstep, voffB); PG8_STAGEA(PG8_SA(0, 0), cA, voffA); PG8_STAGEA(PG8_SA(0, 1), cA + hstep, voffA);
        if (wr == 1) PG8_BAR;
        PG8_WAIT_V(2); PG8_BAR;
        PG8_STAGE(PG8_SB(1, 0), cB + kstep, voffB); PG8_STAGEA(PG8_SA(1, 0), cA + kstep, voffA); PG8_STAGE(PG8_SB(1, 1), cB + hstep + kstep, voffB);
        PG8_WAIT_V(6); PG8_BAR;
    } else {
        PG8_STAGE(PG8_SB(0, 0), cB, voffB); PG8_STAGEA(PG8_SA(0, 0), cA, voffA); PG8_STAGE(PG8_SB(0, 1), cB + hstep, voffB); PG8_STAGEA(PG8_SA(0, 1), cA + hstep, voffA);
        if (wr == 1) PG8_BAR;
        PG8_WAIT_V(4); PG8_BAR;
        PG8_STAGE(PG8_SB(1, 0), cB + kstep, voffB); PG8_STAGEA(PG8_SA(1, 0), cA + kstep, voffA); PG8_STAGE(PG8_SB(1, 1), cB + hstep + kstep, voffB);
        PG8_WAIT_V(6); PG8_BAR;
    }
    for (;;) {
        const bool has_next = S.next(ui + 1, nxt);
        const char* nA = has_next ? (const char*)g.A + (size_t)nxt.pm * tstep + (size_t)nxt.ko * 2 : cA; const char* nB = has_next ? (const char*)g.Bt + (size_t)nxt.pn * tstep + (size_t)nxt.ko * 2 : cB;
        for (int t = 0; t < nt; t += 2) {
            const bool last = (t == nt - 2);
            const char* a1 = cA + (size_t)(t + 1) * kstep;
            const char* a2 = last ? nA : cA + (size_t)(t + 2) * kstep; const char* b2 = last ? nB : cB + (size_t)(t + 2) * kstep;
            const char* a3 = a2 + kstep; const char* b3 = b2 + kstep;
            if (last && has_next) S.a_ready(nxt);
            if constexpr (SP2) {
            PG8_LDB(B0, 0, 0); PG8_LDB(B1, 0, 1); PG8_SCHED; PG8_LDA(At, 0, 0); PG8_STAGEA(PG8_SA(1, 1), a1 + hstep, voffA);
            PG8_WAIT_V(8); PG8_WAIT_L(0); PG8_BAR; PG8_MMA(0, 0, At, B0); PG8_MMA(0, 1, At, B1); PG8_BAR; PG8_SCHED;
            PG8_LDA(At, 0, 1); PG8_STAGE(PG8_SB(0, 0), b2, voffB); PG8_STAGE(PG8_SB(0, 1), b2 + hstep, voffB); PG8_STAGEA(PG8_SA(0, 0), a2, voffA);
            PG8_WAIT_V(8); PG8_WAIT_L(0); PG8_BAR; PG8_MMA(1, 0, At, B0); PG8_MMA(1, 1, At, B1); PG8_BAR; PG8_SCHED;
            PG8_LDB(B0, 1, 0); PG8_LDB(B1, 1, 1); PG8_SCHED; PG8_LDA(At, 1, 0); PG8_STAGEA(PG8_SA(0, 1), a2 + hstep, voffA);
            PG8_WAIT_V(8); PG8_WAIT_L(0); PG8_BAR; PG8_MMA(0, 0, At, B0); PG8_MMA(0, 1, At, B1); PG8_BAR; PG8_SCHED;
            PG8_LDA(At, 1, 1); PG8_STAGE(PG8_SB(1, 0), b3, voffB); PG8_STAGE(PG8_SB(1, 1), b3 + hstep, voffB); PG8_STAGEA(PG8_SA(1, 0), a3, voffA);
            PG8_WAIT_V(8); PG8_WAIT_L(0); PG8_BAR; PG8_MMA(1, 0, At, B0); PG8_MMA(1, 1, At, B1); PG8_BAR; PG8_SCHED;
            } else {
            PG8_LDB(B0, 0, 0); PG8_SCHED; PG8_LDA(At, 0, 0); PG8_STAGEA(PG8_SA(1, 1), a1 + hstep, voffA);
            PG8_WAIT_L(8); PG8_BAR; PG8_WAIT_L(0); PG8_MMA(0, 0, At, B0); PG8_BAR; PG8_SCHED;
            PG8_LDB(B1, 0, 1); PG8_STAGE(PG8_SB(0, 0), b2, voffB);
            PG8_BAR; PG8_WAIT_L(0); PG8_MMA(0, 1, At, B1); PG8_BAR;
            PG8_LDA(At, 0, 1); PG8_STAGEA(PG8_SA(0, 0), a2, voffA);
            PG8_BAR; PG8_WAIT_L(0); PG8_MMA(1, 0, At, B0); PG8_BAR; PG8_SCHED;
            PG8_STAGE(PG8_SB(0, 1), b2 + hstep, voffB);
            PG8_WAIT_V(6); PG8_BAR; PG8_MMA(1, 1, At, B1); PG8_BAR;
            PG8_LDB(B0, 1, 0); PG8_SCHED; PG8_LDA(At, 1, 0); PG8_STAGEA(PG8_SA(0, 1), a2 + hstep, voffA);
            PG8_WAIT_L(8); PG8_BAR; PG8_WAIT_L(0); PG8_MMA(0, 0, At, B0); PG8_BAR; PG8_SCHED;
            PG8_LDB(B1, 1, 1); PG8_STAGE(PG8_SB(1, 0), b3, voffB);
            PG8_BAR; PG8_WAIT_L(0); PG8_MMA(0, 1, At, B1); PG8_BAR;
            PG8_LDA(At, 1, 1); PG8_STAGEA(PG8_SA(1, 0), a3, voffA);
            PG8_BAR; PG8_WAIT_L(0); PG8_MMA(1, 0, At, B0); PG8_BAR; PG8_SCHED;
            PG8_STAGE(PG8_SB(1, 1), b3 + hstep, voffB);
            PG8_WAIT_V(6); PG8_BAR; PG8_MMA(1, 1, At, B1); PG8_BAR;
            }
        }
        if constexpr (ALIGN_EPI) { if (wr == 0) PG8_BAR; }
        if constexpr (!Epi::AFTER_DRAIN) { E(acc, cur, wr, wc, fr, fq); S.done(cur); }
        if (!has_next) break;
#pragma unroll
        for (int a = 0; a < 2; ++a)
#pragma unroll
            for (int b = 0; b < 2; ++b)
#pragma unroll
                for (int m = 0; m < 4; ++m)
#pragma unroll
                    for (int n = 0; n < 2; ++n) acc[a][b][m][n] = (f32x4){0.f, 0.f, 0.f, 0.f};
        cur = nxt; cA = nA; cB = nB; ++ui;
        if constexpr (ALIGN_EPI) { if (wr == 1) PG8_BAR; }
    }
    PG8_WAIT_V(0);
    if constexpr (!ALIGN_EPI) { if (wr == 0) PG8_BAR; }
    PG8_BAR;
    if constexpr (Epi::AFTER_DRAIN) { E.fused(acc, cur, wr, wc, fr, fq, lds, wid, lane); S.done(cur); }
#undef PG8_SA
#undef PG8_SB
#undef PG8_STAGE
#undef PG8_STAGEA
#undef PG8_LDA
#undef PG8_LDB
#undef PG8_MMA
#undef PG8_WAIT_V
#undef PG8_WAIT_L
#undef PG8_BAR
#undef PG8_SCHED
}
}

constexpr size_t MiB = 1u << 20;
constexpr size_t WS_CTL = 0, CTL_ZERO_BYTES = 64 * 1024;
constexpr size_t WS_WIN = 1 * MiB;
constexpr size_t WS_WOUT = 8 * MiB;
constexpr size_t WS_W1 = 10 * MiB;
constexpr size_t WS_W2 = 18 * MiB;
constexpr size_t WS_GW = 26 * MiB;
constexpr size_t WS_TAB = 26 * MiB + 512 * 1024;
constexpr size_t WS_SS1 = 27 * MiB;
constexpr size_t WS_SUMA = 30 * MiB, WS_SUMH = 31 * MiB;
constexpr size_t WS_LSE = 32 * MiB;
constexpr size_t WS_LSES = 36 * MiB;
constexpr size_t WS_OBS = 37 * MiB;
constexpr size_t WS_XRS = 43 * MiB;
constexpr size_t WS_XN = 64 * MiB;
constexpr size_t WS_PROJ = 132 * MiB;
constexpr size_t WS_OB = 300 * MiB;
constexpr size_t WS_MIXED = 400 * MiB;
constexpr size_t WS_X1B = 468 * MiB;
constexpr size_t WS_HB = 536 * MiB;
constexpr size_t WS_Y2 = 804 * MiB;
constexpr size_t WS_SLAB = 872 * MiB;
constexpr size_t WS_END = 936 * MiB;
static_assert(WS_WIN + (size_t)NIN * DM * 2 <= WS_WOUT && WS_SS1 + (size_t)MT * 16 * 4 <= WS_SUMA && WS_LSE + (size_t)3 * MT * 8 * 4 <= WS_LSES && WS_OBS + (size_t)4 * MS * 512 * 2 <= WS_XN, "ws map 1");
static_assert(WS_XN + (size_t)MT * DM * 2 <= WS_PROJ && WS_PROJ + (size_t)MT * NIN * 2 <= WS_OB && WS_OB + (size_t)3 * MT * 512 * 2 <= WS_MIXED && WS_MIXED + (size_t)MT * DM * 2 <= WS_X1B && WS_X1B + (size_t)MT * DM * 2 <= WS_HB && WS_HB + (size_t)MT * FF * 2 <= WS_Y2 && WS_Y2 + (size_t)MT * DM * 2 <= WS_SLAB && WS_SLAB + (size_t)16 * MS * DM * 4 <= WS_END, "ws map 2");
constexpr int CW_BAR = 4096;

constexpr int RING_OFF = 0, RING_BYTES = 131072;
constexpr int LDSCTL_OFF = RING_BYTES, MISC_OFF = LDSCTL_OFF + 320;
constexpr int GWL_OFF = LDSCTL_OFF + 1024;
constexpr int HAL_OFF = GWL_OFF + 16384;
constexpr int LDS_BYTES = HAL_OFF + 8192;
constexpr int BT_OFF = 0;
constexpr int TS_OFF = 18432;
constexpr int TS_STRIDE = 2112;
constexpr int CW_OFF = TS_OFF + 8 * TS_STRIDE * 4;
constexpr int CB_OFF = CW_OFF + 8192;
constexpr int STG_OFF = CB_OFF + 2048;
static_assert(STG_OFF + 8 * 4096 <= RING_BYTES, "P2 LDS scratch");

#define GAS __attribute__((address_space(1)))
#define LAS __attribute__((address_space(3)))
typedef unsigned short bf16;
typedef unsigned v4u __attribute__((ext_vector_type(4)));
typedef unsigned v2u __attribute__((ext_vector_type(2)));
typedef float f32x4 __attribute__((ext_vector_type(4)));
typedef float f32x16 __attribute__((ext_vector_type(16)));
typedef short bf16x8 __attribute__((ext_vector_type(8)));
typedef GAS unsigned gu32;
#define RLX_AGENT __ATOMIC_RELAXED, __HIP_MEMORY_SCOPE_AGENT
#define LDS_WAIT() asm volatile("s_waitcnt lgkmcnt(0)" ::: "memory")
#define VM_WAIT() asm volatile("s_waitcnt vmcnt(0)" ::: "memory")
#define MFMA32(a, b, c) __builtin_amdgcn_mfma_f32_32x32x16_bf16((a), (b), (c), 0, 0, 0)
__device__ __forceinline__ unsigned cvtpk(float lo, float hi) { typedef float f2_t __attribute__((ext_vector_type(2))); typedef __bf16 b2_t __attribute__((ext_vector_type(2))); f2_t v = {lo, hi}; b2_t b = __builtin_convertvector(v, b2_t); return __builtin_bit_cast(unsigned, b); }
__device__ __forceinline__ float bflo(unsigned w) { return __uint_as_float(w << 16); }
__device__ __forceinline__ float bfhi(unsigned w) { return __uint_as_float(w & 0xffff0000u); }
__device__ __forceinline__ bf16x8 pack8f(const f32x4 a, const f32x4 b) { v4u p; p.x = cvtpk(a[0], a[1]); p.y = cvtpk(a[2], a[3]); p.z = cvtpk(b[0], b[1]); p.w = cvtpk(b[2], b[3]); return __builtin_bit_cast(bf16x8, p); }
template <int S> __device__ __forceinline__ bf16x8 pack_step(const f32x16& x) { v4u p; p.x = cvtpk(x[8 * S], x[8 * S + 1]); p.y = cvtpk(x[8 * S + 2], x[8 * S + 3]); p.z = cvtpk(x[8 * S + 4], x[8 * S + 5]); p.w = cvtpk(x[8 * S + 6], x[8 * S + 7]); return __builtin_bit_cast(bf16x8, p); }
__device__ __forceinline__ float lo_half(float x) { auto rr = __builtin_amdgcn_permlane32_swap(__float_as_uint(x), __float_as_uint(x), false, false); return __uint_as_float(rr[0]); }
__device__ __forceinline__ float hi_half(float x) { auto rr = __builtin_amdgcn_permlane32_swap(__float_as_uint(x), __float_as_uint(x), false, false); return __uint_as_float(rr[1]); }
__device__ __forceinline__ float ex2(float x) { return __builtin_amdgcn_exp2f(x); }
__device__ __forceinline__ f32x16 zero16() { f32x16 z;
#pragma unroll
    for (int i = 0; i < 16; ++i) z[i] = 0.f; return z; }
__device__ __forceinline__ bf16x8 make_E(int s, int lane) { const int kk = (lane & 31) - 16 * s - 8 * (lane >> 5); bf16x8 e;
#pragma unroll
    for (int i = 0; i < 8; ++i) e[i] = (i == kk) ? (short)0x3F80 : (short)0; return e; }
__device__ __forceinline__ bf16x8 make_F(int s, int lane) { const int j = lane & 31, hb = lane >> 5; const bool on = ((j >> 4) == s) && (((j >> 2) & 1) == hb); const int kk = ((j >> 3) & 1) * 4 + (j & 3); bf16x8 e;
#pragma unroll
    for (int i = 0; i < 8; ++i) e[i] = (on && i == kk) ? (short)0x3F80 : (short)0; return e; }
__device__ __forceinline__ float wave_sum(float v) {
#pragma unroll
    for (int o = 1; o < 64; o <<= 1) v += __shfl_xor(v, o);
    return v;
}
__device__ __forceinline__ int t5_bucket(int dist) {
    if (dist < 16) return dist;
    const float df = (float)dist;
    int large = 16 + (int)(logf(df / 16.0f) / 4.852030263919617f * 16.0f);
    return large < 31 ? large : 31;
}

typedef short v4i16_t __attribute__((ext_vector_type(4)));
__device__ __forceinline__ bf16x8 vt_frag(const LAS unsigned char* img, int s, int nb, int lane) {
    const int hi = lane >> 5, a = (lane >> 4) & 1, q = (lane & 15) >> 2, p = lane & 3;
    const int r0 = 16 * s + 4 * hi + q, c16 = 4 * nb + 2 * a + (p >> 1), sw = (r0 >> 1) & 7;
    const LAS unsigned char* p0 = img + r0 * 128 + 16 * (c16 ^ sw) + 8 * (p & 1);
    const LAS unsigned char* p1 = img + (r0 + 8) * 128 + 16 * (c16 ^ sw ^ 4) + 8 * (p & 1);
    const v4i16_t lo = __builtin_amdgcn_ds_read_tr16_b64_v4i16((LAS v4i16_t*)p0), hh = __builtin_amdgcn_ds_read_tr16_b64_v4i16((LAS v4i16_t*)p1);
    return __builtin_shufflevector(lo, hh, 0, 1, 2, 3, 4, 5, 6, 7);
}
__device__ __forceinline__ int lane_id_now() { int l; asm volatile("v_mbcnt_lo_u32_b32 %0, -1, 0\n\tv_mbcnt_hi_u32_b32 %0, -1, %0" : "=v"(l)); return l; }
#define XB_TMO      128
#define XB_XCNT(j)  (256  + 64 * (j))
#define XB_XSUB(j)  (1280 + 64 * (j))
#define XB_XGEN(j)  (2304 + 64 * (j))
#define XB_TOP      3328
#define XB_TOPGEN   3392
#define XCD_BAR_WORDS 3456
#define XB_SPIN_CAP (1u << 18)

__device__ __forceinline__ unsigned xb_ld(unsigned* p)              { return __hip_atomic_load(p, __ATOMIC_RELAXED, __HIP_MEMORY_SCOPE_AGENT); }
__device__ __forceinline__ unsigned xb_add(unsigned* p, unsigned v) { return __hip_atomic_fetch_add(p, v, __ATOMIC_RELAXED, __HIP_MEMORY_SCOPE_AGENT); }
__device__ __forceinline__ unsigned xb_xcc_id() { return (unsigned)__builtin_amdgcn_s_getreg((3 << 11) | 20) & 0xFu; }
#define XB_SPIN(cond, bar) do { unsigned _sp = 0; while (cond) { __builtin_amdgcn_s_sleep(1); \
    if ((++_sp & 255u) == 0u) { if (xb_ld(&(bar)[XB_TMO])) break; if (_sp > XB_SPIN_CAP) { atomicAdd(&(bar)[XB_TMO], 1u); break; } } } } while (0)

struct XcdBarrier {
    unsigned* bar; unsigned x; int w;
    volatile LAS unsigned* st;
};

__device__ __forceinline__ XcdBarrier xcd_barrier_post(unsigned* bar, volatile LAS unsigned* st, int wave) {
    XcdBarrier b; b.bar = bar; b.x = xb_xcc_id(); b.st = st; b.w = wave;
    if (wave == 0 && lane_id_now() == 0) (void)xb_add(&bar[XB_XCNT(b.x)], 1u);
    return b;
}
__device__ __forceinline__ void xcd_barrier_complete(unsigned* bar, unsigned x, unsigned& nloc, unsigned& nx) {
    const unsigned G = gridDim.x * gridDim.y * gridDim.z;
    unsigned sum, cnt, mine, sp = 0u;
    for (;;) {
        sum = 0u; cnt = 0u; mine = 0u;
#pragma unroll
        for (unsigned j = 0; j < 16; ++j) { const unsigned c = xb_ld(&bar[XB_XCNT(j)]); sum += c; cnt += (c > 0u) ? 1u : 0u; mine = (j == x) ? c : mine; }
        if (sum == G) break;
        __builtin_amdgcn_s_sleep(1);
        if ((++sp & 255u) == 0u) { if (xb_ld(&bar[XB_TMO])) break; if (sp > XB_SPIN_CAP) { atomicAdd(&bar[XB_TMO], 1u); break; } }
    }
    nloc = mine > 0u ? mine : 1u; nx = cnt > 0u ? cnt : 1u;
}

template <bool FENCE = true>
__device__ __forceinline__ void xcd_barrier(const XcdBarrier& b) {
    asm volatile("s_waitcnt vmcnt(0)" ::: "memory");
    __syncthreads();
    if (b.w == 0 && lane_id_now() == 0) {
        unsigned* bar = b.bar;
        __builtin_amdgcn_s_waitcnt(0);
        unsigned nloc = b.st[0], nx = b.st[1];
        if (nloc == 0u) { xcd_barrier_complete(bar, b.x, nloc, nx); b.st[0] = nloc; b.st[1] = nx; }
        const unsigned old = xb_add(&bar[XB_XSUB(b.x)], 1u);
        const unsigned gen = old / nloc;
        if (old + 1u == (gen + 1u) * nloc) {
            if constexpr (FENCE) __builtin_amdgcn_fence(__ATOMIC_RELEASE, "agent");
            asm volatile("s_waitcnt vmcnt(0)" ::: "memory");
            const unsigned og = xb_add(&bar[XB_TOP], 1u);
            const unsigned tg = og / nx;
            if (og + 1u == (tg + 1u) * nx) xb_add(&bar[XB_TOPGEN], 1u);
            else XB_SPIN(xb_ld(&bar[XB_TOPGEN]) == tg, bar);
            if constexpr (FENCE) __builtin_amdgcn_fence(__ATOMIC_ACQUIRE, "agent");
            xb_add(&bar[XB_XGEN(b.x)], 1u);
            asm volatile("s_waitcnt vmcnt(0)" ::: "memory");
        } else {
            XB_SPIN(xb_ld(&bar[XB_XGEN(b.x)]) == gen, bar);
            if constexpr (FENCE) __builtin_amdgcn_fence(__ATOMIC_ACQUIRE, "agent");
            asm volatile("s_waitcnt vmcnt(0)" ::: "memory");
        }
    }
    __syncthreads();
}
#ifdef NT_PHASE_OUT
#define NT_ST(v, p) __builtin_nontemporal_store((v), (p))
#else
#define NT_ST(v, p) (*(p) = (v))
#endif

__device__ __forceinline__ void p0_transpose_item(const float* W, const float* gain, int K, int N, bf16* WT, LAS float* scr, int item, int lane) {
    const int nblk = N / 32, kb = item / nblk, nb = item % nblk, k0 = 64 * kb, n0 = 32 * nb;
    const GAS float* wp = (const GAS float*)W + (size_t)(k0 + (lane >> 5)) * N + n0 + (lane & 31);
    float v[32];
#pragma unroll
    for (int i = 0; i < 32; ++i) v[i] = __builtin_nontemporal_load(wp + (size_t)(2 * i) * N);
    if (gain) {
#pragma unroll
        for (int i = 0; i < 32; ++i) v[i] *= ((const GAS float*)gain)[k0 + 2 * i + (lane >> 5)];
    }
#pragma unroll
    for (int i = 0; i < 32; ++i) scr[(2 * i + (lane >> 5)) * 33 + (lane & 31)] = v[i];
    LDS_WAIT(); asm volatile("" ::: "memory");
    const int c = lane & 7;
#pragma unroll
    for (int j = 0; j < 4; ++j) { const int n = (lane >> 3) + 8 * j; const LAS float* s = scr + (8 * c) * 33 + n;
        v4u o; o.x = cvtpk(s[0 * 33], s[1 * 33]); o.y = cvtpk(s[2 * 33], s[3 * 33]); o.z = cvtpk(s[4 * 33], s[5 * 33]); o.w = cvtpk(s[6 * 33], s[7 * 33]);
        *(GAS v4u*)(WT + (size_t)(n0 + n) * K + k0 + 8 * c) = o; }
    LDS_WAIT(); asm volatile("" ::: "memory");
}
template <int NR>
__device__ __forceinline__ void rms_rows_to_bf16(const float* xp, const float* xs, const float* g, bf16* xn, int m0, int stride, int lane) {
    f32x4 v[NR][4];
#pragma unroll
    for (int r = 0; r < NR; ++r) { const int m = m0 + r * stride; const int mc = m < MT ? m : MT - 1;
        const GAS f32x4* xr = (const GAS f32x4*)(mc < MP ? xp + (size_t)mc * DM : xs + (size_t)(mc - MP) * DM) + lane;
#pragma unroll
        for (int j = 0; j < 4; ++j) v[r][j] = __builtin_nontemporal_load(xr + 64 * j); }
    const GAS f32x4* gr = (const GAS f32x4*)g + lane;
    f32x4 gg[4];
#pragma unroll
    for (int j = 0; j < 4; ++j) gg[j] = gr[64 * j];
#pragma unroll
    for (int r = 0; r < NR; ++r) { const int m = m0 + r * stride;
        float s = 0.f;
#pragma unroll
        for (int j = 0; j < 4; ++j) s += (v[r][j].x * v[r][j].x + v[r][j].y * v[r][j].y) + (v[r][j].z * v[r][j].z + v[r][j].w * v[r][j].w);
        const float rstd = 1.0f / sqrtf(wave_sum(s) * (1.f / DM) + NORM_EPS);
        if (m < MT) { GAS v2u* o8 = (GAS v2u*)(xn + (size_t)m * DM) + lane;
#pragma unroll
            for (int j = 0; j < 4; ++j) { v2u w; w.x = cvtpk(v[r][j].x * rstd * gg[j].x, v[r][j].y * rstd * gg[j].y); w.y = cvtpk(v[r][j].z * rstd * gg[j].z, v[r][j].w * rstd * gg[j].w); NT_ST(w, o8 + 64 * j); } } }
}

__device__ __forceinline__ float table_entry(const float* rel_bias, int i) {
    if (i < 3 * 8 * 192) { const int g = i / 1536, h = (i / 192) & 7, idx = i % 192, j = idx - 31; const int dil = g == 0 ? 1 : (g == 1 ? 4 : 16);
        return (j >= 0 && j <= 128) ? rel_bias[t5_bucket(j * dil) * 8 + h] * LOG2E : NEGV; }
    i -= 3 * 8 * 192;
    const int h = i / TS_STRIDE, idx = i % TS_STRIDE, dl = idx - 8; float v = NEGV;
    if (dl >= 0 && dl <= 2055) { const int m = (dl <= 128 ? 1 : 0) + (((dl & 3) == 0 && dl <= 512) ? 1 : 0) + (((dl & 15) == 0 && dl <= 2048) ? 1 : 0);
        if (m > 0) v = (m == 1 ? 0.f : (m == 2 ? 1.f : 1.5849625007211562f)) + rel_bias[t5_bucket(dl) * 8 + h] * LOG2E; }
    return v;
}
constexpr int NTAB = 3 * 8 * 192 + 8 * TS_STRIDE;
static_assert(TS_OFF == BT_OFF + 3 * 8 * 192 * 4 && NTAB % 4 == 0, "tables are contiguous in LDS");
__device__ __forceinline__ void build_tables(LAS unsigned char* lds, const float* tab, const float* conv_w, const float* conv_b, const bf16* gw, int g, int tid) {
    for (int i = tid; i < NTAB / 4; i += 512) *(LAS f32x4*)(lds + BT_OFF + 16 * i) = *(const GAS f32x4*)((const GAS float*)tab + 4 * i);
    LAS float* cw = (LAS float*)(lds + CW_OFF);
    for (int i = tid; i < 4 * 512; i += 512) cw[i] = conv_w[i];
    LAS float* cb = (LAS float*)(lds + CB_OFF);
    for (int i = tid; i < 512; i += 512) cb[i] = conv_b[i];
    for (int i = tid; i < 1024; i += 512) { const int mat = i >> 9, orow = (i >> 3) & 63, chn = i & 7;
        const v4u v = *(const GAS v4u*)((const GAS bf16*)gw + ((size_t)(mat * 8 + g) * 64 + orow) * 64 + chn * 8);
        *(LAS v4u*)(lds + GWL_OFF + mat * 8192 + orow * 128 + 16 * (chn ^ ((orow >> 1) & 7))) = v; }
}

__device__ __forceinline__ void kv_rows_out(const v4u (&kr)[4], GAS float* dst, int lane) {
#pragma unroll
    for (int i = 0; i < 4; ++i) { const int row = 8 * i + (lane >> 3); const unsigned ch = (unsigned)((lane & 7) ^ ((row >> 1) & 7));
        GAS float* d = dst + ((unsigned)row * (unsigned)ATT + 8u * ch); const v4u w = kr[i];
        const f32x4 a = {bflo(w.x), bfhi(w.x), bflo(w.y), bfhi(w.y)}, b = {bflo(w.z), bfhi(w.z), bflo(w.w), bfhi(w.w)};
        __builtin_nontemporal_store(a, (GAS f32x4*)d); __builtin_nontemporal_store(b, (GAS f32x4*)(d + 4)); }
}
#ifndef PA_NVE
#define PA_NVE 1
#endif
template <int NT>
__device__ __forceinline__ void pa_body(const GAS bf16* proj, GAS bf16* po, GAS float* plse, const LAS float* tb0, LAS unsigned char* stg, int rowq, unsigned offk0, unsigned ostep, unsigned ostepq, int lane, const bf16x8 E0, const bf16x8 E1, GAS float* kvp, bool kvo) {
    const int hi = lane >> 5, kv = lane & 31;
    bf16x8 qf[4];
    { const GAS bf16* pq = proj + (size_t)rowq * NIN + hi * 8;
#pragma unroll
      for (int ks = 0; ks < 4; ++ks) qf[ks] = *(const GAS bf16x8*)(pq + 16 * ks); }
    constexpr int NVE = NT < PA_NVE ? NT : PA_NVE;
    v4u kr[NT][4];
#pragma unroll
    for (int j = 0; j < NT; ++j)
#pragma unroll
        for (int i = 0; i < 4; ++i) { const int row = 8 * i + (lane >> 3); const unsigned ch = (unsigned)((lane & 7) ^ ((row >> 1) & 7));
            kr[j][i] = *(const GAS v4u*)(proj + (offk0 + (unsigned)j * ostep + (unsigned)i * (ostep >> 2) + 512u + 8u * ch)); }
    LAS unsigned char* wr = stg + 16 * lane;
    const LAS unsigned char* rd0 = stg + kv * 128;
    const int sw = (kv >> 1) & 7;
    const f32x16 zero = zero16();
    f32x16 p[NT];
#pragma unroll
    for (int jj = 0; jj < NT; ++jj) { const int j = jj == 0 ? NT - 1 : jj - 1;
#pragma unroll
        for (int i = 0; i < 4; ++i) *(LAS v4u*)(wr + i * 1024) = kr[j][i];
        if (jj == 0) { if (kvo) kv_rows_out(kr[j], kvp, lane); }
        if (jj < NVE) {
#pragma unroll
            for (int i = 0; i < 4; ++i) { const int row = 8 * i + (lane >> 3); const unsigned ch = (unsigned)((lane & 7) ^ ((row >> 1) & 7));
                kr[j][i] = *(const GAS v4u*)(proj + (offk0 + (unsigned)j * ostep + (unsigned)i * (ostep >> 2) + 1024u + 8u * ch)); } }
        f32x16 a = zero;
#pragma unroll
        for (int ks = 0; ks < 4; ++ks) a = MFMA32(*(const LAS bf16x8*)(rd0 + 16 * ((2 * ks + hi) ^ sw)), qf[ks], a);
        p[j] = a;
    }
    float m = NEGV;
#pragma unroll
    for (int j = 0; j < NT; ++j) { const LAS float* tb = tb0 - 32 * (j + 5 - NT);
#pragma unroll
        for (int r = 0; r < 16; ++r) { p[j][r] += tb[27 - ((r & 3) + 8 * (r >> 2))]; m = fmaxf(m, p[j][r]); } }
    m = fmaxf(lo_half(m), hi_half(m));
    float l = 0.f;
    bf16x8 pb[NT][2];
#pragma unroll
    for (int j = 0; j < NT; ++j) {
#pragma unroll
        for (int r = 0; r < 16; ++r) { const float e = ex2(p[j][r] - m); p[j][r] = e; l += e; }
        pb[j][0] = pack_step<0>(p[j]); pb[j][1] = pack_step<1>(p[j]);
    }
    l = lo_half(l) + hi_half(l);
    __builtin_amdgcn_sched_barrier(0);
#pragma unroll
    for (int jj = NVE; jj < NT; ++jj) { const int j = jj - 1;
#pragma unroll
        for (int i = 0; i < 4; ++i) { const int row = 8 * i + (lane >> 3); const unsigned ch = (unsigned)((lane & 7) ^ ((row >> 1) & 7));
            kr[j][i] = *(const GAS v4u*)(proj + (offk0 + (unsigned)j * ostep + (unsigned)i * (ostep >> 2) + 1024u + 8u * ch)); } }
    f32x16 o0 = zero, o1 = zero;
#pragma unroll
    for (int jj = 0; jj < NT; ++jj) { const int j = jj == 0 ? NT - 1 : jj - 1;
#pragma unroll
        for (int i = 0; i < 4; ++i) *(LAS v4u*)(wr + i * 1024) = kr[j][i];
        if (jj == 0) { if (kvo) kv_rows_out(kr[j], kvp + (size_t)MP * ATT, lane); }
        const bf16x8 v0 = *(const LAS bf16x8*)(rd0 + 16 * ((0 + hi) ^ sw)), v1 = *(const LAS bf16x8*)(rd0 + 16 * ((2 + hi) ^ sw)), v2 = *(const LAS bf16x8*)(rd0 + 16 * ((4 + hi) ^ sw)), v3 = *(const LAS bf16x8*)(rd0 + 16 * ((6 + hi) ^ sw));
        f32x16 x0 = MFMA32(v0, E0, zero); x0 = MFMA32(v1, E1, x0);
        f32x16 x1 = MFMA32(v2, E0, zero); x1 = MFMA32(v3, E1, x1);
        o0 = MFMA32(pack_step<0>(x0), pb[j][0], o0); o1 = MFMA32(pack_step<0>(x1), pb[j][0], o1);
        o0 = MFMA32(pack_step<1>(x0), pb[j][1], o0); o1 = MFMA32(pack_step<1>(x1), pb[j][1], o1);
    }
    const float inv = __builtin_amdgcn_rcpf(l);
    { LAS unsigned char* wq = stg + kv * 128 + 8 * hi;
#pragma unroll
      for (int rg = 0; rg < 4; ++rg) {
        v2u w0, w1;
        w0.x = cvtpk(o0[4 * rg] * inv, o0[4 * rg + 1] * inv); w0.y = cvtpk(o0[4 * rg + 2] * inv, o0[4 * rg + 3] * inv);
        w1.x = cvtpk(o1[4 * rg] * inv, o1[4 * rg + 1] * inv); w1.y = cvtpk(o1[4 * rg + 2] * inv, o1[4 * rg + 3] * inv);
        *(LAS v2u*)(wq + 16 * (rg ^ sw)) = w0; *(LAS v2u*)(wq + 16 * ((4 + rg) ^ sw)) = w1;
      } }
#pragma unroll
    for (int i = 0; i < 4; ++i) { const int row = 8 * i + (lane >> 3); const unsigned ch = (unsigned)((lane & 7) ^ ((row >> 1) & 7));
        const v4u v = *(const LAS v4u*)(stg + i * 1024 + 16 * lane);
        *(GAS v4u*)(po + ((unsigned)i * ostepq + 8u * ch)) = v; }
    if (hi == 0) *plse = m + log2f(l);
}
__device__ __forceinline__ void pa_task(const bf16* proj, bf16* ob, float* lse, float* outp, const LAS float* btab, LAS unsigned char* stg, int id, int lane_in, const int DUMMY = 0) {
    int lane = lane_in; asm volatile("" : "+v"(lane));
    const bf16x8 E0 = make_E(0, lane), E1 = make_E(1, lane);
    const int g = id >> 13, rem = id & 8191, bh = rem >> 6, k64 = (rem + 21 * (id >> 11)) & 63, b = bh >> 3, h = bh & 7;
    int d, c, ti;
    if (g == 0) { d = 1; c = 0; ti = k64; } else if (g == 1) { d = 4; c = k64 >> 4; ti = k64 & 15; } else { d = 16; c = k64 >> 2; ti = k64 & 3; }
    const int q = lane & 31, hi = lane >> 5, i0 = ti * 32;
    const int nt = ti < 4 ? ti + 1 : 5;
    int rowq = b * SEQ + d * (i0 + q) + c;
    int rowk0 = b * SEQ + d * (i0 - 32 * (nt - 1) + (lane >> 3)) + c;
    int dd = d;
    if (DUMMY == 1) { rowq &= 63; rowk0 &= 63; dd = 0; }
    const GAS bf16* pj = (const GAS bf16*)proj + h * 64;
    const int rowq8 = (DUMMY == 1) ? ((lane >> 3) & 63) : b * SEQ + d * (i0 + (lane >> 3)) + c;
    GAS bf16* po = (GAS bf16*)ob + ((size_t)g * MT + rowq8) * ATT + h * 64;
    GAS float* pl = (GAS float*)lse + ((size_t)g * MT + rowq) * 8 + h;
    const LAS float* tb0 = btab + (g * 8 + h) * 192 + (159 - 27 + q - 4 * hi);
    const unsigned ostepq = (unsigned)(8 * dd) * (unsigned)ATT;
    const unsigned offk0 = (unsigned)rowk0 * (unsigned)NIN, ostep = (unsigned)(32 * dd) * (unsigned)NIN;
    GAS float* kvp = (GAS float*)outp + OFF_NKP + ((size_t)(b * SEQ + i0) * ATT + h * 64);
    const bool kvo = (g == 0) && (DUMMY == 0);
    if (nt == 5) pa_body<5>(pj, po, pl, tb0, stg, rowq, offk0, ostep, ostepq, lane, E0, E1, kvp, kvo);
    else if (nt == 4) pa_body<4>(pj, po, pl, tb0, stg, rowq, offk0, ostep, ostepq, lane, E0, E1, kvp, kvo);
    else if (nt == 3) pa_body<3>(pj, po, pl, tb0, stg, rowq, offk0, ostep, ostepq, lane, E0, E1, kvp, kvo);
    else if (nt == 2) pa_body<2>(pj, po, pl, tb0, stg, rowq, offk0, ostep, ostepq, lane, E0, E1, kvp, kvo);
    else pa_body<1>(pj, po, pl, tb0, stg, rowq, offk0, ostep, ostepq, lane, E0, E1, kvp, kvo);
}

struct SaHalf { f32x4 x[8]; };
__device__ __forceinline__ void sa_load(SaHalf& t, const float* c, int b, int h, int tile, int lane) {
    const int pbase = tile < 24 ? 64 * tile : 1536 + 32 * (tile - 24), strd = tile < 24 ? 16 : 8;
    const GAS float* p0 = (const GAS float*)c + ((size_t)b * NCACHE * NH + h) * HD + 4 * (lane & 15);
#pragma unroll
    for (int i = 0; i < 8; ++i) { const int r = 4 * i + (lane >> 4); const int prow = pbase + strd * (r >> 3) + (r & 7);
        t.x[i] = __builtin_nontemporal_load((const GAS f32x4*)(p0 + (size_t)prow * (NH * HD))); }
}
__device__ __forceinline__ void sa_stage(const SaHalf& t, LAS unsigned char* stg, int lane, bf16x8 (&f)[4]) {
#pragma unroll
    for (int i = 0; i < 8; ++i) { const int r = 4 * i + (lane >> 4); v2u w; w.x = cvtpk(t.x[i][0], t.x[i][1]); w.y = cvtpk(t.x[i][2], t.x[i][3]);
        *(LAS v2u*)(stg + r * 128 + 16 * (((lane & 15) >> 1) ^ ((r >> 1) & 7)) + 8 * (lane & 1)) = w; }
    const int kv = lane & 31, hi = lane >> 5, sw = (kv >> 1) & 7;
#pragma unroll
    for (int ks = 0; ks < 4; ++ks) f[ks] = *(const LAS bf16x8*)(stg + kv * 128 + 16 * ((2 * ks + hi) ^ sw));
}
__device__ __forceinline__ void sa_step(const bf16x8 (&kf)[4], const bf16x8 (&vf)[4], const bf16x8 (&qf)[4], const LAS float* ts, int dbase, int strd, float& m, float& l, f32x16& o0, f32x16& o1, const bf16x8 E0, const bf16x8 E1) {
    const f32x16 zero = zero16();
    f32x16 a = zero;
#pragma unroll
    for (int ks = 0; ks < 4; ++ks) a = MFMA32(kf[ks], qf[ks], a);
#pragma unroll
    for (int r = 0; r < 16; ++r) { int dl = dbase - strd * (r >> 2) - (r & 3); dl = dl < -1 ? -1 : dl; a[r] += ts[dl]; }
    float mx = a[0];
#pragma unroll
    for (int r = 1; r < 16; ++r) mx = fmaxf(mx, a[r]);
    mx = fmaxf(lo_half(mx), hi_half(mx));
    const float mn = fmaxf(fmaxf(m, mx), -1e20f);
    const float sc = ex2(m - mn);
    float ls = 0.f;
#pragma unroll
    for (int r = 0; r < 16; ++r) { const float e = ex2(a[r] - mn); a[r] = e; ls += e; }
    ls = lo_half(ls) + hi_half(ls);
    l = l * sc + ls; m = mn;
#pragma unroll
    for (int r = 0; r < 16; ++r) { o0[r] *= sc; o1[r] *= sc; }
    f32x16 x0 = MFMA32(vf[0], E0, zero); x0 = MFMA32(vf[1], E1, x0);
    f32x16 x1 = MFMA32(vf[2], E0, zero); x1 = MFMA32(vf[3], E1, x1);
    { const bf16x8 pb = pack_step<0>(a); o0 = MFMA32(pack_step<0>(x0), pb, o0); o1 = MFMA32(pack_step<0>(x1), pb, o1); }
    { const bf16x8 pb = pack_step<1>(a); o0 = MFMA32(pack_step<1>(x0), pb, o0); o1 = MFMA32(pack_step<1>(x1), pb, o1); }
}
__device__ __forceinline__ void sa_task(const bf16* proj, const float* ck, const float* cv, bf16* obs, float* lses, const LAS float* tabS, LAS unsigned char* stg, int id, int lane_in) {
    int lane = lane_in; asm volatile("" : "+v"(lane));
    const bf16x8 E0 = make_E(0, lane), E1 = make_E(1, lane);
    const int h = id & 7, seg = (id >> 3) & 3, b = id >> 5;
    const int q = lane & 31, hi = lane >> 5, t = q & 7;
    const int rowq = MP + b * DECT + t;
    const GAS bf16* pq = (const GAS bf16*)proj + (size_t)rowq * NIN + h * 64 + hi * 8;
    bf16x8 qf[4];
#pragma unroll
    for (int ks = 0; ks < 4; ++ks) qf[ks] = *(const GAS bf16x8*)(pq + 16 * ks);
    const int T0 = seg == 0 ? 0 : 1 + 10 * seg, T1 = 11 + 10 * seg, T1c = T1 < 40 ? T1 : 40;
    float m = NEGV, l = 0.f; f32x16 o0 = zero16(), o1 = zero16();
    const LAS float* ts = tabS + h * TS_STRIDE + 8;
    SaHalf kx, vx;
    sa_load(kx, ck, b, h, T0, lane); sa_load(vx, cv, b, h, T0, lane);
#pragma unroll 1
    for (int tile = T0; tile < T1c; ++tile) {
        const int pbase = tile < 24 ? 64 * tile : 1536 + 32 * (tile - 24), strd = tile < 24 ? 16 : 8;
        bf16x8 kf[4], vf[4];
        sa_stage(kx, stg, lane, kf); sa_stage(vx, stg, lane, vf);
        __builtin_amdgcn_sched_barrier(0);
        { const int tn = tile + 1 < T1c ? tile + 1 : tile; sa_load(kx, ck, b, h, tn, lane); sa_load(vx, cv, b, h, tn, lane); }
        __builtin_amdgcn_sched_barrier(0);
        sa_step(kf, vf, qf, ts, NCACHE + t - pbase - 4 * hi, strd, m, l, o0, o1, E0, E1);
    }
    if (T1 > 40) {
        const int rk = MP + b * DECT + (q & 7);
        const GAS bf16* pk = (const GAS bf16*)proj + (size_t)rk * NIN + 512 + h * 64 + hi * 8;
        bf16x8 kf[4], vf[4];
#pragma unroll
        for (int ks = 0; ks < 4; ++ks) { kf[ks] = *(const GAS bf16x8*)(pk + 16 * ks); vf[ks] = *(const GAS bf16x8*)(pk + 512 + 16 * ks); }
        sa_step(kf, vf, qf, ts, NCACHE + t - 2048 - 4 * hi, 8, m, l, o0, o1, E0, E1);
    }
    if (q < 8) {
        const float ll = fmaxf(l, 1e-30f), inv = 1.0f / ll;
        GAS bf16* po = (GAS bf16*)obs + ((size_t)seg * MS + b * DECT + t) * ATT + h * 64 + 4 * hi;
#pragma unroll
        for (int rg = 0; rg < 4; ++rg) {
            v2u w0, w1;
            w0.x = cvtpk(o0[4 * rg] * inv, o0[4 * rg + 1] * inv); w0.y = cvtpk(o0[4 * rg + 2] * inv, o0[4 * rg + 3] * inv);
            w1.x = cvtpk(o1[4 * rg] * inv, o1[4 * rg + 1] * inv); w1.y = cvtpk(o1[4 * rg + 2] * inv, o1[4 * rg + 3] * inv);
            *(GAS v2u*)(po + 8 * rg) = w0; *(GAS v2u*)(po + 32 + 8 * rg) = w1;
        }
        if (hi == 0) ((GAS float*)lses)[((size_t)seg * MS + b * DECT + t) * 8 + h] = m + log2f(ll);
    }
}

struct RgIo { const bf16* proj; const unsigned char* wsb; const float* sh; const float* gab; const float* gxb; const float* lam; const bf16* gw; bf16* mixed; bf16* y2; float* suma; float* sumh; float* out; };
struct RgX { v4u x[4][4]; bf16x8 g[4]; };
template <bool SAMPLE, int PART>
__device__ __forceinline__ void rg_xload(RgX& X, const unsigned char* wsb, int rowbase, int tt0, int bs0, int g, int lane) {
    const int tok = lane & 31, hi = lane >> 5;
    const int tq = SAMPLE ? (tok & 7) : (tt0 + tok);
    const GAS unsigned char* pb = (const GAS unsigned char*)wsb;
    const unsigned o0 = (unsigned)WS_PROJ + ((unsigned)(rowbase + tok) * (unsigned)NIN + (unsigned)(1536 + g * 64 + hi * 8)) * 2u;
    const unsigned os = (unsigned)WS_XRS + ((unsigned)((SAMPLE ? bs0 + (tok >> 3) : DECB) * 3) * (unsigned)LRU + (unsigned)(g * 64 + hi * 8)) * 2u;
#pragma unroll
    for (int j = (PART == 0 ? 0 : 3); j < (PART == 0 ? 3 : 4); ++j) { const int tj = tq - 3 + j; const unsigned oj = tj >= 0 ? o0 - (unsigned)((3 - j) * NIN * 2) : os + (unsigned)((3 + tj) * LRU * 2);
#pragma unroll
        for (int ks = 0; ks < 4; ++ks) X.x[ks][j] = *(const GAS v4u*)(pb + (oj + 32u * ks)); }
    if (PART == 1) {
#pragma unroll
        for (int ks = 0; ks < 4; ++ks) X.g[ks] = *(const GAS bf16x8*)(pb + (o0 + 1024u + 32u * ks));
    }
}
__device__ __forceinline__ void rg_conv(const RgX& X, int g, int lane, const LAS float* cw, const LAS float* cb, bf16x8 (&af)[4]) {
    const int hi = lane >> 5;
#pragma unroll
    for (int ks = 0; ks < 4; ++ks) {
        const int cg = g * 64 + 16 * ks + 8 * hi;
        f32x4 a0 = *(const LAS f32x4*)(cb + cg), a1 = *(const LAS f32x4*)(cb + cg + 4);
#pragma unroll
        for (int j = 0; j < 4; ++j) {
            const v4u xw = X.x[ks][j];
            const f32x4 x0 = (f32x4){bflo(xw.x), bfhi(xw.x), bflo(xw.y), bfhi(xw.y)}, x1 = (f32x4){bflo(xw.z), bfhi(xw.z), bflo(xw.w), bfhi(xw.w)};
            const f32x4 w0 = *(const LAS f32x4*)(cw + j * 512 + cg), w1 = *(const LAS f32x4*)(cw + j * 512 + cg + 4);
            a0 += w0 * x0; a1 += w1 * x1;
        }
        af[ks] = pack8f(a0, a1);
        __builtin_amdgcn_sched_barrier(0);
    }
}
struct RgConst { float ba, bx, clam; };
__device__ __forceinline__ RgConst rg_load_consts(const RgIo& io, int g, int nb, int lane) {
    RgConst rc; const int ch = g * 64 + 32 * nb + (lane & 31); rc.ba = ((const GAS float*)io.gab)[ch]; rc.bx = ((const GAS float*)io.gxb)[ch];
    rc.clam = -8.0f * log1pf(expf(-((const GAS float*)io.lam)[ch])) * LOG2E;
    return rc;
}
template <bool SAMPLE, int NB>
__device__ __forceinline__ void rgc_block(const RgIo& io, const LAS unsigned char* gwl, const bf16x8 (&af)[4], const bf16x8 gf0, const bf16x8 gf1, int g, int bs0, int lane,
                                          const bf16x8 E0, const bf16x8 E1, const bf16x8 F0, const bf16x8 F1, const RgConst rc, float& ch_, float& cp_, f32x16& Z1, f32x16& Z2) {
    const int hi = lane >> 5, cl = lane & 31, ch = g * 64 + 32 * NB + cl;
    const f32x16 zero = zero16();
    f32x16 R = zero, I = zero;
    { const int orow = 32 * NB + cl, sw = (orow >> 1) & 7; const LAS unsigned char* pa = gwl + orow * 128; const LAS unsigned char* px = pa + 8192;
#pragma unroll
      for (int ks = 0; ks < 4; ++ks) { const int pos = 16 * ((2 * ks + hi) ^ sw); R = MFMA32(af[ks], *(const LAS bf16x8*)(pa + pos), R); I = MFMA32(af[ks], *(const LAS bf16x8*)(px + pos), I); } }
    f32x16 XC = MFMA32(af[2 * NB], E0, zero); XC = MFMA32(af[2 * NB + 1], E1, XC);
    __builtin_amdgcn_sched_barrier(0);
    f32x16 A, U;
#pragma unroll
    for (int r = 0; r < 16; ++r) {
        const float rr = __builtin_amdgcn_rcpf(1.0f + ex2(-(R[r] + rc.ba) * LOG2E));
        const float ii = __builtin_amdgcn_rcpf(1.0f + ex2(-(I[r] + rc.bx) * LOG2E));
        const float a = ex2(rr * rc.clam);
        A[r] = a; U[r] = __builtin_amdgcn_sqrtf(__builtin_fmaf(-a, a, 1.0f)) * (ii * XC[r]);
    }
    __builtin_amdgcn_sched_barrier(0);
    f32x16 Gt = MFMA32(gf0, E0, zero); Gt = MFMA32(gf1, E1, Gt);
    f32x16 O1, O2;
#pragma unroll
    for (int grp = 0; grp < 4; ++grp) {
        if (SAMPLE) { ch_ = ((const GAS float*)io.sh)[(size_t)(bs0 + grp) * LRU + ch]; cp_ = 0.f; }
        float h0 = ch_, p0 = cp_, hv0[4], hv1[4], pv0[4], pv1[4];
#pragma unroll
        for (int kk = 0; kk < 4; ++kk) { h0 = A[4 * grp + kk] * h0 + U[4 * grp + kk]; p0 *= A[4 * grp + kk]; hv0[kk] = h0; pv0[kk] = p0; }
        float h1 = lo_half(h0), p1 = lo_half(p0);
#pragma unroll
        for (int kk = 0; kk < 4; ++kk) { h1 = A[4 * grp + kk] * h1 + U[4 * grp + kk]; p1 *= A[4 * grp + kk]; hv1[kk] = h1; pv1[kk] = p1; }
        ch_ = hi_half(h1); cp_ = hi_half(p1);
        if (SAMPLE) { if (hi == 0) ((GAS float*)io.out)[OFF_NHS + (size_t)(bs0 + grp) * LRU + ch] = ch_; }
#pragma unroll
        for (int kk = 0; kk < 4; ++kk) { const float x = Gt[4 * grp + kk];
            const float gl = x * __builtin_amdgcn_rcpf(1.0f + ex2(-2.3022081984f * (x + 0.044715f * x * x * x)));
            O1[4 * grp + kk] = (hi ? hv1[kk] : hv0[kk]) * gl; O2[4 * grp + kk] = (hi ? pv1[kk] : pv0[kk]) * gl; }
    }
    __builtin_amdgcn_sched_barrier(0);
    Z1 = MFMA32(pack_step<0>(O1), F0, zero); Z1 = MFMA32(pack_step<1>(O1), F1, Z1);
    Z2 = MFMA32(pack_step<0>(O2), F0, zero); Z2 = MFMA32(pack_step<1>(O2), F1, Z2);
}
template <int NB>
__device__ __forceinline__ void rgc_store(const RgIo& io, LAS unsigned char* stg, const f32x16& Z1, const f32x16& Z2, int g, int rowbase, int lane) {
    const int hi = lane >> 5, cl = lane & 31, sw = (cl >> 1) & 7;
    LAS unsigned char* wq = stg + cl * 128 + 8 * hi;
#pragma unroll
    for (int rg = 0; rg < 4; ++rg) { v2u w; w.x = cvtpk(Z1[4 * rg], Z1[4 * rg + 1]); w.y = cvtpk(Z1[4 * rg + 2], Z1[4 * rg + 3]); *(LAS v2u*)(wq + 16 * (rg ^ sw)) = w;
        v2u y; y.x = cvtpk(Z2[4 * rg], Z2[4 * rg + 1]); y.y = cvtpk(Z2[4 * rg + 2], Z2[4 * rg + 3]); *(LAS v2u*)(wq + 16 * ((4 + rg) ^ sw)) = y; }
    GAS bf16* p1 = (GAS bf16*)io.y2 + (g * 64 + 32 * NB); GAS bf16* p2 = (GAS bf16*)io.y2 + (LRU + g * 64 + 32 * NB);
#pragma unroll
    for (int i = 0; i < 4; ++i) { const int row = 8 * i + (lane >> 3); const int ch = (lane & 7) ^ ((row >> 1) & 7);
        const v4u v = *(const LAS v4u*)(stg + i * 1024 + 16 * lane);
        GAS bf16* dst = (ch < 4) ? p1 + ((unsigned)(rowbase + row) * (unsigned)DM + 8u * ch) : p2 + ((unsigned)(rowbase + row) * (unsigned)DM + 8u * (ch - 4));
        *(GAS v4u*)dst = v; }
}
template <bool SAMPLE>
__device__ __forceinline__ void rgc_task(const RgIo& io, const LAS float* cw, const LAS float* cb, const LAS unsigned char* gwl, LAS unsigned char* stg, int g, int bc, int lane_in) {
    int lane = lane_in; asm volatile("" : "+v"(lane));
    const bf16x8 E0 = make_E(0, lane), E1 = make_E(1, lane), F0 = make_F(0, lane), F1 = make_F(1, lane);
    const int c = SAMPLE ? 0 : (bc & 15), bu = SAMPLE ? 0 : (bc >> 4);
    const int hi = lane >> 5, cl = lane & 31;
    const RgConst rc0 = rg_load_consts(io, g, 0, lane), rc1 = rg_load_consts(io, g, 1, lane);
    const int row0 = SAMPLE ? MP + bc * 32 : bu * SEQ + 128 * c;
    constexpr int NTL = SAMPLE ? 1 : 4;
    float ch0 = 0.f, ch1 = 0.f, cp0 = 1.f, cp1 = 1.f;
    RgX X;
    rg_xload<SAMPLE, 1>(X, io.wsb, row0, 128 * c, SAMPLE ? bc * 4 : 0, g, lane);
#pragma unroll 1
    for (int k = 0; k < NTL; ++k) {
        const int rowbase = row0 + 32 * k, bs0 = SAMPLE ? bc * 4 : 0;
        rg_xload<SAMPLE, 0>(X, io.wsb, rowbase, 128 * c + 32 * k, bs0, g, lane);
        bf16x8 af[4];
        rg_conv(X, g, lane, cw, cb, af);
        const bf16x8 g0 = X.g[0], g1 = X.g[1], g2 = X.g[2], g3 = X.g[3];
        __builtin_amdgcn_sched_barrier(0);
        f32x16 Z1, Z2;
        rgc_block<SAMPLE, 0>(io, gwl, af, g0, g1, g, bs0, lane, E0, E1, F0, F1, rc0, ch0, cp0, Z1, Z2);
        rgc_store<0>(io, stg, Z1, Z2, g, rowbase, lane);
        __builtin_amdgcn_sched_barrier(0);
        rgc_block<SAMPLE, 1>(io, gwl, af, g2, g3, g, bs0, lane, E0, E1, F0, F1, rc1, ch1, cp1, Z1, Z2);
        __builtin_amdgcn_sched_barrier(0);
        if (!SAMPLE) { if (k + 1 < NTL) rg_xload<SAMPLE, 1>(X, io.wsb, rowbase + 32, 128 * c + 32 * k + 32, 0, g, lane); }
        __builtin_amdgcn_sched_barrier(0);
        rgc_store<1>(io, stg, Z1, Z2, g, rowbase, lane);
    }
    if (!SAMPLE) {
        if (hi == 0) { const size_t o = ((size_t)bu * 16 + c) * LRU + g * 64 + cl;
            ((GAS float*)io.suma)[o] = cp0; ((GAS float*)io.sumh)[o] = ch0; ((GAS float*)io.suma)[o + 32] = cp1; ((GAS float*)io.sumh)[o + 32] = ch1; }
        if (c == 15) {
#pragma unroll
            for (int j = 0; j < 3; ++j) { const unsigned short xv = ((const GAS bf16*)io.proj)[(size_t)(bu * SEQ + SEQ - 3 + j) * NIN + 1536 + g * 64 + lane];
                ((GAS float*)io.out)[OFF_NCP + ((size_t)bu * 3 + j) * LRU + g * 64 + lane] = __uint_as_float((unsigned)xv << 16); }
        }
    } else {
#pragma unroll
        for (int sq = 0; sq < 4; ++sq) {
            const int bb = bc * 4 + sq;
#pragma unroll
            for (int j = 0; j < 3; ++j) { const unsigned short xv = ((const GAS bf16*)io.proj)[(size_t)(MP + bb * DECT + 5 + j) * NIN + 1536 + g * 64 + lane];
                ((GAS float*)io.out)[OFF_NCS + ((size_t)bb * 3 + j) * LRU + g * 64 + lane] = __uint_as_float((unsigned)xv << 16); }
        }
    }
}

struct RgRaw { v4u x[4]; v4u h; };
__device__ __forceinline__ void rgp_load(RgRaw& R, const unsigned char* wsb, int rowbase, int tt0, int g, int lane) {
    const GAS unsigned char* pb = (const GAS unsigned char*)wsb;
#pragma unroll
    for (int i = 0; i < 4; ++i) { const int r = 8 * i + (lane >> 3); const unsigned ch = (unsigned)((lane & 7) ^ ((r >> 1) & 7));
        R.x[i] = *(const GAS v4u*)(pb + ((unsigned)WS_PROJ + ((unsigned)(rowbase + r) * (unsigned)NIN + (unsigned)(1536 + g * 64) + 8u * ch) * 2u)); }
    { const int hr = (lane >> 3) < 3 ? (lane >> 3) : 2;
      const unsigned off = (tt0 - 3 + hr >= 0) ? (unsigned)WS_PROJ + ((unsigned)(rowbase - 3 + hr) * (unsigned)NIN + (unsigned)(1536 + g * 64 + 8 * (lane & 7))) * 2u
                                               : (unsigned)WS_XRS + ((unsigned)((DECB * 3 + hr) * LRU + g * 64 + 8 * (lane & 7))) * 2u;
      R.h = *(const GAS v4u*)(pb + off); }
}
__device__ __forceinline__ void rgp_load_gate(v4u (&G)[4], const unsigned char* wsb, int rowbase, int g, int lane) {
    const GAS unsigned char* pb = (const GAS unsigned char*)wsb;
#pragma unroll
    for (int i = 0; i < 4; ++i) { const int r = 8 * i + (lane >> 3); const unsigned ch = (unsigned)((lane & 7) ^ ((r >> 1) & 7));
        G[i] = *(const GAS v4u*)(pb + ((unsigned)WS_PROJ + ((unsigned)(rowbase + r) * (unsigned)NIN + (unsigned)(2048 + g * 64) + 8u * ch) * 2u)); }
}
__device__ __forceinline__ void rgp_task(const RgIo& io, const LAS float* cw, const LAS float* cb, const LAS unsigned char* gwl, LAS unsigned char* stg, LAS unsigned char* hal, int g, int bc, int lane_in) {
    int lane = lane_in; asm volatile("" : "+v"(lane));
    const bf16x8 E0 = make_E(0, lane), E1 = make_E(1, lane), F0 = make_F(0, lane), F1 = make_F(1, lane);
    const int c = bc & 15, bu = bc >> 4;
    const int hi = lane >> 5, cl = lane & 31;
    const RgConst rc0 = rg_load_consts(io, g, 0, lane), rc1 = rg_load_consts(io, g, 1, lane);
    const int row0 = bu * SEQ + 128 * c;
    float ch0 = 0.f, ch1 = 0.f, cp0 = 1.f, cp1 = 1.f;
    RgRaw R;
    rgp_load(R, io.wsb, row0, 128 * c, g, lane);
#pragma unroll 1
    for (int k = 0; k < 4; ++k) {
        const int rowbase = row0 + 32 * k;
        RgX X;
        v4u GR[4]; rgp_load_gate(GR, io.wsb, rowbase, g, lane);
#pragma unroll
        for (int i = 0; i < 4; ++i) *(LAS v4u*)(stg + i * 1024 + 16 * lane) = R.x[i];
        *(LAS v4u*)(hal + 16 * lane) = R.h;
#pragma unroll
        for (int j = 0; j < 4; ++j) { const int rr = cl - 3 + j; const LAS unsigned char* rp = rr >= 0 ? stg + rr * 128 : hal + (rr + 3) * 128; const int sw = rr >= 0 ? ((rr >> 1) & 7) : 0;
#pragma unroll
            for (int ks = 0; ks < 4; ++ks) X.x[ks][j] = *(const LAS v4u*)(rp + 16 * ((2 * ks + hi) ^ sw)); }
#pragma unroll
        for (int i = 0; i < 4; ++i) *(LAS v4u*)(stg + i * 1024 + 16 * lane) = GR[i];
        { const int sw = (cl >> 1) & 7;
#pragma unroll
          for (int ks = 0; ks < 4; ++ks) X.g[ks] = *(const LAS bf16x8*)(stg + cl * 128 + 16 * ((2 * ks + hi) ^ sw)); }
        bf16x8 af[4];
        rg_conv(X, g, lane, cw, cb, af);
        const bf16x8 g0 = X.g[0], g1 = X.g[1], g2 = X.g[2], g3 = X.g[3];
        __builtin_amdgcn_sched_barrier(0);
        { const int kn = k < 3 ? k + 1 : k; rgp_load(R, io.wsb, row0 + 32 * kn, 128 * c + 32 * kn, g, lane); }
        __builtin_amdgcn_sched_barrier(0);
        f32x16 Z1, Z2;
        rgc_block<false, 0>(io, gwl, af, g0, g1, g, 0, lane, E0, E1, F0, F1, rc0, ch0, cp0, Z1, Z2);
        rgc_store<0>(io, stg, Z1, Z2, g, rowbase, lane);
        __builtin_amdgcn_sched_barrier(0);
        rgc_block<false, 1>(io, gwl, af, g2, g3, g, 0, lane, E0, E1, F0, F1, rc1, ch1, cp1, Z1, Z2);
        __builtin_amdgcn_sched_barrier(0);
        rgc_store<1>(io, stg, Z1, Z2, g, rowbase, lane);
    }
    if (hi == 0) { const size_t o = ((size_t)bu * 16 + c) * LRU + g * 64 + cl;
        ((GAS float*)io.suma)[o] = cp0; ((GAS float*)io.sumh)[o] = ch0; ((GAS float*)io.suma)[o + 32] = cp1; ((GAS float*)io.sumh)[o + 32] = ch1; }
    if (c == 15) {
#pragma unroll
        for (int j = 0; j < 3; ++j) { const unsigned short xv = ((const GAS bf16*)io.proj)[(size_t)(bu * SEQ + SEQ - 3 + j) * NIN + 1536 + g * 64 + lane];
            ((GAS float*)io.out)[OFF_NCP + ((size_t)bu * 3 + j) * LRU + g * 64 + lane] = __uint_as_float((unsigned)xv << 16); }
    }
}

template <int NP> struct CmbIn { float ls[NP]; v4u o[NP]; v4u y1, y2; };
template <int NP>
__device__ __forceinline__ void combine_load(CmbIn<NP>& in, const bf16* ob, const float* lse, size_t pstride_rows, size_t row, const bf16* y2_row, const bf16* mixed_row, int lane) {
    const int h = lane >> 3;
#pragma unroll
    for (int p = 0; p < NP; ++p) { in.ls[p] = ((const GAS float*)lse)[(p * pstride_rows + row) * 8 + h]; in.o[p] = *(const GAS v4u*)((const GAS bf16*)ob + (p * pstride_rows + row) * ATT + 8 * lane); }
    in.y1 = *(const GAS v4u*)((const GAS bf16*)y2_row + 8 * lane);
    in.y2 = *(const GAS v4u*)((const GAS bf16*)y2_row + LRU + 8 * lane);
}
template <int NP>
__device__ __forceinline__ void combine_finish(const CmbIn<NP>& in, const f32x4 g0, const f32x4 g1, const f32x4 r0, const f32x4 r1, const float (&hin8)[8], bf16* mixed_row, int lane) {
    float mx = NEGV;
#pragma unroll
    for (int p = 0; p < NP; ++p) mx = fmaxf(mx, in.ls[p]);
    float acc[8], wsum = 0.f;
#pragma unroll
    for (int i = 0; i < 8; ++i) acc[i] = 0.f;
#pragma unroll
    for (int p = 0; p < NP; ++p) { const float wgt = ex2(in.ls[p] - mx); wsum += wgt; const v4u o = in.o[p];
        acc[0] += wgt * bflo(o.x); acc[1] += wgt * bfhi(o.x); acc[2] += wgt * bflo(o.y); acc[3] += wgt * bfhi(o.y);
        acc[4] += wgt * bflo(o.z); acc[5] += wgt * bfhi(o.z); acc[6] += wgt * bflo(o.w); acc[7] += wgt * bfhi(o.w); }
    const v4u y1 = in.y1, y2 = in.y2;
    float rn[8];
    rn[0] = bflo(y1.x) + bflo(y2.x) * hin8[0]; rn[1] = bfhi(y1.x) + bfhi(y2.x) * hin8[1]; rn[2] = bflo(y1.y) + bflo(y2.y) * hin8[2]; rn[3] = bfhi(y1.y) + bfhi(y2.y) * hin8[3];
    rn[4] = bflo(y1.z) + bflo(y2.z) * hin8[4]; rn[5] = bfhi(y1.z) + bfhi(y2.z) * hin8[5]; rn[6] = bflo(y1.w) + bflo(y2.w) * hin8[6]; rn[7] = bfhi(y1.w) + bfhi(y2.w) * hin8[7];
    const float iw = 1.0f / wsum; float ss = 0.f, sr = 0.f;
#pragma unroll
    for (int i = 0; i < 8; ++i) { acc[i] *= iw; ss += acc[i] * acc[i]; sr += rn[i] * rn[i]; }
    const float rstd = 1.0f / sqrtf(wave_sum(ss) * (1.0f / ATT) + NORM_EPS);
    const float rstdr = 1.0f / sqrtf(wave_sum(sr) * (1.0f / LRU) + NORM_EPS);
    v4u w; w.x = cvtpk(acc[0] * rstd * g0[0], acc[1] * rstd * g0[1]); w.y = cvtpk(acc[2] * rstd * g0[2], acc[3] * rstd * g0[3]);
    w.z = cvtpk(acc[4] * rstd * g1[0], acc[5] * rstd * g1[1]); w.w = cvtpk(acc[6] * rstd * g1[2], acc[7] * rstd * g1[3]);
    NT_ST(w, (GAS v4u*)((GAS bf16*)mixed_row + 8 * lane));
    v4u z; z.x = cvtpk(rn[0] * rstdr * r0[0], rn[1] * rstdr * r0[1]); z.y = cvtpk(rn[2] * rstdr * r0[2], rn[3] * rstdr * r0[3]);
    z.z = cvtpk(rn[4] * rstdr * r1[0], rn[5] * rstdr * r1[1]); z.w = cvtpk(rn[6] * rstdr * r1[2], rn[7] * rstdr * r1[3]);
    NT_ST(z, (GAS v4u*)((GAS bf16*)mixed_row + ATT + 8 * lane));
}
template <int NP>
__device__ __forceinline__ void combine_row(const bf16* ob, const float* lse, size_t pstride_rows, size_t row, const float* attg, const float* rnng, const bf16* y2_row, const float (&hin8)[8], bf16* mixed_row, int lane) {
    CmbIn<NP> in; combine_load<NP>(in, ob, lse, pstride_rows, row, y2_row, mixed_row, lane);
    const f32x4 g0 = *(const GAS f32x4*)((const GAS float*)attg + 8 * lane), g1 = *(const GAS f32x4*)((const GAS float*)attg + 8 * lane + 4);
    const f32x4 r0 = *(const GAS f32x4*)((const GAS float*)rnng + 8 * lane), r1 = *(const GAS f32x4*)((const GAS float*)rnng + 8 * lane + 4);
    combine_finish<NP>(in, g0, g1, r0, r1, hin8, mixed_row, lane);
}
__device__ __forceinline__ void combine_run(const bf16* ob, const float* lse, const float* attg, const float* rnng, const bf16* y2, const float* suma, const float* sumh, bf16* mixed, float* out, int run, int lane) {
    const int row0 = run * 16, b = row0 >> 11, c = (row0 >> 7) & 15;
    float hin[8];
#pragma unroll
    for (int i = 0; i < 8; ++i) hin[i] = 0.f;
    const GAS float* pa = (const GAS float*)suma + (size_t)b * 16 * LRU + 8 * lane; const GAS float* ph = (const GAS float*)sumh + (size_t)b * 16 * LRU + 8 * lane;
#pragma unroll 1
    for (int c0 = 0; c0 < c; c0 += 8) {
        f32x4 a0[8], a1[8], h0[8], h1[8];
#pragma unroll
        for (int u = 0; u < 8; ++u) { const int cc = c0 + u < 16 ? c0 + u : 15;
            a0[u] = *(const GAS f32x4*)(pa + cc * LRU); a1[u] = *(const GAS f32x4*)(pa + cc * LRU + 4); h0[u] = *(const GAS f32x4*)(ph + cc * LRU); h1[u] = *(const GAS f32x4*)(ph + cc * LRU + 4); }
#pragma unroll
        for (int u = 0; u < 8; ++u) { if (c0 + u < c) {
#pragma unroll
            for (int i = 0; i < 4; ++i) { hin[i] = a0[u][i] * hin[i] + h0[u][i]; hin[4 + i] = a1[u][i] * hin[4 + i] + h1[u][i]; } } }
    }
    const f32x4 g0 = *(const GAS f32x4*)((const GAS float*)attg + 8 * lane), g1 = *(const GAS f32x4*)((const GAS float*)attg + 8 * lane + 4);
    const f32x4 r0 = *(const GAS f32x4*)((const GAS float*)rnng + 8 * lane), r1 = *(const GAS f32x4*)((const GAS float*)rnng + 8 * lane + 4);
    CmbIn<3> A, B;
    combine_load<3>(A, ob, lse, (size_t)MT, (size_t)row0, y2 + (size_t)row0 * DM, mixed + (size_t)row0 * DM, lane);
#pragma unroll 1
    for (int r = 0; r < 16; r += 2) {
        { const size_t row = (size_t)row0 + r + 1; combine_load<3>(B, ob, lse, (size_t)MT, row, y2 + row * DM, mixed + row * DM, lane); }
        __builtin_amdgcn_sched_barrier(0);
        combine_finish<3>(A, g0, g1, r0, r1, hin, mixed + ((size_t)row0 + r) * DM, lane);
        __builtin_amdgcn_sched_barrier(0);
        { const size_t row = (size_t)row0 + (r + 2 < 16 ? r + 2 : r); combine_load<3>(A, ob, lse, (size_t)MT, row, y2 + row * DM, mixed + row * DM, lane); }
        __builtin_amdgcn_sched_barrier(0);
        combine_finish<3>(B, g0, g1, r0, r1, hin, mixed + ((size_t)row0 + r + 1) * DM, lane);
    }
    if ((row0 & (SEQ - 1)) == SEQ - 16) {
        const f32x4 a0 = *(const GAS f32x4*)(pa + 15 * LRU), a1 = *(const GAS f32x4*)(pa + 15 * LRU + 4), h0 = *(const GAS f32x4*)(ph + 15 * LRU), h1 = *(const GAS f32x4*)(ph + 15 * LRU + 4);
        f32x4 o0, o1;
#pragma unroll
        for (int i = 0; i < 4; ++i) { o0[i] = a0[i] * hin[i] + h0[i]; o1[i] = a1[i] * hin[4 + i] + h1[i]; }
        GAS float* po = (GAS float*)out + OFF_NHP + (size_t)b * LRU + 8 * lane; *(GAS f32x4*)po = o0; *(GAS f32x4*)(po + 4) = o1;
    }
}

template <int NR>
__device__ __forceinline__ void final_norm_rows(const bf16* xb, float* y, const float* g, int m0, int stride, int lane) {
    v2u v[NR][4];
#pragma unroll
    for (int r = 0; r < NR; ++r) { const int m = m0 + r * stride; const int mc = m < MP ? m : MP - 1; const GAS v2u* xr = (const GAS v2u*)(xb + (size_t)mc * DM) + lane;
#pragma unroll
        for (int j = 0; j < 4; ++j) v[r][j] = xr[64 * j]; }
    const GAS f32x4* gr = (const GAS f32x4*)g + lane;
    f32x4 gg[4];
#pragma unroll
    for (int j = 0; j < 4; ++j) gg[j] = gr[64 * j];
#pragma unroll
    for (int r = 0; r < NR; ++r) { const int m = m0 + r * stride;
        f32x4 a[4]; float s = 0.f;
#pragma unroll
        for (int j = 0; j < 4; ++j) { a[j] = (f32x4){bflo(v[r][j].x), bfhi(v[r][j].x), bflo(v[r][j].y), bfhi(v[r][j].y)}; s += (a[j].x * a[j].x + a[j].y * a[j].y) + (a[j].z * a[j].z + a[j].w * a[j].w); }
        const float rstd = 1.0f / sqrtf(wave_sum(s) * (1.f / DM) + NORM_EPS);
        if (m < MP) { GAS f32x4* yr = (GAS f32x4*)(y + (size_t)m * DM) + lane;
#pragma unroll
            for (int j = 0; j < 4; ++j) yr[64 * j] = a[j] * rstd * gg[j]; } }
}
__device__ __forceinline__ void final_norm_sample_row(const bf16* xb, float* y, const float* slab, const float* g, int rs, int lane) {
    GAS f32x4* yr = (GAS f32x4*)(y + (size_t)(MP + rs) * DM) + lane; const GAS f32x4* gr = (const GAS f32x4*)g + lane;
    const GAS v2u* xr = (const GAS v2u*)(xb + (size_t)(MP + rs) * DM) + lane;
    f32x4 v[4];
#pragma unroll
    for (int j = 0; j < 4; ++j) { const v2u w = xr[64 * j]; v[j] = (f32x4){bflo(w.x), bfhi(w.x), bflo(w.y), bfhi(w.y)}; }
#pragma unroll 4
    for (int s = 0; s < 16; ++s) { const GAS f32x4* sp = (const GAS f32x4*)(slab + ((size_t)s * MS + rs) * DM) + lane;
#pragma unroll
        for (int j = 0; j < 4; ++j) v[j] += sp[64 * j]; }
    float sm = 0.f;
#pragma unroll
    for (int j = 0; j < 4; ++j) sm += (v[j].x * v[j].x + v[j].y * v[j].y) + (v[j].z * v[j].z + v[j].w * v[j].w);
    const float rstd = 1.0f / sqrtf(wave_sum(sm) * (1.f / DM) + NORM_EPS);
#pragma unroll
    for (int j = 0; j < 4; ++j) yr[64 * j] = v[j] * rstd * gr[64 * j];
}

#ifndef REP_P0
#define REP_P0 1
#endif
#ifndef REP_BAR
#define REP_BAR 0
#endif
#ifndef REP_PA
#define REP_PA 1
#endif
#ifndef P6_AUXA
#define P6_AUXA 0
#endif
#ifndef PA_DUMMY
#define PA_DUMMY 0
#endif
#ifndef REP_SA
#define REP_SA 1
#endif
#ifndef REP_RG
#define REP_RG 1
#endif
#ifndef REP_P7
#define REP_P7 1
#endif
#ifndef REP_CMB
#define REP_CMB 1
#endif
#ifndef REP_P1
#define REP_P1 1
#endif
#ifndef REP_P4
#define REP_P4 1
#endif
#ifndef REP_P5
#define REP_P5 1
#endif
#ifndef LATE_W
#define LATE_W 1
#endif
#ifndef REP_ALL
#define REP_ALL 1
#endif
#ifndef REP_P6
#define REP_P6 1
#endif

#ifdef SK_PA
#define DO_PA(x)
#else
#define DO_PA(x) x
#endif
#ifdef SK_RA
#define DO_RA(x)
#else
#define DO_RA(x) x
#endif
#ifdef SK_SA
#define DO_SA(x)
#else
#define DO_SA(x) x
#endif
#ifdef SK_RB
#define DO_RB(x)
#else
#define DO_RB(x) x
#endif
#ifdef SK_RBS
#define DO_RBS(x)
#else
#define DO_RBS(x) x
#endif
#ifdef SK_GEMM
#define DO_GEMM if (0)
#else
#define DO_GEMM
#endif

#ifndef STAG1
#define STAG1 0
#endif
#ifndef STAG4
#define STAG4 0
#endif
#ifndef STAG5
#define STAG5 0
#endif
#define STAGGER(nunits, ticks) do { if ((ticks) > 0 && bx >= (nunits) % G) { const unsigned long long t0_ = __builtin_amdgcn_s_memrealtime(), d_ = (unsigned long long)(1 + ((bx >> 5) % 3)) * (ticks); \
        while (__builtin_amdgcn_s_memrealtime() - t0_ < d_) __builtin_amdgcn_s_sleep(8); } } while (0)
struct Args { const float* in[23]; float* out; unsigned char* ws; };
constexpr int NWAVES = 8;
__global__ void __launch_bounds__(NWAVES * 64, 2) hymba_fwd(Args args) {
    extern __shared__ __attribute__((aligned(16))) unsigned char lds_raw[];
    LAS unsigned char* lds = (LAS unsigned char*)lds_raw;
    volatile LAS unsigned* MISC = (volatile LAS unsigned*)(lds + MISC_OFF);
    const int wave = __builtin_amdgcn_readfirstlane((int)threadIdx.x >> 6);
    const int G = gridDim.x; const int bx = blockIdx.x; const int vcu = (G % 8 == 0) ? (bx % 8) * (G / 8) + bx / 8 : bx;
    const int gw = vcu * NWAVES + wave, NGW = G * NWAVES;
    unsigned char* ws = args.ws;
    gu32* ctl = (gu32*)(ws + WS_CTL);
    const float* x_prompt = args.in[0]; const float* x_sample = args.in[1]; const float* cache_k = args.in[2]; const float* cache_v = args.in[3];
    const float* state_conv = args.in[4]; const float* state_h = args.in[5]; const float* norm1_g = args.in[6]; const float* w_in = args.in[7];
    const float* rel_bias = args.in[8]; const float* conv_w = args.in[9]; const float* conv_b = args.in[10]; const float* gate_a_w = args.in[11];
    const float* gate_a_b = args.in[12]; const float* gate_x_w = args.in[13]; const float* gate_x_b = args.in[14]; const float* lru_lambda = args.in[15];
    const float* att_out_g = args.in[16]; const float* rnn_out_g = args.in[17]; const float* w_out = args.in[18]; const float* norm2_g = args.in[19];
    const float* w_mlp_in = args.in[20]; const float* w_mlp_out = args.in[21]; const float* final_g = args.in[22];
    float* out = args.out;
    bf16* Win_t = (bf16*)(ws + WS_WIN); bf16* Wout_t = (bf16*)(ws + WS_WOUT); bf16* W1_t = (bf16*)(ws + WS_W1); bf16* W2_t = (bf16*)(ws + WS_W2); bf16* GW = (bf16*)(ws + WS_GW);
    float* SS1 = (float*)(ws + WS_SS1); float* SUMA = (float*)(ws + WS_SUMA); float* SUMH = (float*)(ws + WS_SUMH); bf16* Y2B = (bf16*)(ws + WS_Y2); float* SLAB = (float*)(ws + WS_SLAB);
    float* LSE = (float*)(ws + WS_LSE); float* LSES = (float*)(ws + WS_LSES); bf16* OBS = (bf16*)(ws + WS_OBS); bf16* OB = (bf16*)(ws + WS_OB);
    bf16* XN = (bf16*)(ws + WS_XN); bf16* PROJ = (bf16*)(ws + WS_PROJ); bf16* MIXED = (bf16*)(ws + WS_MIXED); bf16* X1B = (bf16*)(ws + WS_X1B); bf16* HB = (bf16*)(ws + WS_HB);

    for (int u = wave * 64 + lane_id_now(); u < (LDS_BYTES - LDSCTL_OFF) / 4; u += NWAVES * 64) ((LAS unsigned*)(lds + LDSCTL_OFF))[u] = 0u;
    __syncthreads();
    XcdBarrier bar = xcd_barrier_post((unsigned*)(ctl + CW_BAR), MISC + 8, wave);

    for (int rep_ = 0; rep_ < REP_P0; ++rep_) {
        const int lane0 = lane_id_now();
        LAS float* scr = (LAS float*)(lds + RING_OFF + wave * 16384);
        constexpr int I_IN = (DM / 64) * (NIN / 32), I_O = (DM / 64) * (DM / 32), I_1 = (DM / 64) * (FF / 32), I_2 = (FF / 64) * (DM / 32);
        constexpr int NITEMS = I_IN + I_O + I_1 + I_2;
        for (int it = gw; it < (LATE_W ? I_IN : NITEMS); it += NGW) {
            int r = it;
            if (r < I_IN) { p0_transpose_item(w_in, nullptr, DM, NIN, Win_t, scr, r, lane0); continue; } r -= I_IN;
            if (r < I_O) { p0_transpose_item(w_out, nullptr, DM, DM, Wout_t, scr, r, lane0); continue; } r -= I_O;
            if (r < I_1) { p0_transpose_item(w_mlp_in, norm2_g, DM, FF, W1_t, scr, r, lane0); continue; } r -= I_1;
            p0_transpose_item(w_mlp_out, nullptr, FF, DM, W2_t, scr, r, lane0);
        }
        for (int idx = gw * 64 + lane0; idx < 2 * 8 * 64 * 64; idx += NGW * 64) {
            const int mat = idx >> 15, g = (idx >> 12) & 7, o = (idx >> 6) & 63, i = idx & 63;
            const float v = (mat ? gate_x_w : gate_a_w)[g * 4096 + i * 64 + o];
            GW[idx] = (bf16)(cvtpk(v, v) & 0xffffu);
        }
        for (int idx = gw * 64 + lane0; idx < NTAB; idx += NGW * 64) ((float*)(ws + WS_TAB))[idx] = table_entry(rel_bias, idx);
        for (int idx = gw * 64 + lane0; idx < (DECB + 1) * 3 * LRU; idx += NGW * 64) { const float v = idx < DECB * 3 * LRU ? state_conv[idx] : 0.f; ((bf16*)(ws + WS_XRS))[idx] = (bf16)(cvtpk(v, v) & 0xffffu); }
        for (int m0 = gw; m0 < MT; m0 += 4 * NGW) rms_rows_to_bf16<4>(x_prompt, x_sample, norm1_g, XN, m0, NGW, lane0);
    }
    xcd_barrier(bar);

    {
        pg8::Gemm g{XN, Win_t, MT, NIN, DM}; pg8::StaticOrder S; S.init(MT, NIN, G, bx);
        pg8::EpiInProj E{PROJ, out, QSCALE};
        STAGGER(1320, STAG1);
        for (int rep_ = 0; rep_ < REP_P1; ++rep_) { DO_GEMM pg8::gemm_phase<pg8::EpiInProj, pg8::StaticOrder, true, true>(lds + RING_OFF, g, S, E, wave); }
        constexpr int TAIL1 = ((MT / 256) * (NIN / 256)) % 256;
        if (LATE_W) {
            const bool all = (G != 256);
            if (all || bx >= TAIL1) {
                __syncthreads();
                const int lane1 = lane_id_now();
                LAS float* scr = (LAS float*)(lds + RING_OFF + wave * 16384);
                constexpr int I_O = (DM / 64) * (DM / 32), I_1 = (DM / 64) * (FF / 32), I_2 = (FF / 64) * (DM / 32);
                const int w2 = ((all ? bx : bx - TAIL1) * NWAVES + wave), nw2 = (all ? G : G - TAIL1) * NWAVES;
                for (int it = w2; it < I_O + I_1 + I_2; it += nw2) {
                    int r = it;
                    if (r < I_O) { p0_transpose_item(w_out, nullptr, DM, DM, Wout_t, scr, r, lane1); continue; } r -= I_O;
                    if (r < I_1) { p0_transpose_item(w_mlp_in, norm2_g, DM, FF, W1_t, scr, r, lane1); continue; } r -= I_1;
                    p0_transpose_item(w_mlp_out, nullptr, FF, DM, W2_t, scr, r, lane1);
                }
            }
        }
    }
    xcd_barrier(bar);

    {
        const int rgg = vcu & 7;
        const int lane = lane_id_now();
        build_tables(lds, (const float*)(ws + WS_TAB), conv_w, conv_b, GW, rgg, wave * 64 + lane);
        __syncthreads();
        const LAS float* btab = (const LAS float*)(lds + BT_OFF); const LAS float* tabS = (const LAS float*)(lds + TS_OFF);
        const LAS float* cw = (const LAS float*)(lds + CW_OFF); const LAS float* cb = (const LAS float*)(lds + CB_OFF);
        const RgIo io{PROJ, ws, state_h, gate_a_b, gate_x_b, lru_lambda, GW, MIXED, Y2B, SUMA, SUMH, out};
        const int sagrp = gw % 3;
#define SA_PASS() do { for (int rep_ = 0; rep_ < REP_SA; ++rep_) for (int id = gw; id < 4096; id += NGW) sa_task(PROJ, cache_k, cache_v, OBS, LSES, tabS, lds + STG_OFF + wave * 4096, id, lane); } while (0)
#define PA_PASS(lo, hi) do { for (int rep_ = 0; rep_ < REP_PA; ++rep_) for (int id = gw + (lo) * NGW; id < 24576 && id < (hi); id += NGW) \
        pa_task(PROJ, rep_ ? (bf16*)HB : OB, rep_ ? (float*)(HB + (size_t)MT * 2048) : LSE, out, btab, lds + STG_OFF + wave * 4096, id, lane, rep_ ? PA_DUMMY : 0); } while (0)
        if (sagrp == 0) SA_PASS();
        PA_PASS(0, gw + 6 * NGW);
        if (sagrp == 1) SA_PASS();
        PA_PASS(6, 24576);
        { const LAS unsigned char* gwl = lds + GWL_OFF;
          for (int rep_ = 0; rep_ < REP_RG; ++rep_) { for (int bc = (vcu >> 3) * NWAVES + wave; bc < 256; bc += (G >> 3) * NWAVES) rgp_task(io, cw, cb, gwl, lds + STG_OFF + wave * 4096, lds + HAL_OFF + wave * 1024, rgg, bc, lane);
              if (wave == NWAVES - 1) for (int bc = vcu >> 3; bc < 32; bc += (G >> 3)) rgc_task<true>(io, cw, cb, gwl, lds + STG_OFF + wave * 4096, rgg, bc, lane); } }
        if (sagrp == 2) SA_PASS();
#undef SA_PASS
#undef PA_PASS
    }
    xcd_barrier(bar);

    for (int rep_ = 0; rep_ < REP_BAR; ++rep_) xcd_barrier(bar);
    for (int rep_ = 0; rep_ < REP_CMB; ++rep_) {
        const int lane3 = lane_id_now();
        for (int run = gw; run < MP / 16; run += NGW) combine_run(OB, LSE, att_out_g, rnn_out_g, Y2B, SUMA, SUMH, MIXED, out, run, lane3);
        const float hz[8] = {0.f, 0.f, 0.f, 0.f, 0.f, 0.f, 0.f, 0.f};
        for (int rs = gw; rs < MS; rs += NGW) combine_row<4>(OBS, LSES, (size_t)MS, (size_t)rs, att_out_g, rnn_out_g, Y2B + (size_t)(MP + rs) * DM, hz, MIXED + (size_t)(MP + rs) * DM, lane3);
    }
    xcd_barrier(bar);

    {
        const int NSW = 16, GB = G - NSW;
        pg8::StaticOrder S4p; S4p.init(MP, DM, G, bx); pg8::StaticOrder S4s; S4s.init(MS, DM, G, bx); pg8::StaticOrder S5; S5.init(MT, FF, G, bx);
        const pg8::Gemm g4{MIXED, Wout_t, MT, DM, DM}; const pg8::Gemm g5{X1B, W1_t, MT, FF, DM};
        const pg8::EpiWout E4{x_prompt, x_sample, X1B, SS1}; const pg8::EpiUp E5{HB, SS1};
        { const pg8::RangeOrder R{S4p, 0, (MP / 256) * (DM / 256), G, bx, 0};
          for (int rep_ = 0; rep_ < REP_P4; ++rep_) { DO_GEMM pg8::gemm_phase<pg8::EpiWout, pg8::RangeOrder, true, true>(lds + RING_OFF, g4, R, E4, wave); } }
        xcd_barrier(bar);
        if (bx >= GB) { const pg8::RangeOrder R{S4s, 0, (MS / 256) * (DM / 256), NSW, bx - GB, MP / 256};
          DO_GEMM pg8::gemm_phase<pg8::EpiWout, pg8::RangeOrder, true, true>(lds + RING_OFF, g4, R, E4, wave); }
        else { const pg8::RangeOrder R{S5, 0, 2 * GB, GB, bx, 0};
          DO_GEMM pg8::gemm_phase<pg8::EpiUp, pg8::RangeOrder, true, true>(lds + RING_OFF, g5, R, E5, wave); }
        xcd_barrier(bar);
        { const pg8::RangeOrder R{S5, 2 * GB, (MT / 256) * (FF / 256), G, bx, 0};
          for (int rep_ = 0; rep_ < REP_P5; ++rep_) { DO_GEMM pg8::gemm_phase<pg8::EpiUp, pg8::RangeOrder, true, true>(lds + RING_OFF, g5, R, E5, wave); } }
    }
    xcd_barrier(bar);

    {
        { pg8::Gemm g{HB, W2_t, MP, DM, FF}; pg8::StaticOrder S; S.init(MP, DM, G, bx);
          for (int rep_ = 0; rep_ < REP_P6; ++rep_) { pg8::EpiDown E{X1B, rep_ + 1 < REP_P6 ? XN : X1B};
          DO_GEMM pg8::gemm_phase<pg8::EpiDown, pg8::StaticOrder, true, true>(lds + RING_OFF, g, S, E, wave); } }
        __syncthreads();
        { pg8::Gemm g2{(const bf16*)(args.ws + WS_HB), (const bf16*)(args.ws + WS_W2), MT, DM, 256, FF}; const pg8::SplitKOrder S2{(int)gridDim.x, (int)blockIdx.x, 16};
          pg8::EpiSlab E2{(float*)(args.ws + WS_SLAB)};
          DO_GEMM pg8::gemm_phase<pg8::EpiSlab, pg8::SplitKOrder, false, false>(lds + RING_OFF, g2, S2, E2, wave); }
    }
    xcd_barrier(bar);

    for (int rep7_ = 0; rep7_ < REP_P7; ++rep7_) {
    const int lane7 = lane_id_now();
    for (int m0 = gw; m0 < MP; m0 += 8 * NGW) final_norm_rows<8>(X1B, out + OFF_Y, final_g, m0, NGW, lane7);
    for (int rs = NGW - 1 - gw; rs < MS; rs += NGW) final_norm_sample_row(X1B, out + OFF_Y, SLAB, final_g, rs, lane7);
    }
}

extern "C" void kernel_launch(void* const* d_in, const int* in_sizes, int n_in, void* d_out, int out_size, void* d_ws, size_t ws_size, hipStream_t stream) {
    static int grid = 0;
    if (grid == 0) {
        if (n_in != 23 || in_sizes[0] != MP * DM || (size_t)out_size != OUT_TOTAL || ws_size < WS_END) {
            fprintf(stderr, "kernel_launch: shape mismatch: n_in %d in0 %d out %d ws %zu (need %zu); nothing launched\n", n_in, n_in > 0 ? in_sizes[0] : -1, out_size, ws_size, (size_t)WS_END); grid = -1; return; }
        int dev = 0, cus = 0, per_cu = 0;
        if (hipGetDevice(&dev) != hipSuccess || hipDeviceGetAttribute(&cus, hipDeviceAttributeMultiprocessorCount, dev) != hipSuccess) { fprintf(stderr, "kernel_launch: device query failed\n"); grid = -1; return; }
        if (hipFuncSetAttribute((const void*)hymba_fwd, hipFuncAttributeMaxDynamicSharedMemorySize, LDS_BYTES) != hipSuccess) { fprintf(stderr, "kernel_launch: hipFuncSetAttribute failed\n"); grid = -1; return; }
        if (hipOccupancyMaxActiveBlocksPerMultiprocessor(&per_cu, (const void*)hymba_fwd, NWAVES * 64, LDS_BYTES) != hipSuccess || per_cu < 1)
            fprintf(stderr, "kernel_launch: note: occupancy query reports %d workgroups per CU\n", per_cu);
        (void)hipGetLastError();
        if (cus <= 32) { fprintf(stderr, "kernel_launch: this kernel's unit dealing needs more than 32 CUs (device has %d); nothing launched\n", cus); grid = -1; return; }
        grid = cus;
    }
    if (grid < 0) return;
    if (hipMemsetAsync((char*)d_ws + WS_CTL, 0, CTL_ZERO_BYTES, stream) != hipSuccess) { fprintf(stderr, "kernel_launch: memset failed\n"); return; }
    Args a{};
    for (int i = 0; i < 23; ++i) a.in[i] = (const float*)d_in[i];
    a.out = (float*)d_out; a.ws = (unsigned char*)d_ws;
#ifdef REP_LAUNCH
    for (int r_ = 1; r_ < REP_LAUNCH; ++r_) { hipLaunchKernelGGL(hymba_fwd, dim3(grid), dim3(NWAVES * 64), LDS_BYTES, stream, a); (void)hipMemsetAsync((char*)d_ws + WS_CTL, 0, CTL_ZERO_BYTES, stream); }
#endif
    hipLaunchKernelGGL(hymba_fwd, dim3(grid), dim3(NWAVES * 64), LDS_BYTES, stream, a);
    const hipError_t le = hipPeekAtLastError();
    if (le != hipSuccess) fprintf(stderr, "kernel_launch: launch failed: %s\n", hipGetErrorName(le));
}
```

```cpp
#include <hip/hip_runtime.h>
#include <cstdio>
#include <cstdint>

constexpr int DM = 1024, NB = 16, SEQ = 2048, DECB = 128, DECT = 8, NH = 8, HD = 64, ATT = 512, LRU = 512, FF = 4096, NIN = 2560;
constexpr int MP = NB * SEQ;
constexpr int MS = DECB * DECT;
constexpr int MT = MP + MS;
constexpr int NCACHE = 2048;
constexpr float NORM_EPS = 1e-6f;
constexpr float NEGV = -1e30f;
constexpr float LOG2E = 1.4426950408889634f;
constexpr float QSCALE = 0.125f * LOG2E;
constexpr size_t OFF_Y = 0;
constexpr size_t OFF_NKP = (size_t)MT * DM;
constexpr size_t OFF_NVP = OFF_NKP + (size_t)MP * ATT;
constexpr size_t OFF_NCP = OFF_NVP + (size_t)MP * ATT;
constexpr size_t OFF_NHP = OFF_NCP + (size_t)NB * 3 * LRU;
constexpr size_t OFF_NKS = OFF_NHP + (size_t)NB * LRU;
constexpr size_t OFF_NVS = OFF_NKS + (size_t)MS * ATT;
constexpr size_t OFF_NCS = OFF_NVS + (size_t)MS * ATT;
constexpr size_t OFF_NHS = OFF_NCS + (size_t)DECB * 3 * LRU;
constexpr size_t OUT_TOTAL = OFF_NHS + (size_t)DECB * LRU;
static_assert(OUT_TOTAL == 69500928, "output size");

namespace pg8 {
#define PG8_LAS __attribute__((address_space(3)))
typedef unsigned short bf16_t;
typedef short bf16x8 __attribute__((ext_vector_type(8)));
typedef float f32x4 __attribute__((ext_vector_type(4)));
typedef unsigned u32x4 __attribute__((ext_vector_type(4)));
constexpr int BM = 256, BK = 64, HALF = 128, HTB = HALF * BK * 2  , STAGE_BYTES = 8 * HTB, NXCD = 8, WGM = 8;

__host__ __device__ __forceinline__ int lds_byte(int r, int c) { const int st = (r >> 4) * 2 + (c >> 5), rr = r & 15, cc = c & 31, ob = rr * 64 + cc * 2; return st * 1024 + (ob ^ (((ob >> 9) & 1) << 5)); }
__host__ __device__ __forceinline__ void stage_rc(int b, int& R, int& C) { const int st = b / 1024, sb = b % 1024, swz = sb ^ (((sb >> 9) & 1) << 5); R = (st >> 1) * 16 + swz / 64; C = (st & 1) * 32 + (swz % 64) / 2; }
__host__ __device__ __forceinline__ int perm32(int rho) { const int n = rho >> 4, i = rho & 15; return 8 * (i >> 2) + 4 * n + (i & 3); }

struct Unit { int pm, pn; int ko = 0; };
struct Gemm { const bf16_t* A; const bf16_t* Bt; int M, N, K; int ld = 0; };

struct StaticOrder {
    int nM, nN, nwg, G, c;
    __host__ __device__ void init(int M, int N, int G_, int c_) { nM = M / BM; nN = N / BM; nwg = nM * nN; G = G_; c = c_; }
    __host__ __device__ bool next(int i, Unit& u) const {
        const long L = (long)i * G + c; if (L >= nwg) return false;
        int wgid = (int)L; { const int q = nwg / NXCD, r = nwg % NXCD, xcd = wgid % NXCD, off = wgid / NXCD; wgid = (xcd < r ? xcd * (q + 1) : r * (q + 1) + (xcd - r) * q) + off; }
        const int nig = WGM * nN, gid = wgid / nig, fm = gid * WGM, gsz = (nM - fm) < WGM ? (nM - fm) : WGM;
        u.pm = fm + ((wgid % nig) % gsz); u.pn = (wgid % nig) / gsz; return true;
    }
    __device__ __forceinline__ void a_ready(const Unit&) const {}
    __device__ __forceinline__ void done(const Unit&) const {}
};

__device__ __forceinline__ unsigned cvt_pk_bf16(float lo, float hi) { unsigned r; asm volatile("v_cvt_pk_bf16_f32 %0, %1, %2" : "=v"(r) : "v"(lo), "v"(hi)); return r; }
__device__ __forceinline__ u32x4 pack8(const f32x4 v0, const f32x4 v1) { u32x4 w; w.x = cvt_pk_bf16(v0[0], v0[1]); w.y = cvt_pk_bf16(v0[2], v0[3]); w.z = cvt_pk_bf16(v1[0], v1[1]); w.w = cvt_pk_bf16(v1[2], v1[3]); return w; }

struct EpiInProj {
    static constexpr bool PERM = true, AFTER_DRAIN = false;
    bf16_t* proj; float* out; float qscale;
    __device__ __forceinline__ void operator()(const f32x4 (&acc)[2][2][4][2], const Unit& u, int wr, int wc, int fr, int fq) const {
        const int row0 = u.pm * BM + wr * 64 + fr, col0 = u.pn * BM + wc * 32 + 8 * fq;
        const int kind = u.pn >> 1;
        const float sc = (kind == 0) ? qscale : 1.f;
        float* fdst = nullptr;
        const bool smp = u.pm >= (MP / BM);
        if (smp && (kind == 1 || kind == 2)) {
            const size_t off = smp ? (kind == 1 ? OFF_NKS : OFF_NVS) : (kind == 1 ? OFF_NKP : OFF_NVP);
            const int frow = smp ? row0 - MP : row0;
            fdst = out + off + (size_t)frow * ATT + (col0 - kind * ATT);
        }
#pragma unroll
        for (int ai = 0; ai < 2; ++ai)
#pragma unroll
            for (int m = 0; m < 4; ++m) { bf16_t* rowp = proj + (size_t)(row0 + ai * HALF + m * 16) * NIN + col0;
#pragma unroll
                for (int bj = 0; bj < 2; ++bj) { const f32x4 v0 = acc[ai][bj][m][0] * sc, v1 = acc[ai][bj][m][1] * sc;
                    *(u32x4*)(rowp + bj * HALF) = pack8(v0, v1);
                    if (fdst) { float* fp = fdst + (size_t)(ai * HALF + m * 16) * ATT + bj * HALF; *(f32x4*)fp = v0; *(f32x4*)(fp + 4) = v1; } } }
    }
};
struct EpiWout {
    static constexpr bool PERM = true, AFTER_DRAIN = false;
    const float* xp; const float* xs; bf16_t* x1b; float* ss1;
    __device__ __forceinline__ void operator()(const f32x4 (&acc)[2][2][4][2], const Unit& u, int wr, int wc, int fr, int fq) const {
        const int row0 = u.pm * BM + wr * 64 + fr, col0 = u.pn * BM + wc * 32 + 8 * fq;
        const float* xin = (u.pm >= (MP / BM)) ? xs + (size_t)(row0 - MP) * DM : xp + (size_t)row0 * DM;
#pragma unroll
        for (int ai = 0; ai < 2; ++ai)
#pragma unroll
            for (int m = 0; m < 4; ++m) { const int dr = ai * HALF + m * 16; const float* xr = xin + (size_t)dr * DM + col0; bf16_t* br = x1b + (size_t)(row0 + dr) * DM + col0;
                float ss = 0.f;
#pragma unroll
                for (int bj = 0; bj < 2; ++bj) { const f32x4 a0 = *(const f32x4*)(xr + bj * HALF), a1 = *(const f32x4*)(xr + bj * HALF + 4);
                    const f32x4 v0 = acc[ai][bj][m][0] + a0, v1 = acc[ai][bj][m][1] + a1;
                    *(u32x4*)(br + bj * HALF) = pack8(v0, v1);
                    ss += (v0[0] * v0[0] + v0[1] * v0[1]) + (v0[2] * v0[2] + v0[3] * v0[3]) + (v1[0] * v1[0] + v1[1] * v1[1]) + (v1[2] * v1[2] + v1[3] * v1[3]); }
                ss += __shfl_xor(ss, 16); ss += __shfl_xor(ss, 32);
                if (fq == 0) ss1[(size_t)(row0 + dr) * 16 + u.pn * 4 + wc] = ss; }
    }
};
struct EpiUp {
    static constexpr bool PERM = true, AFTER_DRAIN = false;
    bf16_t* hb; const float* ss1;
    __device__ __forceinline__ void operator()(const f32x4 (&acc)[2][2][4][2], const Unit& u, int wr, int wc, int fr, int fq) const {
        const int row0 = u.pm * BM + wr * 64 + fr, col0 = u.pn * BM + wc * 32 + 8 * fq;
        float rs2[2];
#pragma unroll
        for (int t = 0; t < 2; ++t) { const int r = row0 + (fq >> 1) * HALF + (2 * (fq & 1) + t) * 16; const f32x4* sp = (const f32x4*)(ss1 + (size_t)r * 16);
            const f32x4 s0 = sp[0], s1 = sp[1], s2 = sp[2], s3 = sp[3]; const f32x4 s = (s0 + s1) + (s2 + s3);
            rs2[t] = 1.0f / sqrtf(((s[0] + s[1]) + (s[2] + s[3])) * (1.0f / DM) + NORM_EPS); }
        float rstd[8];
#pragma unroll
        for (int e = 0; e < 8; ++e) rstd[e] = __shfl((e & 1) ? rs2[1] : rs2[0], (e >> 1) * 16 + fr);
#pragma unroll
        for (int ai = 0; ai < 2; ++ai)
#pragma unroll
            for (int m = 0; m < 4; ++m) { bf16_t* rowp = hb + (size_t)(row0 + ai * HALF + m * 16) * FF + col0; const float rs = rstd[ai * 4 + m];
#pragma unroll
                for (int bj = 0; bj < 2; ++bj) { f32x4 v0 = acc[ai][bj][m][0] * rs, v1 = acc[ai][bj][m][1] * rs;
#pragma unroll
                    for (int i = 0; i < 4; ++i) { const float a = fmaxf(v0[i], 0.f), b = fmaxf(v1[i], 0.f); v0[i] = a * a; v1[i] = b * b; }
                    *(u32x4*)(rowp + bj * HALF) = pack8(v0, v1); } }
    }
};
struct EpiDown {
    static constexpr bool PERM = true, AFTER_DRAIN = false;
    bf16_t* xb; bf16_t* xd;
    __device__ __forceinline__ void operator()(const f32x4 (&acc)[2][2][4][2], const Unit& u, int wr, int wc, int fr, int fq) const {
        const int row0 = u.pm * BM + wr * 64 + fr, col0 = u.pn * BM + wc * 32 + 8 * fq;
#pragma unroll
        for (int ai = 0; ai < 2; ++ai)
#pragma unroll
            for (int m = 0; m < 4; ++m) { const size_t ro = (size_t)(row0 + ai * HALF + m * 16) * DM + col0; bf16_t* yr = xd + ro;
#pragma unroll
                for (int bj = 0; bj < 2; ++bj) { const u32x4 w = *(const u32x4*)(xb + ro + bj * HALF);
                    const f32x4 a0 = {__uint_as_float(w.x << 16), __uint_as_float(w.x & 0xffff0000u), __uint_as_float(w.y << 16), __uint_as_float(w.y & 0xffff0000u)};
                    const f32x4 a1 = {__uint_as_float(w.z << 16), __uint_as_float(w.z & 0xffff0000u), __uint_as_float(w.w << 16), __uint_as_float(w.w & 0xffff0000u)};
                    *(u32x4*)(yr + bj * HALF) = pack8(acc[ai][bj][m][0] + a0, acc[ai][bj][m][1] + a1); } }
    }
};

struct EpiSlab {
    static constexpr bool PERM = false, AFTER_DRAIN = false;
    float* slab;
    __device__ __forceinline__ void operator()(const f32x4 (&acc)[2][2][4][2], const Unit& u, int wr, int wc, int fr, int fq) const {
        const int row0 = (u.pm - MP / BM) * BM + wr * 64 + fr, col0 = u.pn * BM + wc * 32 + 4 * fq;
        float* base = slab + (size_t)(u.ko >> 8) * MS * DM;
#pragma unroll
        for (int ai = 0; ai < 2; ++ai)
#pragma unroll
            for (int m = 0; m < 4; ++m) { float* yr = base + (size_t)(row0 + ai * HALF + m * 16) * DM + col0;
#pragma unroll
                for (int bj = 0; bj < 2; ++bj) { *(f32x4*)(yr + bj * HALF) = acc[ai][bj][m][0]; *(f32x4*)(yr + bj * HALF + 16) = acc[ai][bj][m][1]; } }
    }
};
struct SplitKOrder {
    int G, c, KS;
    __device__ __forceinline__ bool next(int i, Unit& u) const { const int L = i * G + c; if (L >= 16 * KS) return false; u.pn = L & 3; u.ko = ((L >> 2) % KS) * 256; u.pm = MP / BM + L / (4 * KS); return true; }
    __device__ __forceinline__ void a_ready(const Unit&) const {}
    __device__ __forceinline__ void done(const Unit&) const {}
};
struct RangeOrder {
    StaticOrder base; int L0, L1, step, c, pm_off;
    __device__ __forceinline__ bool next(int i, Unit& u) const { const int L = L0 + i * step + c; if (c < 0 || c >= step || L >= L1) return false;
        StaticOrder b = base; b.G = 1; b.c = L; if (!b.next(0, u)) return false; u.pm += pm_off; return true; }
    __device__ __forceinline__ void a_ready(const Unit&) const {}
    __device__ __forceinline__ void done(const Unit&) const {}
};


template <class Epi, class Sched, bool ALIGN_EPI = false, bool SP2 = false, int AUXA = 0>
__device__ __forceinline__ void gemm_phase(PG8_LAS unsigned char* lds, const Gemm g, const Sched& S, const Epi& E, const int wave_) {
    int tid_; asm volatile("v_mbcnt_lo_u32_b32 %0, -1, 0\n\tv_mbcnt_hi_u32_b32 %0, -1, %0" : "=v"(tid_)); tid_ += wave_ * 64;
    const int tid = tid_, wid = __builtin_amdgcn_readfirstlane(tid >> 6), lane = tid & 63, wr = wid >> 2, wc = wid & 3, fr = lane & 15, fq = lane >> 4;
    const int nt = g.K / BK, K = g.ld ? g.ld : g.K;
    unsigned voffA[2], voffB[2];
#pragma unroll
    for (int i = 0; i < 2; ++i) { int R, C; stage_rc(tid * 16 + i * 8192, R, C); const int Rb = Epi::PERM ? ((R & ~31) + perm32(R & 31)) : R;
        voffA[i] = (unsigned)(R * K + C) * 2u; voffB[i] = (unsigned)(Rb * K + C) * 2u; }
    const size_t kstep = (size_t)(BK * 2);
    const size_t hstep = (size_t)HALF * K * 2;
    const size_t tstep = 2 * hstep;
    const unsigned ldsw = (unsigned)wid * 1024u;
    const int aoff = lds_byte(wr * 64 + fr, fq * 8), boff = lds_byte(wc * 32 + fr, fq * 8);
#define PG8_SA(b, h) (((b) * 2 + (h)) * HTB)
#define PG8_SB(b, h) ((4 + (b) * 2 + (h)) * HTB)
#define PG8_STAGE(bufoff, gbase, voff) do { _Pragma("unroll") for (int _i = 0; _i < 2; ++_i) \
        __builtin_amdgcn_global_load_lds((const unsigned*)((const char*)(gbase) + (voff)[_i]), (PG8_LAS unsigned*)(lds + (bufoff) + ldsw + _i * 8192), 16, 0, 0); } while (0)
#define PG8_STAGEA(bufoff, gbase, voff) do { _Pragma("unroll") for (int _i = 0; _i < 2; ++_i) \
        __builtin_amdgcn_global_load_lds((const unsigned*)((const char*)(gbase) + (voff)[_i]), (PG8_LAS unsigned*)(lds + (bufoff) + ldsw + _i * 8192), 16, 0, AUXA); } while (0)
#define PG8_LDA(dst, b, h) do { _Pragma("unroll") for (int m = 0; m < 4; ++m) _Pragma("unroll") for (int k = 0; k < 2; ++k) dst[m][k] = *(const PG8_LAS bf16x8*)(lds + PG8_SA(b, h) + aoff + m * 2048 + k * 1024); } while (0)
#define PG8_LDB(dst, b, h) do { _Pragma("unroll") for (int n = 0; n < 2; ++n) _Pragma("unroll") for (int k = 0; k < 2; ++k) dst[n][k] = *(const PG8_LAS bf16x8*)(lds + PG8_SB(b, h) + boff + n * 2048 + k * 1024); } while (0)
#define PG8_MMA(ai, bj, At, Bt) do { __builtin_amdgcn_s_setprio(1); _Pragma("unroll") for (int m = 0; m < 4; ++m) _Pragma("unroll") for (int n = 0; n < 2; ++n) _Pragma("unroll") for (int k = 0; k < 2; ++k) \
        acc[ai][bj][m][n] = __builtin_amdgcn_mfma_f32_16x16x32_bf16(Bt[n][k], At[m][k], acc[ai][bj][m][n], 0, 0, 0); __builtin_amdgcn_s_setprio(0); } while (0)
#define PG8_WAIT_V(n) asm volatile("s_waitcnt vmcnt(" #n ")" ::: "memory")
#define PG8_WAIT_L(n) asm volatile("s_waitcnt lgkmcnt(" #n ")" ::: "memory")
#define PG8_BAR __builtin_amdgcn_s_barrier()
#define PG8_SCHED __builtin_amdgcn_sched_barrier(0)
    Unit cur, nxt; int ui = 0;
    if (!S.next(0, cur)) return;
    f32x4 acc[2][2][4][2];
#pragma unroll
    for (int a = 0; a < 2; ++a)
#pragma unroll
        for (int b = 0; b < 2; ++b)
#pragma unroll
            for (int m = 0; m < 4; ++m)
#pragma unroll
                for (int n = 0; n < 2; ++n) acc[a][b][m][n] = (f32x4){0.f, 0.f, 0.f, 0.f};
    bf16x8 At[4][2], B0[2][2], B1[2][2];
    const char* cA = (const char*)g.A + (size_t)cur.pm * tstep + (size_t)cur.ko * 2; const char* cB = (const char*)g.Bt + (size_t)cur.pn * tstep + (size_t)cur.ko * 2;
    S.a_ready(cur);
    if constexpr (SP2) {
        PG8_STAGE(PG8_SB(0, 0), cB, voffB); PG8_STAGE(PG8_SB(0, 1), cB + hstep, voffB); PG8_STAGEA(PG8_SA(0, 0), cA, voffA); PG8_STAGEA(PG8_SA(0, 1), cA + hstep, voffA);
        if (wr == 1) PG8_BAR;
        PG8_WAIT_V(2); PG8_BAR;
        PG8_STAGE(PG8_SB(1, 0), cB + kstep, voffB); PG8_STAGEA(PG8_SA(1, 0), cA + kstep, voffA); PG8_STAGE(PG8_SB(1, 1), cB + hstep + kstep, voffB);
        PG8_WAIT_V(6); PG8_BAR;
    } else {
        PG8_STAGE(PG8_SB(0, 0), cB, voffB); PG8_STAGEA(PG8_SA(0, 0), cA, voffA); PG8_STAGE(PG8_SB(0, 1), cB + hstep, voffB); PG8_STAGEA(PG8_SA(0, 1), cA + hstep, voffA);
        if (wr == 1) PG8_BAR;
        PG8_WAIT_V(4); PG8_BAR;
        PG8_STAGE(PG8_SB(1, 0), cB + kstep, voffB); PG8_STAGEA(PG8_SA(1, 0), cA + kstep, voffA); PG8_STAGE(PG8_SB(1, 1), cB + hstep + kstep, voffB);
        PG8_WAIT_V(6); PG8_BAR;
    }
    for (;;) {
        const bool has_next = S.next(ui + 1, nxt);
        const char* nA = has_next ? (const char*)g.A + (size_t)nxt.pm * tstep + (size_t)nxt.ko * 2 : cA; const char* nB = has_next ? (const char*)g.Bt + (size_t)nxt.pn * tstep + (size_t)nxt.ko * 2 : cB;
        for (int t = 0; t < nt; t += 2) {
            const bool last = (t == nt - 2);
            const char* a1 = cA + (size_t)(t + 1) * kstep;
            const char* a2 = last ? nA : cA + (size_t)(t + 2) * kstep; const char* b2 = last ? nB : cB + (size_t)(t + 2) * kstep;
            const char* a3 = a2 + kstep; const char* b3 = b2 + kstep;
            if (last && has_next) S.a_ready(nxt);
            if constexpr (SP2) {
            PG8_LDB(B0, 0, 0); PG8_LDB(B1, 0, 1); PG8_SCHED; PG8_LDA(At, 0, 0); PG8_STAGEA(PG8_SA(1, 1), a1 + hstep, voffA);
            PG8_WAIT_V(8); PG8_WAIT_L(0); PG8_BAR; PG8_MMA(0, 0, At, B0); PG8_MMA(0, 1, At, B1); PG8_BAR; PG8_SCHED;
            PG8_LDA(At, 0, 1); PG8_STAGE(PG8_SB(0, 0), b2, voffB); PG8_STAGE(PG8_SB(0, 1), b2 + hstep, voffB); PG8_STAGEA(PG8_SA(0, 0), a2, voffA);
            PG8_WAIT_V(8); PG8_WAIT_L(0); PG8_BAR; PG8_MMA(1, 0, At, B0); PG8_MMA(1, 1, At, B1); PG8_BAR; PG8_SCHED;
            PG8_LDB(B0, 1, 0); PG8_LDB(B1, 1, 1); PG8_SCHED; PG8_LDA(At, 1, 0); PG8_STAGEA(PG8_SA(0, 1), a2 + hstep, voffA);
            PG8_WAIT_V(8); PG8_WAIT_L(0); PG8_BAR; PG8_MMA(0, 0, At, B0); PG8_MMA(0, 1, At, B1); PG8_BAR; PG8_SCHED;
            PG8_LDA(At, 1, 1); PG8_STAGE(PG8_SB(1, 0), b3, voffB); PG8_STAGE(PG8_SB(1, 1), b3 + hstep, voffB); PG8_STAGEA(PG8_SA(1, 0), a3, voffA);
            PG8_WAIT_V(8); PG8_WAIT_L(0); PG8_BAR; PG8_MMA(1, 0, At, B0); PG8_MMA(1, 1, At, B1); PG8_BAR; PG8_SCHED;
            } else {
            PG8_LDB(B0, 0, 0); PG8_SCHED; PG8_LDA(At, 0, 0); PG8_STAGEA(PG8_SA(1, 1), a1 + hstep, voffA);
            PG8_WAIT_L(8); PG8_BAR; PG8_WAIT_L(0); PG8_MMA(0, 0, At, B0); PG8_BAR; PG8_SCHED;
            PG8_LDB(B1, 0, 1); PG8_STAGE(PG8_SB(0, 0), b2, voffB);
            PG8_BAR; PG8_WAIT_L(0); PG8_MMA(0, 1, At, B1); PG8_BAR;
            PG8_LDA(At, 0, 1); PG8_STAGEA(PG8_SA(0, 0), a2, voffA);
            PG8_BAR; PG8_WAIT_L(0); PG8_MMA(1, 0, At, B0); PG8_BAR; PG8_SCHED;
            PG8_STAGE(PG8_SB(0, 1), b2 + hstep, voffB);
            PG8_WAIT_V(6); PG8_BAR; PG8_MMA(1, 1, At, B1); PG8_BAR;
            PG8_LDB(B0, 1, 0); PG8_SCHED; PG8_LDA(At, 1, 0); PG8_STAGEA(PG8_SA(0, 1), a2 + hstep, voffA);
            PG8_WAIT_L(8); PG8_BAR; PG8_WAIT_L(0); PG8_MMA(0, 0, At, B0); PG8_BAR; PG8_SCHED;
            PG8_LDB(B1, 1, 1); PG8_STAGE(PG8_SB(1, 0), b3, voffB);
            PG8_BAR; PG8_WAIT_L(0); PG8_MMA(0, 1, At, B1); PG8_BAR;
            PG8_LDA(At, 1, 1); PG8_STAGEA(PG8_SA(1, 0), a3, voffA);
            PG8_BAR; PG8_WAIT_L(0); PG8_MMA(1, 0, At, B0); PG8_BAR; PG8_SCHED;
            PG8_STAGE(PG8_SB(1, 1), b3 + hstep, voffB);
            PG8_WAIT_V(6); PG8_BAR; PG8_MMA(1, 1, At, B1); PG8_BAR;
            }
        }
        if constexpr (ALIGN_EPI) { if (wr == 0) PG8_BAR; }
        if constexpr (!Epi::AFTER_DRAIN) { E(acc, cur, wr, wc, fr, fq); S.done(cur); }
        if (!has_next) break;
#pragma unroll
        for (int a = 0; a < 2; ++a)
#pragma unroll
            for (int b = 0; b < 2; ++b)
#pragma unroll
                for (int m = 0; m < 4; ++m)
#pragma unroll
                    for (int n = 0; n < 2; ++n) acc[a][b][m][n] = (f32x4){0.f, 0.f, 0.f, 0.f};
        cur = nxt; cA = nA; cB = nB; ++ui;
        if constexpr (ALIGN_EPI) { if (wr == 1) PG8_BAR; }
    }
    PG8_WAIT_V(0);
    if constexpr (!ALIGN_EPI) { if (wr == 0) PG8_BAR; }
    PG8_BAR;
    if constexpr (Epi::AFTER_DRAIN) { E.fused(acc, cur, wr, wc, fr, fq, lds, wid, lane); S.done(cur); }
#undef PG8_SA
#undef PG8_SB
#undef PG8_STAGE
#undef PG8_STAGEA
#undef PG8_LDA
#undef PG8_LDB
#undef PG8_MMA
#undef PG8_WAIT_V
#undef PG8_WAIT_L
#undef PG8_BAR
#undef PG8_SCHED
}
}

constexpr size_t MiB = 1u << 20;
constexpr size_t WS_CTL = 0, CTL_ZERO_BYTES = 64 * 1024;
constexpr size_t WS_WIN = 1 * MiB;
constexpr size_t WS_WOUT = 8 * MiB;
constexpr size_t WS_W1 = 10 * MiB;
constexpr size_t WS_W2 = 18 * MiB;
constexpr size_t WS_GW = 26 * MiB;
constexpr size_t WS_TAB = 26 * MiB + 512 * 1024;
constexpr size_t WS_SS1 = 27 * MiB;
constexpr size_t WS_SUMA = 30 * MiB, WS_SUMH = 31 * MiB;
constexpr size_t WS_LSE = 32 * MiB;
constexpr size_t WS_LSES = 36 * MiB;
constexpr size_t WS_OBS = 37 * MiB;
constexpr size_t WS_XRS = 43 * MiB;
constexpr size_t WS_XN = 64 * MiB;
constexpr size_t WS_PROJ = 132 * MiB;
constexpr size_t WS_OB = 300 * MiB;
constexpr size_t WS_MIXED = 400 * MiB;
constexpr size_t WS_X1B = 468 * MiB;
constexpr size_t WS_HB = 536 * MiB;
constexpr size_t WS_Y2 = 804 * MiB;
constexpr size_t WS_SLAB = 872 * MiB;
constexpr size_t WS_END = 936 * MiB;
static_assert(WS_WIN + (size_t)NIN * DM * 2 <= WS_WOUT && WS_SS1 + (size_t)MT * 16 * 4 <= WS_SUMA && WS_LSE + (size_t)3 * MT * 8 * 4 <= WS_LSES && WS_OBS + (size_t)4 * MS * 512 * 2 <= WS_XN, "ws map 1");
static_assert(WS_XN + (size_t)MT * DM * 2 <= WS_PROJ && WS_PROJ + (size_t)MT * NIN * 2 <= WS_OB && WS_OB + (size_t)3 * MT * 512 * 2 <= WS_MIXED && WS_MIXED + (size_t)MT * DM * 2 <= WS_X1B && WS_X1B + (size_t)MT * DM * 2 <= WS_HB && WS_HB + (size_t)MT * FF * 2 <= WS_Y2 && WS_Y2 + (size_t)MT * DM * 2 <= WS_SLAB && WS_SLAB + (size_t)16 * MS * DM * 4 <= WS_END, "ws map 2");
constexpr int CW_BAR = 4096;

constexpr int RING_OFF = 0, RING_BYTES = 131072;
constexpr int LDSCTL_OFF = RING_BYTES, MISC_OFF = LDSCTL_OFF + 320;
constexpr int GWL_OFF = LDSCTL_OFF + 1024;
constexpr int HAL_OFF = GWL_OFF + 16384;
constexpr int LDS_BYTES = HAL_OFF + 8192;
constexpr int BT_OFF = 0;
constexpr int TS_OFF = 18432;
constexpr int TS_STRIDE = 2112;
constexpr int CW_OFF = TS_OFF + 8 * TS_STRIDE * 4;
constexpr int CB_OFF = CW_OFF + 8192;
constexpr int STG_OFF = CB_OFF + 2048;
static_assert(STG_OFF + 8 * 4096 <= RING_BYTES, "P2 LDS scratch");

#define GAS __attribute__((address_space(1)))
#define LAS __attribute__((address_space(3)))
typedef unsigned short bf16;
typedef unsigned v4u __attribute__((ext_vector_type(4)));
typedef unsigned v2u __attribute__((ext_vector_type(2)));
typedef float f32x4 __attribute__((ext_vector_type(4)));
typedef float f32x16 __attribute__((ext_vector_type(16)));
typedef short bf16x8 __attribute__((ext_vector_type(8)));
typedef GAS unsigned gu32;
#define RLX_AGENT __ATOMIC_RELAXED, __HIP_MEMORY_SCOPE_AGENT
#define LDS_WAIT() asm volatile("s_waitcnt lgkmcnt(0)" ::: "memory")
#define VM_WAIT() asm volatile("s_waitcnt vmcnt(0)" ::: "memory")
#define MFMA32(a, b, c) __builtin_amdgcn_mfma_f32_32x32x16_bf16((a), (b), (c), 0, 0, 0)
__device__ __forceinline__ unsigned cvtpk(float lo, float hi) { typedef float f2_t __attribute__((ext_vector_type(2))); typedef __bf16 b2_t __attribute__((ext_vector_type(2))); f2_t v = {lo, hi}; b2_t b = __builtin_convertvector(v, b2_t); return __builtin_bit_cast(unsigned, b); }
__device__ __forceinline__ float bflo(unsigned w) { return __uint_as_float(w << 16); }
__device__ __forceinline__ float bfhi(unsigned w) { return __uint_as_float(w & 0xffff0000u); }
__device__ __forceinline__ bf16x8 pack8f(const f32x4 a, const f32x4 b) { v4u p; p.x = cvtpk(a[0], a[1]); p.y = cvtpk(a[2], a[3]); p.z = cvtpk(b[0], b[1]); p.w = cvtpk(b[2], b[3]); return __builtin_bit_cast(bf16x8, p); }
template <int S> __device__ __forceinline__ bf16x8 pack_step(const f32x16& x) { v4u p; p.x = cvtpk(x[8 * S], x[8 * S + 1]); p.y = cvtpk(x[8 * S + 2], x[8 * S + 3]); p.z = cvtpk(x[8 * S + 4], x[8 * S + 5]); p.w = cvtpk(x[8 * S + 6], x[8 * S + 7]); return __builtin_bit_cast(bf16x8, p); }
__device__ __forceinline__ float lo_half(float x) { auto rr = __builtin_amdgcn_permlane32_swap(__float_as_uint(x), __float_as_uint(x), false, false); return __uint_as_float(rr[0]); }
__device__ __forceinline__ float hi_half(float x) { auto rr = __builtin_amdgcn_permlane32_swap(__float_as_uint(x), __float_as_uint(x), false, false); return __uint_as_float(rr[1]); }
__device__ __forceinline__ float ex2(float x) { return __builtin_amdgcn_exp2f(x); }
__device__ __forceinline__ f32x16 zero16() { f32x16 z;
#pragma unroll
    for (int i = 0; i < 16; ++i) z[i] = 0.f; return z; }
__device__ __forceinline__ bf16x8 make_E(int s, int lane) { const int kk = (lane & 31) - 16 * s - 8 * (lane >> 5); bf16x8 e;
#pragma unroll
    for (int i = 0; i < 8; ++i) e[i] = (i == kk) ? (short)0x3F80 : (short)0; return e; }
__device__ __forceinline__ bf16x8 make_F(int s, int lane) { const int j = lane & 31, hb = lane >> 5; const bool on = ((j >> 4) == s) && (((j >> 2) & 1) == hb); const int kk = ((j >> 3) & 1) * 4 + (j & 3); bf16x8 e;
#pragma unroll
    for (int i = 0; i < 8; ++i) e[i] = (on && i == kk) ? (short)0x3F80 : (short)0; return e; }
__device__ __forceinline__ float wave_sum(float v) {
#pragma unroll
    for (int o = 1; o < 64; o <<= 1) v += __shfl_xor(v, o);
    return v;
}
__device__ __forceinline__ int t5_bucket(int dist) {
    if (dist < 16) return dist;
    const float df = (float)dist;
    int large = 16 + (int)(logf(df / 16.0f) / 4.852030263919617f * 16.0f);
    return large < 31 ? large : 31;
}

typedef short v4i16_t __attribute__((ext_vector_type(4)));
__device__ __forceinline__ bf16x8 vt_frag(const LAS unsigned char* img, int s, int nb, int lane) {
    const int hi = lane >> 5, a = (lane >> 4) & 1, q = (lane & 15) >> 2, p = lane & 3;
    const int r0 = 16 * s + 4 * hi + q, c16 = 4 * nb + 2 * a + (p >> 1), sw = (r0 >> 1) & 7;
    const LAS unsigned char* p0 = img + r0 * 128 + 16 * (c16 ^ sw) + 8 * (p & 1);
    const LAS unsigned char* p1 = img + (r0 + 8) * 128 + 16 * (c16 ^ sw ^ 4) + 8 * (p & 1);
    const v4i16_t lo = __builtin_amdgcn_ds_read_tr16_b64_v4i16((LAS v4i16_t*)p0), hh = __builtin_amdgcn_ds_read_tr16_b64_v4i16((LAS v4i16_t*)p1);
    return __builtin_shufflevector(lo, hh, 0, 1, 2, 3, 4, 5, 6, 7);
}
__device__ __forceinline__ int lane_id_now() { int l; asm volatile("v_mbcnt_lo_u32_b32 %0, -1, 0\n\tv_mbcnt_hi_u32_b32 %0, -1, %0" : "=v"(l)); return l; }
#define XB_TMO      128
#define XB_XCNT(j)  (256  + 64 * (j))
#define XB_XSUB(j)  (1280 + 64 * (j))
#define XB_XGEN(j)  (2304 + 64 * (j))
#define XB_TOP      3328
#define XB_TOPGEN   3392
#define XCD_BAR_WORDS 3456
#define XB_SPIN_CAP (1u << 18)

__device__ __forceinline__ unsigned xb_ld(unsigned* p)              { return __hip_atomic_load(p, __ATOMIC_RELAXED, __HIP_MEMORY_SCOPE_AGENT); }
__device__ __forceinline__ unsigned xb_add(unsigned* p, unsigned v) { return __hip_atomic_fetch_add(p, v, __ATOMIC_RELAXED, __HIP_MEMORY_SCOPE_AGENT); }
__device__ __forceinline__ unsigned xb_xcc_id() { return (unsigned)__builtin_amdgcn_s_getreg((3 << 11) | 20) & 0xFu; }
#define XB_SPIN(cond, bar) do { unsigned _sp = 0; while (cond) { __builtin_amdgcn_s_sleep(1); \
    if ((++_sp & 255u) == 0u) { if (xb_ld(&(bar)[XB_TMO])) break; if (_sp > XB_SPIN_CAP) { atomicAdd(&(bar)[XB_TMO], 1u); break; } } } } while (0)

struct XcdBarrier {
    unsigned* bar; unsigned x; int w;
    volatile LAS unsigned* st;
};

__device__ __forceinline__ XcdBarrier xcd_barrier_post(unsigned* bar, volatile LAS unsigned* st, int wave) {
    XcdBarrier b; b.bar = bar; b.x = xb_xcc_id(); b.st = st; b.w = wave;
    if (wave == 0 && lane_id_now() == 0) (void)xb_add(&bar[XB_XCNT(b.x)], 1u);
    return b;
}
__device__ __forceinline__ void xcd_barrier_complete(unsigned* bar, unsigned x, unsigned& nloc, unsigned& nx) {
    const unsigned G = gridDim.x * gridDim.y * gridDim.z;
    unsigned sum, cnt, mine, sp = 0u;
    for (;;) {
        sum = 0u; cnt = 0u; mine = 0u;
#pragma unroll
        for (unsigned j = 0; j < 16; ++j) { const unsigned c = xb_ld(&bar[XB_XCNT(j)]); sum += c; cnt += (c > 0u) ? 1u : 0u; mine = (j == x) ? c : mine; }
        if (sum == G) break;
        __builtin_amdgcn_s_sleep(1);
        if ((++sp & 255u) == 0u) { if (xb_ld(&bar[XB_TMO])) break; if (sp > XB_SPIN_CAP) { atomicAdd(&bar[XB_TMO], 1u); break; } }
    }
    nloc = mine > 0u ? mine : 1u; nx = cnt > 0u ? cnt : 1u;
}

template <bool FENCE = true>
__device__ __forceinline__ void xcd_barrier(const XcdBarrier& b) {
    asm volatile("s_waitcnt vmcnt(0)" ::: "memory");
    __syncthreads();
    if (b.w == 0 && lane_id_now() == 0) {
        unsigned* bar = b.bar;
        __builtin_amdgcn_s_waitcnt(0);
        unsigned nloc = b.st[0], nx = b.st[1];
        if (nloc == 0u) { xcd_barrier_complete(bar, b.x, nloc, nx); b.st[0] = nloc; b.st[1] = nx; }
        const unsigned old = xb_add(&bar[XB_XSUB(b.x)], 1u);
        const unsigned gen = old / nloc;
        if (old + 1u == (gen + 1u) * nloc) {
            if constexpr (FENCE) __builtin_amdgcn_fence(__ATOMIC_RELEASE, "agent");
            asm volatile("s_waitcnt vmcnt(0)" ::: "memory");
            const unsigned og = xb_add(&bar[XB_TOP], 1u);
            const unsigned tg = og / nx;
            if (og + 1u == (tg + 1u) * nx) xb_add(&bar[XB_TOPGEN], 1u);
            else XB_SPIN(xb_ld(&bar[XB_TOPGEN]) == tg, bar);
            if constexpr (FENCE) __builtin_amdgcn_fence(__ATOMIC_ACQUIRE, "agent");
            xb_add(&bar[XB_XGEN(b.x)], 1u);
            asm volatile("s_waitcnt vmcnt(0)" ::: "memory");
        } else {
            XB_SPIN(xb_ld(&bar[XB_XGEN(b.x)]) == gen, bar);
            if constexpr (FENCE) __builtin_amdgcn_fence(__ATOMIC_ACQUIRE, "agent");
            asm volatile("s_waitcnt vmcnt(0)" ::: "memory");
        }
    }
    __syncthreads();
}
#ifdef NT_PHASE_OUT
#define NT_ST(v, p) __builtin_nontemporal_store((v), (p))
#else
#define NT_ST(v, p) (*(p) = (v))
#endif

__device__ __forceinline__ void p0_transpose_item(const float* W, const float* gain, int K, int N, bf16* WT, LAS float* scr, int item, int lane) {
    const int nblk = N / 32, kb = item / nblk, nb = item % nblk, k0 = 64 * kb, n0 = 32 * nb;
    const GAS float* wp = (const GAS float*)W + (size_t)(k0 + (lane >> 5)) * N + n0 + (lane & 31);
    float v[32];
#pragma unroll
    for (int i = 0; i < 32; ++i) v[i] = __builtin_nontemporal_load(wp + (size_t)(2 * i) * N);
    if (gain) {
#pragma unroll
        for (int i = 0; i < 32; ++i) v[i] *= ((const GAS float*)gain)[k0 + 2 * i + (lane >> 5)];
    }
#pragma unroll
    for (int i = 0; i < 32; ++i) scr[(2 * i + (lane >> 5)) * 33 + (lane & 31)] = v[i];
    LDS_WAIT(); asm volatile("" ::: "memory");
    const int c = lane & 7;
#pragma unroll
    for (int j = 0; j < 4; ++j) { const int n = (lane >> 3) + 8 * j; const LAS float* s = scr + (8 * c) * 33 + n;
        v4u o; o.x = cvtpk(s[0 * 33], s[1 * 33]); o.y = cvtpk(s[2 * 33], s[3 * 33]); o.z = cvtpk(s[4 * 33], s[5 * 33]); o.w = cvtpk(s[6 * 33], s[7 * 33]);
        *(GAS v4u*)(WT + (size_t)(n0 + n) * K + k0 + 8 * c) = o; }
    LDS_WAIT(); asm volatile("" ::: "memory");
}
template <int NR>
__device__ __forceinline__ void rms_rows_to_bf16(const float* xp, const float* xs, const float* g, bf16* xn, int m0, int stride, int lane) {
    f32x4 v[NR][4];
#pragma unroll
    for (int r = 0; r < NR; ++r) { const int m = m0 + r * stride; const int mc = m < MT ? m : MT - 1;
        const GAS f32x4* xr = (const GAS f32x4*)(mc < MP ? xp + (size_t)mc * DM : xs + (size_t)(mc - MP) * DM) + lane;
#pragma unroll
        for (int j = 0; j < 4; ++j) v[r][j] = __builtin_nontemporal_load(xr + 64 * j); }
    const GAS f32x4* gr = (const GAS f32x4*)g + lane;
    f32x4 gg[4];
#pragma unroll
    for (int j = 0; j < 4; ++j) gg[j] = gr[64 * j];
#pragma unroll
    for (int r = 0; r < NR; ++r) { const int m = m0 + r * stride;
        float s = 0.f;
#pragma unroll
        for (int j = 0; j < 4; ++j) s += (v[r][j].x * v[r][j].x + v[r][j].y * v[r][j].y) + (v[r][j].z * v[r][j].z + v[r][j].w * v[r][j].w);
        const float rstd = 1.0f / sqrtf(wave_sum(s) * (1.f / DM) + NORM_EPS);
        if (m < MT) { GAS v2u* o8 = (GAS v2u*)(xn + (size_t)m * DM) + lane;
#pragma unroll
            for (int j = 0; j < 4; ++j) { v2u w; w.x = cvtpk(v[r][j].x * rstd * gg[j].x, v[r][j].y * rstd * gg[j].y); w.y = cvtpk(v[r][j].z * rstd * gg[j].z, v[r][j].w * rstd * gg[j].w); NT_ST(w, o8 + 64 * j); } } }
}

__device__ __forceinline__ float table_entry(const float* rel_bias, int i) {
    if (i < 3 * 8 * 192) { const int g = i / 1536, h = (i / 192) & 7, idx = i % 192, j = idx - 31; const int dil = g == 0 ? 1 : (g == 1 ? 4 : 16);
        return (j >= 0 && j <= 128) ? rel_bias[t5_bucket(j * dil) * 8 + h] * LOG2E : NEGV; }
    i -= 3 * 8 * 192;
    const int h = i / TS_STRIDE, idx = i % TS_STRIDE, dl = idx - 8; float v = NEGV;
    if (dl >= 0 && dl <= 2055) { const int m = (dl <= 128 ? 1 : 0) + (((dl & 3) == 0 && dl <= 512) ? 1 : 0) + (((dl & 15) == 0 && dl <= 2048) ? 1 : 0);
        if (m > 0) v = (m == 1 ? 0.f : (m == 2 ? 1.f : 1.5849625007211562f)) + rel_bias[t5_bucket(dl) * 8 + h] * LOG2E; }
    return v;
}
constexpr int NTAB = 3 * 8 * 192 + 8 * TS_STRIDE;
static_assert(TS_OFF == BT_OFF + 3 * 8 * 192 * 4 && NTAB % 4 == 0, "tables are contiguous in LDS");
__device__ __forceinline__ void build_tables(LAS unsigned char* lds, const float* tab, const float* conv_w, const float* conv_b, const bf16* gw, int g, int tid) {
    for (int i = tid; i < NTAB / 4; i += 512) *(LAS f32x4*)(lds + BT_OFF + 16 * i) = *(const GAS f32x4*)((const GAS float*)tab + 4 * i);
    LAS float* cw = (LAS float*)(lds + CW_OFF);
    for (int i = tid; i < 4 * 512; i += 512) cw[i] = conv_w[i];
    LAS float* cb = (LAS float*)(lds + CB_OFF);
    for (int i = tid; i < 512; i += 512) cb[i] = conv_b[i];
    for (int i = tid; i < 1024; i += 512) { const int mat = i >> 9, orow = (i >> 3) & 63, chn = i & 7;
        const v4u v = *(const GAS v4u*)((const GAS bf16*)gw + ((size_t)(mat * 8 + g) * 64 + orow) * 64 + chn * 8);
        *(LAS v4u*)(lds + GWL_OFF + mat * 8192 + orow * 128 + 16 * (chn ^ ((orow >> 1) & 7))) = v; }
}

__device__ __forceinline__ void kv_rows_out(const v4u (&kr)[4], GAS float* dst, int lane) {
#pragma unroll
    for (int i = 0; i < 4; ++i) { const int row = 8 * i + (lane >> 3); const unsigned ch = (unsigned)((lane & 7) ^ ((row >> 1) & 7));
        GAS float* d = dst + ((unsigned)row * (unsigned)ATT + 8u * ch); const v4u w = kr[i];
        const f32x4 a = {bflo(w.x), bfhi(w.x), bflo(w.y), bfhi(w.y)}, b = {bflo(w.z), bfhi(w.z), bflo(w.w), bfhi(w.w)};
        __builtin_nontemporal_store(a, (GAS f32x4*)d); __builtin_nontemporal_store(b, (GAS f32x4*)(d + 4)); }
}
#ifndef PA_NVE
#define PA_NVE 1
#endif
template <int NT>
__device__ __forceinline__ void pa_body(const GAS bf16* proj, GAS bf16* po, GAS float* plse, const LAS float* tb0, LAS unsigned char* stg, int rowq, unsigned offk0, unsigned ostep, unsigned ostepq, int lane, const bf16x8 E0, const bf16x8 E1, GAS float* kvp, bool kvo) {
    const int hi = lane >> 5, kv = lane & 31;
    bf16x8 qf[4];
    { const GAS bf16* pq = proj + (size_t)rowq * NIN + hi * 8;
#pragma unroll
      for (int ks = 0; ks < 4; ++ks) qf[ks] = *(const GAS bf16x8*)(pq + 16 * ks); }
    constexpr int NVE = NT < PA_NVE ? NT : PA_NVE;
    v4u kr[NT][4];
#pragma unroll
    for (int j = 0; j < NT; ++j)
#pragma unroll
        for (int i = 0; i < 4; ++i) { const int row = 8 * i + (lane >> 3); const unsigned ch = (unsigned)((lane & 7) ^ ((row >> 1) & 7));
            kr[j][i] = *(const GAS v4u*)(proj + (offk0 + (unsigned)j * ostep + (unsigned)i * (ostep >> 2) + 512u + 8u * ch)); }
    LAS unsigned char* wr = stg + 16 * lane;
    const LAS unsigned char* rd0 = stg + kv * 128;
    const int sw = (kv >> 1) & 7;
    const f32x16 zero = zero16();
    f32x16 p[NT];
#pragma unroll
    for (int jj = 0; jj < NT; ++jj) { const int j = jj == 0 ? NT - 1 : jj - 1;
#pragma unroll
        for (int i = 0; i < 4; ++i) *(LAS v4u*)(wr + i * 1024) = kr[j][i];
        if (jj == 0) { if (kvo) kv_rows_out(kr[j], kvp, lane); }
        if (jj < NVE) {
#pragma unroll
            for (int i = 0; i < 4; ++i) { const int row = 8 * i + (lane >> 3); const unsigned ch = (unsigned)((lane & 7) ^ ((row >> 1) & 7));
                kr[j][i] = *(const GAS v4u*)(proj + (offk0 + (unsigned)j * ostep + (unsigned)i * (ostep >> 2) + 1024u + 8u * ch)); } }
        f32x16 a = zero;
#pragma unroll
        for (int ks = 0; ks < 4; ++ks) a = MFMA32(*(const LAS bf16x8*)(rd0 + 16 * ((2 * ks + hi) ^ sw)), qf[ks], a);
        p[j] = a;
    }
    float m = NEGV;
#pragma unroll
    for (int j = 0; j < NT; ++j) { const LAS float* tb = tb0 - 32 * (j + 5 - NT);
#pragma unroll
        for (int r = 0; r < 16; ++r) { p[j][r] += tb[27 - ((r & 3) + 8 * (r >> 2))]; m = fmaxf(m, p[j][r]); } }
    m = fmaxf(lo_half(m), hi_half(m));
    float l = 0.f;
    bf16x8 pb[NT][2];
#pragma unroll
    for (int j = 0; j < NT; ++j) {
#pragma unroll
        for (int r = 0; r < 16; ++r) { const float e = ex2(p[j][r] - m); p[j][r] = e; l += e; }
        pb[j][0] = pack_step<0>(p[j]); pb[j][1] = pack_step<1>(p[j]);
    }
    l = lo_half(l) + hi_half(l);
    __builtin_amdgcn_sched_barrier(0);
#pragma unroll
    for (int jj = NVE; jj < NT; ++jj) { const int j = jj - 1;
#pragma unroll
        for (int i = 0; i < 4; ++i) { const int row = 8 * i + (lane >> 3); const unsigned ch = (unsigned)((lane & 7) ^ ((row >> 1) & 7));
            kr[j][i] = *(const GAS v4u*)(proj + (offk0 + (unsigned)j * ostep + (unsigned)i * (ostep >> 2) + 1024u + 8u * ch)); } }
    f32x16 o0 = zero, o1 = zero;
#pragma unroll
    for (int jj = 0; jj < NT; ++jj) { const int j = jj == 0 ? NT - 1 : jj - 1;
#pragma unroll
        for (int i = 0; i < 4; ++i) *(LAS v4u*)(wr + i * 1024) = kr[j][i];
        if (jj == 0) { if (kvo) kv_rows_out(kr[j], kvp + (size_t)MP * ATT, lane); }
        const bf16x8 v0 = *(const LAS bf16x8*)(rd0 + 16 * ((0 + hi) ^ sw)), v1 = *(const LAS bf16x8*)(rd0 + 16 * ((2 + hi) ^ sw)), v2 = *(const LAS bf16x8*)(rd0 + 16 * ((4 + hi) ^ sw)), v3 = *(const LAS bf16x8*)(rd0 + 16 * ((6 + hi) ^ sw));
        f32x16 x0 = MFMA32(v0, E0, zero); x0 = MFMA32(v1, E1, x0);
        f32x16 x1 = MFMA32(v2, E0, zero); x1 = MFMA32(v3, E1, x1);
        o0 = MFMA32(pack_step<0>(x0), pb[j][0], o0); o1 = MFMA32(pack_step<0>(x1), pb[j][0], o1);
        o0 = MFMA32(pack_step<1>(x0), pb[j][1], o0); o1 = MFMA32(pack_step<1>(x1), pb[j][1], o1);
    }
    const float inv = __builtin_amdgcn_rcpf(l);
    { LAS unsigned char* wq = stg + kv * 128 + 8 * hi;
#pragma unroll
      for (int rg = 0; rg < 4; ++rg) {
        v2u w0, w1;
        w0.x = cvtpk(o0[4 * rg] * inv, o0[4 * rg + 1] * inv); w0.y = cvtpk(o0[4 * rg + 2] * inv, o0[4 * rg + 3] * inv);
        w1.x = cvtpk(o1[4 * rg] * inv, o1[4 * rg + 1] * inv); w1.y = cvtpk(o1[4 * rg + 2] * inv, o1[4 * rg + 3] * inv);
        *(LAS v2u*)(wq + 16 * (rg ^ sw)) = w0; *(LAS v2u*)(wq + 16 * ((4 + rg) ^ sw)) = w1;
      } }
#pragma unroll
    for (int i = 0; i < 4; ++i) { const int row = 8 * i + (lane >> 3); const unsigned ch = (unsigned)((lane & 7) ^ ((row >> 1) & 7));
        const v4u v = *(const LAS v4u*)(stg + i * 1024 + 16 * lane);
        *(GAS v4u*)(po + ((unsigned)i * ostepq + 8u * ch)) = v; }
    if (hi == 0) *plse = m + log2f(l);
}
__device__ __forceinline__ void pa_task(const bf16* proj, bf16* ob, float* lse, float* outp, const LAS float* btab, LAS unsigned char* stg, int id, int lane_in, const int DUMMY = 0) {
    int lane = lane_in; asm volatile("" : "+v"(lane));
    const bf16x8 E0 = make_E(0, lane), E1 = make_E(1, lane);
    const int g = id >> 13, rem = id & 8191, bh = rem >> 6, k64 = (rem + 21 * (id >> 11)) & 63, b = bh >> 3, h = bh & 7;
    int d, c, ti;
    if (g == 0) { d = 1; c = 0; ti = k64; } else if (g == 1) { d = 4; c = k64 >> 4; ti = k64 & 15; } else { d = 16; c = k64 >> 2; ti = k64 & 3; }
    const int q = lane & 31, hi = lane >> 5, i0 = ti * 32;
    const int nt = ti < 4 ? ti + 1 : 5;
    int rowq = b * SEQ + d * (i0 + q) + c;
    int rowk0 = b * SEQ + d * (i0 - 32 * (nt - 1) + (lane >> 3)) + c;
    int dd = d;
    if (DUMMY == 1) { rowq &= 63; rowk0 &= 63; dd = 0; }
    const GAS bf16* pj = (const GAS bf16*)proj + h * 64;
    const int rowq8 = (DUMMY == 1) ? ((lane >> 3) & 63) : b * SEQ + d * (i0 + (lane >> 3)) + c;
    GAS bf16* po = (GAS bf16*)ob + ((size_t)g * MT + rowq8) * ATT + h * 64;
    GAS float* pl = (GAS float*)lse + ((size_t)g * MT + rowq) * 8 + h;
    const LAS float* tb0 = btab + (g * 8 + h) * 192 + (159 - 27 + q - 4 * hi);
    const unsigned ostepq = (unsigned)(8 * dd) * (unsigned)ATT;
    const unsigned offk0 = (unsigned)rowk0 * (unsigned)NIN, ostep = (unsigned)(32 * dd) * (unsigned)NIN;
    GAS float* kvp = (GAS float*)outp + OFF_NKP + ((size_t)(b * SEQ + i0) * ATT + h * 64);
    const bool kvo = (g == 0) && (DUMMY == 0);
    if (nt == 5) pa_body<5>(pj, po, pl, tb0, stg, rowq, offk0, ostep, ostepq, lane, E0, E1, kvp, kvo);
    else if (nt == 4) pa_body<4>(pj, po, pl, tb0, stg, rowq, offk0, ostep, ostepq, lane, E0, E1, kvp, kvo);
    else if (nt == 3) pa_body<3>(pj, po, pl, tb0, stg, rowq, offk0, ostep, ostepq, lane, E0, E1, kvp, kvo);
    else if (nt == 2) pa_body<2>(pj, po, pl, tb0, stg, rowq, offk0, ostep, ostepq, lane, E0, E1, kvp, kvo);
    else pa_body<1>(pj, po, pl, tb0, stg, rowq, offk0, ostep, ostepq, lane, E0, E1, kvp, kvo);
}

struct SaHalf { f32x4 x[8]; };
__device__ __forceinline__ void sa_load(SaHalf& t, const float* c, int b, int h, int tile, int lane) {
    const int pbase = tile < 24 ? 64 * tile : 1536 + 32 * (tile - 24), strd = tile < 24 ? 16 : 8;
    const GAS float* p0 = (const GAS float*)c + ((size_t)b * NCACHE * NH + h) * HD + 4 * (lane & 15);
#pragma unroll
    for (int i = 0; i < 8; ++i) { const int r = 4 * i + (lane >> 4); const int prow = pbase + strd * (r >> 3) + (r & 7);
        t.x[i] = __builtin_nontemporal_load((const GAS f32x4*)(p0 + (size_t)prow * (NH * HD))); }
}
__device__ __forceinline__ void sa_stage(const SaHalf& t, LAS unsigned char* stg, int lane, bf16x8 (&f)[4]) {
#pragma unroll
    for (int i = 0; i < 8; ++i) { const int r = 4 * i + (lane >> 4); v2u w; w.x = cvtpk(t.x[i][0], t.x[i][1]); w.y = cvtpk(t.x[i][2], t.x[i][3]);
        *(LAS v2u*)(stg + r * 128 + 16 * (((lane & 15) >> 1) ^ ((r >> 1) & 7)) + 8 * (lane & 1)) = w; }
    const int kv = lane & 31, hi = lane >> 5, sw = (kv >> 1) & 7;
#pragma unroll
    for (int ks = 0; ks < 4; ++ks) f[ks] = *(const LAS bf16x8*)(stg + kv * 128 + 16 * ((2 * ks + hi) ^ sw));
}
__device__ __forceinline__ void sa_step(const bf16x8 (&kf)[4], const bf16x8 (&vf)[4], const bf16x8 (&qf)[4], const LAS float* ts, int dbase, int strd, float& m, float& l, f32x16& o0, f32x16& o1, const bf16x8 E0, const bf16x8 E1) {
    const f32x16 zero = zero16();
    f32x16 a = zero;
#pragma unroll
    for (int ks = 0; ks < 4; ++ks) a = MFMA32(kf[ks], qf[ks], a);
#pragma unroll
    for (int r = 0; r < 16; ++r) { int dl = dbase - strd * (r >> 2) - (r & 3); dl = dl < -1 ? -1 : dl; a[r] += ts[dl]; }
    float mx = a[0];
#pragma unroll
    for (int r = 1; r < 16; ++r) mx = fmaxf(mx, a[r]);
    mx = fmaxf(lo_half(mx), hi_half(mx));
    const float mn = fmaxf(fmaxf(m, mx), -1e20f);
    const float sc = ex2(m - mn);
    float ls = 0.f;
#pragma unroll
    for (int r = 0; r < 16; ++r) { const float e = ex2(a[r] - mn); a[r] = e; ls += e; }
    ls = lo_half(ls) + hi_half(ls);
    l = l * sc + ls; m = mn;
#pragma unroll
    for (int r = 0; r < 16; ++r) { o0[r] *= sc; o1[r] *= sc; }
    f32x16 x0 = MFMA32(vf[0], E0, zero); x0 = MFMA32(vf[1], E1, x0);
    f32x16 x1 = MFMA32(vf[2], E0, zero); x1 = MFMA32(vf[3], E1, x1);
    { const bf16x8 pb = pack_step<0>(a); o0 = MFMA32(pack_step<0>(x0), pb, o0); o1 = MFMA32(pack_step<0>(x1), pb, o1); }
    { const bf16x8 pb = pack_step<1>(a); o0 = MFMA32(pack_step<1>(x0), pb, o0); o1 = MFMA32(pack_step<1>(x1), pb, o1); }
}
__device__ __forceinline__ void sa_task(const bf16* proj, const float* ck, const float* cv, bf16* obs, float* lses, const LAS float* tabS, LAS unsigned char* stg, int id, int lane_in) {
    int lane = lane_in; asm volatile("" : "+v"(lane));
    const bf16x8 E0 = make_E(0, lane), E1 = make_E(1, lane);
    const int h = id & 7, seg = (id >> 3) & 3, b = id >> 5;
    const int q = lane & 31, hi = lane >> 5, t = q & 7;
    const int rowq = MP + b * DECT + t;
    const GAS bf16* pq = (const GAS bf16*)proj + (size_t)rowq * NIN + h * 64 + hi * 8;
    bf16x8 qf[4];
#pragma unroll
    for (int ks = 0; ks < 4; ++ks) qf[ks] = *(const GAS bf16x8*)(pq + 16 * ks);
    const int T0 = seg == 0 ? 0 : 1 + 10 * seg, T1 = 11 + 10 * seg, T1c = T1 < 40 ? T1 : 40;
    float m = NEGV, l = 0.f; f32x16 o0 = zero16(), o1 = zero16();
    const LAS float* ts = tabS + h * TS_STRIDE + 8;
    SaHalf kx, vx;
    sa_load(kx, ck, b, h, T0, lane); sa_load(vx, cv, b, h, T0, lane);
#pragma unroll 1
    for (int tile = T0; tile < T1c; ++tile) {
        const int pbase = tile < 24 ? 64 * tile : 1536 + 32 * (tile - 24), strd = tile < 24 ? 16 : 8;
        bf16x8 kf[4], vf[4];
        sa_stage(kx, stg, lane, kf); sa_stage(vx, stg, lane, vf);
        __builtin_amdgcn_sched_barrier(0);
        { const int tn = tile + 1 < T1c ? tile + 1 : tile; sa_load(kx, ck, b, h, tn, lane); sa_load(vx, cv, b, h, tn, lane); }
        __builtin_amdgcn_sched_barrier(0);
        sa_step(kf, vf, qf, ts, NCACHE + t - pbase - 4 * hi, strd, m, l, o0, o1, E0, E1);
    }
    if (T1 > 40) {
        const int rk = MP + b * DECT + (q & 7);
        const GAS bf16* pk = (const GAS bf16*)proj + (size_t)rk * NIN + 512 + h * 64 + hi * 8;
        bf16x8 kf[4], vf[4];
#pragma unroll
        for (int ks = 0; ks < 4; ++ks) { kf[ks] = *(const GAS bf16x8*)(pk + 16 * ks); vf[ks] = *(const GAS bf16x8*)(pk + 512 + 16 * ks); }
        sa_step(kf, vf, qf, ts, NCACHE + t - 2048 - 4 * hi, 8, m, l, o0, o1, E0, E1);
    }
    if (q < 8) {
        const float ll = fmaxf(l, 1e-30f), inv = 1.0f / ll;
        GAS bf16* po = (GAS bf16*)obs + ((size_t)seg * MS + b * DECT + t) * ATT + h * 64 + 4 * hi;
#pragma unroll
        for (int rg = 0; rg < 4; ++rg) {
            v2u w0, w1;
            w0.x = cvtpk(o0[4 * rg] * inv, o0[4 * rg + 1] * inv); w0.y = cvtpk(o0[4 * rg + 2] * inv, o0[4 * rg + 3] * inv);
            w1.x = cvtpk(o1[4 * rg] * inv, o1[4 * rg + 1] * inv); w1.y = cvtpk(o1[4 * rg + 2] * inv, o1[4 * rg + 3] * inv);
            *(GAS v2u*)(po + 8 * rg) = w0; *(GAS v2u*)(po + 32 + 8 * rg) = w1;
        }
        if (hi == 0) ((GAS float*)lses)[((size_t)seg * MS + b * DECT + t) * 8 + h] = m + log2f(ll);
    }
}

struct RgIo { const bf16* proj; const unsigned char* wsb; const float* sh; const float* gab; const float* gxb; const float* lam; const bf16* gw; bf16* mixed; bf16* y2; float* suma; float* sumh; float* out; };
struct RgX { v4u x[4][4]; bf16x8 g[4]; };
template <bool SAMPLE, int PART>
__device__ __forceinline__ void rg_xload(RgX& X, const unsigned char* wsb, int rowbase, int tt0, int bs0, int g, int lane) {
    const int tok = lane & 31, hi = lane >> 5;
    const int tq = SAMPLE ? (tok & 7) : (tt0 + tok);
    const GAS unsigned char* pb = (const GAS unsigned char*)wsb;
    const unsigned o0 = (unsigned)WS_PROJ + ((unsigned)(rowbase + tok) * (unsigned)NIN + (unsigned)(1536 + g * 64 + hi * 8)) * 2u;
    const unsigned os = (unsigned)WS_XRS + ((unsigned)((SAMPLE ? bs0 + (tok >> 3) : DECB) * 3) * (unsigned)LRU + (unsigned)(g * 64 + hi * 8)) * 2u;
#pragma unroll
    for (int j = (PART == 0 ? 0 : 3); j < (PART == 0 ? 3 : 4); ++j) { const int tj = tq - 3 + j; const unsigned oj = tj >= 0 ? o0 - (unsigned)((3 - j) * NIN * 2) : os + (unsigned)((3 + tj) * LRU * 2);
#pragma unroll
        for (int ks = 0; ks < 4; ++ks) X.x[ks][j] = *(const GAS v4u*)(pb + (oj + 32u * ks)); }
    if (PART == 1) {
#pragma unroll
        for (int ks = 0; ks < 4; ++ks) X.g[ks] = *(const GAS bf16x8*)(pb + (o0 + 1024u + 32u * ks));
    }
}
__device__ __forceinline__ void rg_conv(const RgX& X, int g, int lane, const LAS float* cw, const LAS float* cb, bf16x8 (&af)[4]) {
    const int hi = lane >> 5;
#pragma unroll
    for (int ks = 0; ks < 4; ++ks) {
        const int cg = g * 64 + 16 * ks + 8 * hi;
        f32x4 a0 = *(const LAS f32x4*)(cb + cg), a1 = *(const LAS f32x4*)(cb + cg + 4);
#pragma unroll
        for (int j = 0; j < 4; ++j) {
            const v4u xw = X.x[ks][j];
            const f32x4 x0 = (f32x4){bflo(xw.x), bfhi(xw.x), bflo(xw.y), bfhi(xw.y)}, x1 = (f32x4){bflo(xw.z), bfhi(xw.z), bflo(xw.w), bfhi(xw.w)};
            const f32x4 w0 = *(const LAS f32x4*)(cw + j * 512 + cg), w1 = *(const LAS f32x4*)(cw + j * 512 + cg + 4);
            a0 += w0 * x0; a1 += w1 * x1;
        }
        af[ks] = pack8f(a0, a1);
        __builtin_amdgcn_sched_barrier(0);
    }
}
struct RgConst { float ba, bx, clam; };
__device__ __forceinline__ RgConst rg_load_consts(const RgIo& io, int g, int nb, int lane) {
    RgConst rc; const int ch = g * 64 + 32 * nb + (lane & 31); rc.ba = ((const GAS float*)io.gab)[ch]; rc.bx = ((const GAS float*)io.gxb)[ch];
    rc.clam = -8.0f * log1pf(expf(-((const GAS float*)io.lam)[ch])) * LOG2E;
    return rc;
}
template <bool SAMPLE, int NB>
__device__ __forceinline__ void rgc_block(const RgIo& io, const LAS unsigned char* gwl, const bf16x8 (&af)[4], const bf16x8 gf0, const bf16x8 gf1, int g, int bs0, int lane,
                                          const bf16x8 E0, const bf16x8 E1, const bf16x8 F0, const bf16x8 F1, const RgConst rc, float& ch_, float& cp_, f32x16& Z1, f32x16& Z2) {
    const int hi = lane >> 5, cl = lane & 31, ch = g * 64 + 32 * NB + cl;
    const f32x16 zero = zero16();
    f32x16 R = zero, I = zero;
    { const int orow = 32 * NB + cl, sw = (orow >> 1) & 7; const LAS unsigned char* pa = gwl + orow * 128; const LAS unsigned char* px = pa + 8192;
#pragma unroll
      for (int ks = 0; ks < 4; ++ks) { const int pos = 16 * ((2 * ks + hi) ^ sw); R = MFMA32(af[ks], *(const LAS bf16x8*)(pa + pos), R); I = MFMA32(af[ks], *(const LAS bf16x8*)(px + pos), I); } }
    f32x16 XC = MFMA32(af[2 * NB], E0, zero); XC = MFMA32(af[2 * NB + 1], E1, XC);
    __builtin_amdgcn_sched_barrier(0);
    f32x16 A, U;
#pragma unroll
    for (int r = 0; r < 16; ++r) {
        const float rr = __builtin_amdgcn_rcpf(1.0f + ex2(-(R[r] + rc.ba) * LOG2E));
        const float ii = __builtin_amdgcn_rcpf(1.0f + ex2(-(I[r] + rc.bx) * LOG2E));
        const float a = ex2(rr * rc.clam);
        A[r] = a; U[r] = __builtin_amdgcn_sqrtf(__builtin_fmaf(-a, a, 1.0f)) * (ii * XC[r]);
    }
    __builtin_amdgcn_sched_barrier(0);
    f32x16 Gt = MFMA32(gf0, E0, zero); Gt = MFMA32(gf1, E1, Gt);
    f32x16 O1, O2;
#pragma unroll
    for (int grp = 0; grp < 4; ++grp) {
        if (SAMPLE) { ch_ = ((const GAS float*)io.sh)[(size_t)(bs0 + grp) * LRU + ch]; cp_ = 0.f; }
        float h0 = ch_, p0 = cp_, hv0[4], hv1[4], pv0[4], pv1[4];
#pragma unroll
        for (int kk = 0; kk < 4; ++kk) { h0 = A[4 * grp + kk] * h0 + U[4 * grp + kk]; p0 *= A[4 * grp + kk]; hv0[kk] = h0; pv0[kk] = p0; }
        float h1 = lo_half(h0), p1 = lo_half(p0);
#pragma unroll
        for (int kk = 0; kk < 4; ++kk) { h1 = A[4 * grp + kk] * h1 + U[4 * grp + kk]; p1 *= A[4 * grp + kk]; hv1[kk] = h1; pv1[kk] = p1; }
        ch_ = hi_half(h1); cp_ = hi_half(p1);
        if (SAMPLE) { if (hi == 0) ((GAS float*)io.out)[OFF_NHS + (size_t)(bs0 + grp) * LRU + ch] = ch_; }
#pragma unroll
        for (int kk = 0; kk < 4; ++kk) { const float x = Gt[4 * grp + kk];
            const float gl = x * __builtin_amdgcn_rcpf(1.0f + ex2(-2.3022081984f * (x + 0.044715f * x * x * x)));
            O1[4 * grp + kk] = (hi ? hv1[kk] : hv0[kk]) * gl; O2[4 * grp + kk] = (hi ? pv1[kk] : pv0[kk]) * gl; }
    }
    __builtin_amdgcn_sched_barrier(0);
    Z1 = MFMA32(pack_step<0>(O1), F0, zero); Z1 = MFMA32(pack_step<1>(O1), F1, Z1);
    Z2 = MFMA32(pack_step<0>(O2), F0, zero); Z2 = MFMA32(pack_step<1>(O2), F1, Z2);
}
template <int NB>
__device__ __forceinline__ void rgc_store(const RgIo& io, LAS unsigned char* stg, const f32x16& Z1, const f32x16& Z2, int g, int rowbase, int lane) {
    const int hi = lane >> 5, cl = lane & 31, sw = (cl >> 1) & 7;
    LAS unsigned char* wq = stg + cl * 128 + 8 * hi;
#pragma unroll
    for (int rg = 0; rg < 4; ++rg) { v2u w; w.x = cvtpk(Z1[4 * rg], Z1[4 * rg + 1]); w.y = cvtpk(Z1[4 * rg + 2], Z1[4 * rg + 3]); *(LAS v2u*)(wq + 16 * (rg ^ sw)) = w;
        v2u y; y.x = cvtpk(Z2[4 * rg], Z2[4 * rg + 1]); y.y = cvtpk(Z2[4 * rg + 2], Z2[4 * rg + 3]); *(LAS v2u*)(wq + 16 * ((4 + rg) ^ sw)) = y; }
    GAS bf16* p1 = (GAS bf16*)io.y2 + (g * 64 + 32 * NB); GAS bf16* p2 = (GAS bf16*)io.y2 + (LRU + g * 64 + 32 * NB);
#pragma unroll
    for (int i = 0; i < 4; ++i) { const int row = 8 * i + (lane >> 3); const int ch = (lane & 7) ^ ((row >> 1) & 7);
        const v4u v = *(const LAS v4u*)(stg + i * 1024 + 16 * lane);
        GAS bf16* dst = (ch < 4) ? p1 + ((unsigned)(rowbase + row) * (unsigned)DM + 8u * ch) : p2 + ((unsigned)(rowbase + row) * (unsigned)DM + 8u * (ch - 4));
        *(GAS v4u*)dst = v; }
}
template <bool SAMPLE>
__device__ __forceinline__ void rgc_task(const RgIo& io, const LAS float* cw, const LAS float* cb, const LAS unsigned char* gwl, LAS unsigned char* stg, int g, int bc, int lane_in) {
    int lane = lane_in; asm volatile("" : "+v"(lane));
    const bf16x8 E0 = make_E(0, lane), E1 = make_E(1, lane), F0 = make_F(0, lane), F1 = make_F(1, lane);
    const int c = SAMPLE ? 0 : (bc & 15), bu = SAMPLE ? 0 : (bc >> 4);
    const int hi = lane >> 5, cl = lane & 31;
    const RgConst rc0 = rg_load_consts(io, g, 0, lane), rc1 = rg_load_consts(io, g, 1, lane);
    const int row0 = SAMPLE ? MP + bc * 32 : bu * SEQ + 128 * c;
    constexpr int NTL = SAMPLE ? 1 : 4;
    float ch0 = 0.f, ch1 = 0.f, cp0 = 1.f, cp1 = 1.f;
    RgX X;
    rg_xload<SAMPLE, 1>(X, io.wsb, row0, 128 * c, SAMPLE ? bc * 4 : 0, g, lane);
#pragma unroll 1
    for (int k = 0; k < NTL; ++k) {
        const int rowbase = row0 + 32 * k, bs0 = SAMPLE ? bc * 4 : 0;
        rg_xload<SAMPLE, 0>(X, io.wsb, rowbase, 128 * c + 32 * k, bs0, g, lane);
        bf16x8 af[4];
        rg_conv(X, g, lane, cw, cb, af);
        const bf16x8 g0 = X.g[0], g1 = X.g[1], g2 = X.g[2], g3 = X.g[3];
        __builtin_amdgcn_sched_barrier(0);
        f32x16 Z1, Z2;
        rgc_block<SAMPLE, 0>(io, gwl, af, g0, g1, g, bs0, lane, E0, E1, F0, F1, rc0, ch0, cp0, Z1, Z2);
        rgc_store<0>(io, stg, Z1, Z2, g, rowbase, lane);
        __builtin_amdgcn_sched_barrier(0);
        rgc_block<SAMPLE, 1>(io, gwl, af, g2, g3, g, bs0, lane, E0, E1, F0, F1, rc1, ch1, cp1, Z1, Z2);
        __builtin_amdgcn_sched_barrier(0);
        if (!SAMPLE) { if (k + 1 < NTL) rg_xload<SAMPLE, 1>(X, io.wsb, rowbase + 32, 128 * c + 32 * k + 32, 0, g, lane); }
        __builtin_amdgcn_sched_barrier(0);
        rgc_store<1>(io, stg, Z1, Z2, g, rowbase, lane);
    }
    if (!SAMPLE) {
        if (hi == 0) { const size_t o = ((size_t)bu * 16 + c) * LRU + g * 64 + cl;
            ((GAS float*)io.suma)[o] = cp0; ((GAS float*)io.sumh)[o] = ch0; ((GAS float*)io.suma)[o + 32] = cp1; ((GAS float*)io.sumh)[o + 32] = ch1; }
        if (c == 15) {
#pragma unroll
            for (int j = 0; j < 3; ++j) { const unsigned short xv = ((const GAS bf16*)io.proj)[(size_t)(bu * SEQ + SEQ - 3 + j) * NIN + 1536 + g * 64 + lane];
                ((GAS float*)io.out)[OFF_NCP + ((size_t)bu * 3 + j) * LRU + g * 64 + lane] = __uint_as_float((unsigned)xv << 16); }
        }
    } else {
#pragma unroll
        for (int sq = 0; sq < 4; ++sq) {
            const int bb = bc * 4 + sq;
#pragma unroll
            for (int j = 0; j < 3; ++j) { const unsigned short xv = ((const GAS bf16*)io.proj)[(size_t)(MP + bb * DECT + 5 + j) * NIN + 1536 + g * 64 + lane];
                ((GAS float*)io.out)[OFF_NCS + ((size_t)bb * 3 + j) * LRU + g * 64 + lane] = __uint_as_float((unsigned)xv << 16); }
        }
    }
}

struct RgRaw { v4u x[4]; v4u h; };
__device__ __forceinline__ void rgp_load(RgRaw& R, const unsigned char* wsb, int rowbase, int tt0, int g, int lane) {
    const GAS unsigned char* pb = (const GAS unsigned char*)wsb;
#pragma unroll
    for (int i = 0; i < 4; ++i) { const int r = 8 * i + (lane >> 3); const unsigned ch = (unsigned)((lane & 7) ^ ((r >> 1) & 7));
        R.x[i] = *(const GAS v4u*)(pb + ((unsigned)WS_PROJ + ((unsigned)(rowbase + r) * (unsigned)NIN + (unsigned)(1536 + g * 64) + 8u * ch) * 2u)); }
    { const int hr = (lane >> 3) < 3 ? (lane >> 3) : 2;
      const unsigned off = (tt0 - 3 + hr >= 0) ? (unsigned)WS_PROJ + ((unsigned)(rowbase - 3 + hr) * (unsigned)NIN + (unsigned)(1536 + g * 64 + 8 * (lane & 7))) * 2u
                                               : (unsigned)WS_XRS + ((unsigned)((DECB * 3 + hr) * LRU + g * 64 + 8 * (lane & 7))) * 2u;
      R.h = *(const GAS v4u*)(pb + off); }
}
__device__ __forceinline__ void rgp_load_gate(v4u (&G)[4], const unsigned char* wsb, int rowbase, int g, int lane) {
    const GAS unsigned char* pb = (const GAS unsigned char*)wsb;
#pragma unroll
    for (int i = 0; i < 4; ++i) { const int r = 8 * i + (lane >> 3); const unsigned ch = (unsigned)((lane & 7) ^ ((r >> 1) & 7));
        G[i] = *(const GAS v4u*)(pb + ((unsigned)WS_PROJ + ((unsigned)(rowbase + r) * (unsigned)NIN + (unsigned)(2048 + g * 64) + 8u * ch) * 2u)); }
}
__device__ __forceinline__ void rgp_task(const RgIo& io, const LAS float* cw, const LAS float* cb, const LAS unsigned char* gwl, LAS unsigned char* stg, LAS unsigned char* hal, int g, int bc, int lane_in) {
    int lane = lane_in; asm volatile("" : "+v"(lane));
    const bf16x8 E0 = make_E(0, lane), E1 = make_E(1, lane), F0 = make_F(0, lane), F1 = make_F(1, lane);
    const int c = bc & 15, bu = bc >> 4;
    const int hi = lane >> 5, cl = lane & 31;
    const RgConst rc0 = rg_load_consts(io, g, 0, lane), rc1 = rg_load_consts(io, g, 1, lane);
    const int row0 = bu * SEQ + 128 * c;
    float ch0 = 0.f, ch1 = 0.f, cp0 = 1.f, cp1 = 1.f;
    RgRaw R;
    rgp_load(R, io.wsb, row0, 128 * c, g, lane);
#pragma unroll 1
    for (int k = 0; k < 4; ++k) {
        const int rowbase = row0 + 32 * k;
        RgX X;
        v4u GR[4]; rgp_load_gate(GR, io.wsb, rowbase, g, lane);
#pragma unroll
        for (int i = 0; i < 4; ++i) *(LAS v4u*)(stg + i * 1024 + 16 * lane) = R.x[i];
        *(LAS v4u*)(hal + 16 * lane) = R.h;
#pragma unroll
        for (int j = 0; j < 4; ++j) { const int rr = cl - 3 + j; const LAS unsigned char* rp = rr >= 0 ? stg + rr * 128 : hal + (rr + 3) * 128; const int sw = rr >= 0 ? ((rr >> 1) & 7) : 0;
#pragma unroll
            for (int ks = 0; ks < 4; ++ks) X.x[ks][j] = *(const LAS v4u*)(rp + 16 * ((2 * ks + hi) ^ sw)); }
#pragma unroll
        for (int i = 0; i < 4; ++i) *(LAS v4u*)(stg + i * 1024 + 16 * lane) = GR[i];
        { const int sw = (cl >> 1) & 7;
#pragma unroll
          for (int ks = 0; ks < 4; ++ks) X.g[ks] = *(const LAS bf16x8*)(stg + cl * 128 + 16 * ((2 * ks + hi) ^ sw)); }
        bf16x8 af[4];
        rg_conv(X, g, lane, cw, cb, af);
        const bf16x8 g0 = X.g[0], g1 = X.g[1], g2 = X.g[2], g3 = X.g[3];
        __builtin_amdgcn_sched_barrier(0);
        { const int kn = k < 3 ? k + 1 : k; rgp_load(R, io.wsb, row0 + 32 * kn, 128 * c + 32 * kn, g, lane); }
        __builtin_amdgcn_sched_barrier(0);
        f32x16 Z1, Z2;
        rgc_block<false, 0>(io, gwl, af, g0, g1, g, 0, lane, E0, E1, F0, F1, rc0, ch0, cp0, Z1, Z2);
        rgc_store<0>(io, stg, Z1, Z2, g, rowbase, lane);
        __builtin_amdgcn_sched_barrier(0);
        rgc_block<false, 1>(io, gwl, af, g2, g3, g, 0, lane, E0, E1, F0, F1, rc1, ch1, cp1, Z1, Z2);
        __builtin_amdgcn_sched_barrier(0);
        rgc_store<1>(io, stg, Z1, Z2, g, rowbase, lane);
    }
    if (hi == 0) { const size_t o = ((size_t)bu * 16 + c) * LRU + g * 64 + cl;
        ((GAS float*)io.suma)[o] = cp0; ((GAS float*)io.sumh)[o] = ch0; ((GAS float*)io.suma)[o + 32] = cp1; ((GAS float*)io.sumh)[o + 32] = ch1; }
    if (c == 15) {
#pragma unroll
        for (int j = 0; j < 3; ++j) { const unsigned short xv = ((const GAS bf16*)io.proj)[(size_t)(bu * SEQ + SEQ - 3 + j) * NIN + 1536 + g * 64 + lane];
            ((GAS float*)io.out)[OFF_NCP + ((size_t)bu * 3 + j) * LRU + g * 64 + lane] = __uint_as_float((unsigned)xv << 16); }
    }
}

template <int NP> struct CmbIn { float ls[NP]; v4u o[NP]; v4u y1, y2; };
template <int NP>
__device__ __forceinline__ void combine_load(CmbIn<NP>& in, const bf16* ob, const float* lse, size_t pstride_rows, size_t row, const bf16* y2_row, const bf16* mixed_row, int lane) {
    const int h = lane >> 3;
#pragma unroll
    for (int p = 0; p < NP; ++p) { in.ls[p] = ((const GAS float*)lse)[(p * pstride_rows + row) * 8 + h]; in.o[p] = __builtin_nontemporal_load((const GAS v4u*)((const GAS bf16*)ob + (p * pstride_rows + row) * ATT + 8 * lane)); }
    in.y1 = __builtin_nontemporal_load((const GAS v4u*)((const GAS bf16*)y2_row + 8 * lane));
    in.y2 = __builtin_nontemporal_load((const GAS v4u*)((const GAS bf16*)y2_row + LRU + 8 * lane));
}
template <int NP>
__device__ __forceinline__ void combine_finish(const CmbIn<NP>& in, const f32x4 g0, const f32x4 g1, const f32x4 r0, const f32x4 r1, const float (&hin8)[8], bf16* mixed_row, int lane) {
    float mx = NEGV;
#pragma unroll
    for (int p = 0; p < NP; ++p) mx = fmaxf(mx, in.ls[p]);
    float acc[8], wsum = 0.f;
#pragma unroll
    for (int i = 0; i < 8; ++i) acc[i] = 0.f;
#pragma unroll
    for (int p = 0; p < NP; ++p) { const float wgt = ex2(in.ls[p] - mx); wsum += wgt; const v4u o = in.o[p];
        acc[0] += wgt * bflo(o.x); acc[1] += wgt * bfhi(o.x); acc[2] += wgt * bflo(o.y); acc[3] += wgt * bfhi(o.y);
        acc[4] += wgt * bflo(o.z); acc[5] += wgt * bfhi(o.z); acc[6] += wgt * bflo(o.w); acc[7] += wgt * bfhi(o.w); }
    const v4u y1 = in.y1, y2 = in.y2;
    float rn[8];
    rn[0] = bflo(y1.x) + bflo(y2.x) * hin8[0]; rn[1] = bfhi(y1.x) + bfhi(y2.x) * hin8[1]; rn[2] = bflo(y1.y) + bflo(y2.y) * hin8[2]; rn[3] = bfhi(y1.y) + bfhi(y2.y) * hin8[3];
    rn[4] = bflo(y1.z) + bflo(y2.z) * hin8[4]; rn[5] = bfhi(y1.z) + bfhi(y2.z) * hin8[5]; rn[6] = bflo(y1.w) + bflo(y2.w) * hin8[6]; rn[7] = bfhi(y1.w) + bfhi(y2.w) * hin8[7];
    const float iw = 1.0f / wsum; float ss = 0.f, sr = 0.f;
#pragma unroll
    for (int i = 0; i < 8; ++i) { acc[i] *= iw; ss += acc[i] * acc[i]; sr += rn[i] * rn[i]; }
    const float rstd = 1.0f / sqrtf(wave_sum(ss) * (1.0f / ATT) + NORM_EPS);
    const float rstdr = 1.0f / sqrtf(wave_sum(sr) * (1.0f / LRU) + NORM_EPS);
    v4u w; w.x = cvtpk(acc[0] * rstd * g0[0], acc[1] * rstd * g0[1]); w.y = cvtpk(acc[2] * rstd * g0[2], acc[3] * rstd * g0[3]);
    w.z = cvtpk(acc[4] * rstd * g1[0], acc[5] * rstd * g1[1]); w.w = cvtpk(acc[6] * rstd * g1[2], acc[7] * rstd * g1[3]);
    NT_ST(w, (GAS v4u*)((GAS bf16*)mixed_row + 8 * lane));
    v4u z; z.x = cvtpk(rn[0] * rstdr * r0[0], rn[1] * rstdr * r0[1]); z.y = cvtpk(rn[2] * rstdr * r0[2], rn[3] * rstdr * r0[3]);
    z.z = cvtpk(rn[4] * rstdr * r1[0], rn[5] * rstdr * r1[1]); z.w = cvtpk(rn[6] * rstdr * r1[2], rn[7] * rstdr * r1[3]);
    NT_ST(z, (GAS v4u*)((GAS bf16*)mixed_row + ATT + 8 * lane));
}
template <int NP>
__device__ __forceinline__ void combine_row(const bf16* ob, const float* lse, size_t pstride_rows, size_t row, const float* attg, const float* rnng, const bf16* y2_row, const float (&hin8)[8], bf16* mixed_row, int lane) {
    CmbIn<NP> in; combine_load<NP>(in, ob, lse, pstride_rows, row, y2_row, mixed_row, lane);
    const f32x4 g0 = *(const GAS f32x4*)((const GAS float*)attg + 8 * lane), g1 = *(const GAS f32x4*)((const GAS float*)attg + 8 * lane + 4);
    const f32x4 r0 = *(const GAS f32x4*)((const GAS float*)rnng + 8 * lane), r1 = *(const GAS f32x4*)((const GAS float*)rnng + 8 * lane + 4);
    combine_finish<NP>(in, g0, g1, r0, r1, hin8, mixed_row, lane);
}
__device__ __forceinline__ void combine_run(const bf16* ob, const float* lse, const float* attg, const float* rnng, const bf16* y2, const float* suma, const float* sumh, bf16* mixed, float* out, int run, int lane) {
    const int row0 = run * 16, b = row0 >> 11, c = (row0 >> 7) & 15;
    float hin[8];
#pragma unroll
    for (int i = 0; i < 8; ++i) hin[i] = 0.f;
    const GAS float* pa = (const GAS float*)suma + (size_t)b * 16 * LRU + 8 * lane; const GAS float* ph = (const GAS float*)sumh + (size_t)b * 16 * LRU + 8 * lane;
#pragma unroll 1
    for (int c0 = 0; c0 < c; c0 += 8) {
        f32x4 a0[8], a1[8], h0[8], h1[8];
#pragma unroll
        for (int u = 0; u < 8; ++u) { const int cc = c0 + u < 16 ? c0 + u : 15;
            a0[u] = *(const GAS f32x4*)(pa + cc * LRU); a1[u] = *(const GAS f32x4*)(pa + cc * LRU + 4); h0[u] = *(const GAS f32x4*)(ph + cc * LRU); h1[u] = *(const GAS f32x4*)(ph + cc * LRU + 4); }
#pragma unroll
        for (int u = 0; u < 8; ++u) { if (c0 + u < c) {
#pragma unroll
            for (int i = 0; i < 4; ++i) { hin[i] = a0[u][i] * hin[i] + h0[u][i]; hin[4 + i] = a1[u][i] * hin[4 + i] + h1[u][i]; } } }
    }
    const f32x4 g0 = *(const GAS f32x4*)((const GAS float*)attg + 8 * lane), g1 = *(const GAS f32x4*)((const GAS float*)attg + 8 * lane + 4);
    const f32x4 r0 = *(const GAS f32x4*)((const GAS float*)rnng + 8 * lane), r1 = *(const GAS f32x4*)((const GAS float*)rnng + 8 * lane + 4);
    CmbIn<3> A, B;
    combine_load<3>(A, ob, lse, (size_t)MT, (size_t)row0, y2 + (size_t)row0 * DM, mixed + (size_t)row0 * DM, lane);
#pragma unroll 1
    for (int r = 0; r < 16; r += 2) {
        { const size_t row = (size_t)row0 + r + 1; combine_load<3>(B, ob, lse, (size_t)MT, row, y2 + row * DM, mixed + row * DM, lane); }
        __builtin_amdgcn_sched_barrier(0);
        combine_finish<3>(A, g0, g1, r0, r1, hin, mixed + ((size_t)row0 + r) * DM, lane);
        __builtin_amdgcn_sched_barrier(0);
        { const size_t row = (size_t)row0 + (r + 2 < 16 ? r + 2 : r); combine_load<3>(A, ob, lse, (size_t)MT, row, y2 + row * DM, mixed + row * DM, lane); }
        __builtin_amdgcn_sched_barrier(0);
        combine_finish<3>(B, g0, g1, r0, r1, hin, mixed + ((size_t)row0 + r + 1) * DM, lane);
    }
    if ((row0 & (SEQ - 1)) == SEQ - 16) {
        const f32x4 a0 = *(const GAS f32x4*)(pa + 15 * LRU), a1 = *(const GAS f32x4*)(pa + 15 * LRU + 4), h0 = *(const GAS f32x4*)(ph + 15 * LRU), h1 = *(const GAS f32x4*)(ph + 15 * LRU + 4);
        f32x4 o0, o1;
#pragma unroll
        for (int i = 0; i < 4; ++i) { o0[i] = a0[i] * hin[i] + h0[i]; o1[i] = a1[i] * hin[4 + i] + h1[i]; }
        GAS float* po = (GAS float*)out + OFF_NHP + (size_t)b * LRU + 8 * lane; *(GAS f32x4*)po = o0; *(GAS f32x4*)(po + 4) = o1;
    }
}

template <int NR>
__device__ __forceinline__ void final_norm_rows(const bf16* xb, float* y, const float* g, int m0, int stride, int lane) {
    v2u v[NR][4];
#pragma unroll
    for (int r = 0; r < NR; ++r) { const int m = m0 + r * stride; const int mc = m < MP ? m : MP - 1; const GAS v2u* xr = (const GAS v2u*)(xb + (size_t)mc * DM) + lane;
#pragma unroll
        for (int j = 0; j < 4; ++j) v[r][j] = xr[64 * j]; }
    const GAS f32x4* gr = (const GAS f32x4*)g + lane;
    f32x4 gg[4];
#pragma unroll
    for (int j = 0; j < 4; ++j) gg[j] = gr[64 * j];
#pragma unroll
    for (int r = 0; r < NR; ++r) { const int m = m0 + r * stride;
        f32x4 a[4]; float s = 0.f;
#pragma unroll
        for (int j = 0; j < 4; ++j) { a[j] = (f32x4){bflo(v[r][j].x), bfhi(v[r][j].x), bflo(v[r][j].y), bfhi(v[r][j].y)}; s += (a[j].x * a[j].x + a[j].y * a[j].y) + (a[j].z * a[j].z + a[j].w * a[j].w); }
        const float rstd = 1.0f / sqrtf(wave_sum(s) * (1.f / DM) + NORM_EPS);
        if (m < MP) { GAS f32x4* yr = (GAS f32x4*)(y + (size_t)m * DM) + lane;
#pragma unroll
            for (int j = 0; j < 4; ++j) __builtin_nontemporal_store(a[j] * rstd * gg[j], yr + 64 * j); } }
}
__device__ __forceinline__ void final_norm_sample_row(const bf16* xb, float* y, const float* slab, const float* g, int rs, int lane) {
    GAS f32x4* yr = (GAS f32x4*)(y + (size_t)(MP + rs) * DM) + lane; const GAS f32x4* gr = (const GAS f32x4*)g + lane;
    const GAS v2u* xr = (const GAS v2u*)(xb + (size_t)(MP + rs) * DM) + lane;
    f32x4 v[4];
#pragma unroll
    for (int j = 0; j < 4; ++j) { const v2u w = xr[64 * j]; v[j] = (f32x4){bflo(w.x), bfhi(w.x), bflo(w.y), bfhi(w.y)}; }
#pragma unroll 4
    for (int s = 0; s < 16; ++s) { const GAS f32x4* sp = (const GAS f32x4*)(slab + ((size_t)s * MS + rs) * DM) + lane;
#pragma unroll
        for (int j = 0; j < 4; ++j) v[j] += sp[64 * j]; }
    float sm = 0.f;
#pragma unroll
    for (int j = 0; j < 4; ++j) sm += (v[j].x * v[j].x + v[j].y * v[j].y) + (v[j].z * v[j].z + v[j].w * v[j].w);
    const float rstd = 1.0f / sqrtf(wave_sum(sm) * (1.f / DM) + NORM_EPS);
#pragma unroll
    for (int j = 0; j < 4; ++j) yr[64 * j] = v[j] * rstd * gr[64 * j];
}

#ifndef REP_P0
#define REP_P0 1
#endif
#ifndef REP_BAR
#define REP_BAR 0
#endif
#ifndef REP_PA
#define REP_PA 1
#endif
#ifndef P6_AUXA
#define P6_AUXA 0
#endif
#ifndef PA_DUMMY
#define PA_DUMMY 0
#endif
#ifndef REP_SA
#define REP_SA 1
#endif
#ifndef REP_RG
#define REP_RG 1
#endif
#ifndef REP_P7
#define REP_P7 1
#endif
#ifndef REP_CMB
#define REP_CMB 1
#endif
#ifndef REP_P1
#define REP_P1 1
#endif
#ifndef REP_P4
#define REP_P4 1
#endif
#ifndef REP_P5
#define REP_P5 1
#endif
#ifndef LATE_W
#define LATE_W 1
#endif
#ifndef REP_ALL
#define REP_ALL 1
#endif
#ifndef REP_P6
#define REP_P6 1
#endif

#ifdef SK_PA
#define DO_PA(x)
#else
#define DO_PA(x) x
#endif
#ifdef SK_RA
#define DO_RA(x)
#else
#define DO_RA(x) x
#endif
#ifdef SK_SA
#define DO_SA(x)
#else
#define DO_SA(x) x
#endif
#ifdef SK_RB
#define DO_RB(x)
#else
#define DO_RB(x) x
#endif
#ifdef SK_RBS
#define DO_RBS(x)
#else
#define DO_RBS(x) x
#endif
#ifdef SK_GEMM
#define DO_GEMM if (0)
#else
#define DO_GEMM
#endif

#ifndef STAG1
#define STAG1 0
#endif
#ifndef STAG4
#define STAG4 0
#endif
#ifndef STAG5
#define STAG5 0
#endif
#define STAGGER(nunits, ticks) do { if ((ticks) > 0 && bx >= (nunits) % G) { const unsigned long long t0_ = __builtin_amdgcn_s_memrealtime(), d_ = (unsigned long long)(1 + ((bx >> 5) % 3)) * (ticks); \
        while (__builtin_amdgcn_s_memrealtime() - t0_ < d_) __builtin_amdgcn_s_sleep(8); } } while (0)
struct Args { const float* in[23]; float* out; unsigned char* ws; };
constexpr int NWAVES = 8;
__global__ void __launch_bounds__(NWAVES * 64, 2) hymba_fwd(Args args) {
    extern __shared__ __attribute__((aligned(16))) unsigned char lds_raw[];
    LAS unsigned char* lds = (LAS unsigned char*)lds_raw;
    volatile LAS unsigned* MISC = (volatile LAS unsigned*)(lds + MISC_OFF);
    const int wave = __builtin_amdgcn_readfirstlane((int)threadIdx.x >> 6);
    const int G = gridDim.x; const int bx = blockIdx.x; const int vcu = (G % 8 == 0) ? (bx % 8) * (G / 8) + bx / 8 : bx;
    const int gw = vcu * NWAVES + wave, NGW = G * NWAVES;
    unsigned char* ws = args.ws;
    gu32* ctl = (gu32*)(ws + WS_CTL);
    const float* x_prompt = args.in[0]; const float* x_sample = args.in[1]; const float* cache_k = args.in[2]; const float* cache_v = args.in[3];
    const float* state_conv = args.in[4]; const float* state_h = args.in[5]; const float* norm1_g = args.in[6]; const float* w_in = args.in[7];
    const float* rel_bias = args.in[8]; const float* conv_w = args.in[9]; const float* conv_b = args.in[10]; const float* gate_a_w = args.in[11];
    const float* gate_a_b = args.in[12]; const float* gate_x_w = args.in[13]; const float* gate_x_b = args.in[14]; const float* lru_lambda = args.in[15];
    const float* att_out_g = args.in[16]; const float* rnn_out_g = args.in[17]; const float* w_out = args.in[18]; const float* norm2_g = args.in[19];
    const float* w_mlp_in = args.in[20]; const float* w_mlp_out = args.in[21]; const float* final_g = args.in[22];
    float* out = args.out;
    bf16* Win_t = (bf16*)(ws + WS_WIN); bf16* Wout_t = (bf16*)(ws + WS_WOUT); bf16* W1_t = (bf16*)(ws + WS_W1); bf16* W2_t = (bf16*)(ws + WS_W2); bf16* GW = (bf16*)(ws + WS_GW);
    float* SS1 = (float*)(ws + WS_SS1); float* SUMA = (float*)(ws + WS_SUMA); float* SUMH = (float*)(ws + WS_SUMH); bf16* Y2B = (bf16*)(ws + WS_Y2); float* SLAB = (float*)(ws + WS_SLAB);
    float* LSE = (float*)(ws + WS_LSE); float* LSES = (float*)(ws + WS_LSES); bf16* OBS = (bf16*)(ws + WS_OBS); bf16* OB = (bf16*)(ws + WS_OB);
    bf16* XN = (bf16*)(ws + WS_XN); bf16* PROJ = (bf16*)(ws + WS_PROJ); bf16* MIXED = (bf16*)(ws + WS_MIXED); bf16* X1B = (bf16*)(ws + WS_X1B); bf16* HB = (bf16*)(ws + WS_HB);

    for (int u = wave * 64 + lane_id_now(); u < (LDS_BYTES - LDSCTL_OFF) / 4; u += NWAVES * 64) ((LAS unsigned*)(lds + LDSCTL_OFF))[u] = 0u;
    __syncthreads();
    XcdBarrier bar = xcd_barrier_post((unsigned*)(ctl + CW_BAR), MISC + 8, wave);

    for (int rep_ = 0; rep_ < REP_P0; ++rep_) {
        const int lane0 = lane_id_now();
        LAS float* scr = (LAS float*)(lds + RING_OFF + wave * 16384);
        constexpr int I_IN = (DM / 64) * (NIN / 32), I_O = (DM / 64) * (DM / 32), I_1 = (DM / 64) * (FF / 32), I_2 = (FF / 64) * (DM / 32);
        constexpr int NITEMS = I_IN + I_O + I_1 + I_2;
        for (int it = gw; it < (LATE_W ? I_IN : NITEMS); it += NGW) {
            int r = it;
            if (r < I_IN) { p0_transpose_item(w_in, nullptr, DM, NIN, Win_t, scr, r, lane0); continue; } r -= I_IN;
            if (r < I_O) { p0_transpose_item(w_out, nullptr, DM, DM, Wout_t, scr, r, lane0); continue; } r -= I_O;
            if (r < I_1) { p0_transpose_item(w_mlp_in, norm2_g, DM, FF, W1_t, scr, r, lane0); continue; } r -= I_1;
            p0_transpose_item(w_mlp_out, nullptr, FF, DM, W2_t, scr, r, lane0);
        }
        for (int idx = gw * 64 + lane0; idx < 2 * 8 * 64 * 64; idx += NGW * 64) {
            const int mat = idx >> 15, g = (idx >> 12) & 7, o = (idx >> 6) & 63, i = idx & 63;
            const float v = (mat ? gate_x_w : gate_a_w)[g * 4096 + i * 64 + o];
            GW[idx] = (bf16)(cvtpk(v, v) & 0xffffu);
        }
        for (int idx = gw * 64 + lane0; idx < NTAB; idx += NGW * 64) ((float*)(ws + WS_TAB))[idx] = table_entry(rel_bias, idx);
        for (int idx = gw * 64 + lane0; idx < (DECB + 1) * 3 * LRU; idx += NGW * 64) { const float v = idx < DECB * 3 * LRU ? state_conv[idx] : 0.f; ((bf16*)(ws + WS_XRS))[idx] = (bf16)(cvtpk(v, v) & 0xffffu); }
        for (int m0 = gw; m0 < MT; m0 += 4 * NGW) rms_rows_to_bf16<4>(x_prompt, x_sample, norm1_g, XN, m0, NGW, lane0);
    }
    xcd_barrier(bar);

    {
        pg8::Gemm g{XN, Win_t, MT, NIN, DM}; pg8::StaticOrder S; S.init(MT, NIN, G, bx);
        pg8::EpiInProj E{PROJ, out, QSCALE};
        STAGGER(1320, STAG1);
        for (int rep_ = 0; rep_ < REP_P1; ++rep_) { DO_GEMM pg8::gemm_phase<pg8::EpiInProj, pg8::StaticOrder, true, true>(lds + RING_OFF, g, S, E, wave); }
        constexpr int TAIL1 = ((MT / 256) * (NIN / 256)) % 256;
        if (LATE_W) {
            const bool all = (G != 256);
            if (all || bx >= TAIL1) {
                __syncthreads();
                const int lane1 = lane_id_now();
                LAS float* scr = (LAS float*)(lds + RING_OFF + wave * 16384);
                constexpr int I_O = (DM / 64) * (DM / 32), I_1 = (DM / 64) * (FF / 32), I_2 = (FF / 64) * (DM / 32);
                const int w2 = ((all ? bx : bx - TAIL1) * NWAVES + wave), nw2 = (all ? G : G - TAIL1) * NWAVES;
                for (int it = w2; it < I_O + I_1 + I_2; it += nw2) {
                    int r = it;
                    if (r < I_O) { p0_transpose_item(w_out, nullptr, DM, DM, Wout_t, scr, r, lane1); continue; } r -= I_O;
                    if (r < I_1) { p0_transpose_item(w_mlp_in, norm2_g, DM, FF, W1_t, scr, r, lane1); continue; } r -= I_1;
                    p0_transpose_item(w_mlp_out, nullptr, FF, DM, W2_t, scr, r, lane1);
                }
            }
        }
    }
    xcd_barrier(bar);

    {
        const int rgg = vcu & 7;
        const int lane = lane_id_now();
        build_tables(lds, (const float*)(ws + WS_TAB), conv_w, conv_b, GW, rgg, wave * 64 + lane);
        __syncthreads();
        const LAS float* btab = (const LAS float*)(lds + BT_OFF); const LAS float* tabS = (const LAS float*)(lds + TS_OFF);
        const LAS float* cw = (const LAS float*)(lds + CW_OFF); const LAS float* cb = (const LAS float*)(lds + CB_OFF);
        const RgIo io{PROJ, ws, state_h, gate_a_b, gate_x_b, lru_lambda, GW, MIXED, Y2B, SUMA, SUMH, out};
        const int sagrp = gw % 3;
#define SA_PASS() do { for (int rep_ = 0; rep_ < REP_SA; ++rep_) for (int id = gw; id < 4096; id += NGW) sa_task(PROJ, cache_k, cache_v, OBS, LSES, tabS, lds + STG_OFF + wave * 4096, id, lane); } while (0)
#define PA_PASS(lo, hi) do { for (int rep_ = 0; rep_ < REP_PA; ++rep_) for (int id = gw + (lo) * NGW; id < 24576 && id < (hi); id += NGW) \
        pa_task(PROJ, rep_ ? (bf16*)HB : OB, rep_ ? (float*)(HB + (size_t)MT * 2048) : LSE, out, btab, lds + STG_OFF + wave * 4096, id, lane, rep_ ? PA_DUMMY : 0); } while (0)
        if (sagrp == 0) SA_PASS();
        PA_PASS(0, gw + 6 * NGW);
        if (sagrp == 1) SA_PASS();
        PA_PASS(6, 24576);
        { const LAS unsigned char* gwl = lds + GWL_OFF;
          for (int rep_ = 0; rep_ < REP_RG; ++rep_) { for (int bc = (vcu >> 3) * NWAVES + wave; bc < 256; bc += (G >> 3) * NWAVES) rgp_task(io, cw, cb, gwl, lds + STG_OFF + wave * 4096, lds + HAL_OFF + wave * 1024, rgg, bc, lane);
              if (wave == NWAVES - 1) for (int bc = vcu >> 3; bc < 32; bc += (G >> 3)) rgc_task<true>(io, cw, cb, gwl, lds + STG_OFF + wave * 4096, rgg, bc, lane); } }
        if (sagrp == 2) SA_PASS();
#undef SA_PASS
#undef PA_PASS
    }
    xcd_barrier(bar);

    for (int rep_ = 0; rep_ < REP_BAR; ++rep_) xcd_barrier(bar);
    for (int rep_ = 0; rep_ < REP_CMB; ++rep_) {
        const int lane3 = lane_id_now();
        for (int run = gw; run < MP / 16; run += NGW) combine_run(OB, LSE, att_out_g, rnn_out_g, Y2B, SUMA, SUMH, MIXED, out, run, lane3);
        const float hz[8] = {0.f, 0.f, 0.f, 0.f, 0.f, 0.f, 0.f, 0.f};
        for (int rs = gw; rs < MS; rs += NGW) combine_row<4>(OBS, LSES, (size_t)MS, (size_t)rs, att_out_g, rnn_out_g, Y2B + (size_t)(MP + rs) * DM, hz, MIXED + (size_t)(MP + rs) * DM, lane3);
    }
    xcd_barrier(bar);

    {
        const int NSW = 16, GB = G - NSW;
        pg8::StaticOrder S4p; S4p.init(MP, DM, G, bx); pg8::StaticOrder S4s; S4s.init(MS, DM, G, bx); pg8::StaticOrder S5; S5.init(MT, FF, G, bx);
        const pg8::Gemm g4{MIXED, Wout_t, MT, DM, DM}; const pg8::Gemm g5{X1B, W1_t, MT, FF, DM};
        const pg8::EpiWout E4{x_prompt, x_sample, X1B, SS1}; const pg8::EpiUp E5{HB, SS1};
        { const pg8::RangeOrder R{S4p, 0, (MP / 256) * (DM / 256), G, bx, 0};
          for (int rep_ = 0; rep_ < REP_P4; ++rep_) { DO_GEMM pg8::gemm_phase<pg8::EpiWout, pg8::RangeOrder, true, true>(lds + RING_OFF, g4, R, E4, wave); } }
        xcd_barrier(bar);
        if (bx >= GB) { const pg8::RangeOrder R{S4s, 0, (MS / 256) * (DM / 256), NSW, bx - GB, MP / 256};
          DO_GEMM pg8::gemm_phase<pg8::EpiWout, pg8::RangeOrder, true, true>(lds + RING_OFF, g4, R, E4, wave); }
        else { const pg8::RangeOrder R{S5, 0, 2 * GB, GB, bx, 0};
          DO_GEMM pg8::gemm_phase<pg8::EpiUp, pg8::RangeOrder, true, true>(lds + RING_OFF, g5, R, E5, wave); }
        xcd_barrier(bar);
        { const pg8::RangeOrder R{S5, 2 * GB, (MT / 256) * (FF / 256), G, bx, 0};
          for (int rep_ = 0; rep_ < REP_P5; ++rep_) { DO_GEMM pg8::gemm_phase<pg8::EpiUp, pg8::RangeOrder, true, true>(lds + RING_OFF, g5, R, E5, wave); } }
    }
    xcd_barrier(bar);

    {
        { pg8::Gemm g{HB, W2_t, MP, DM, FF}; pg8::StaticOrder S; S.init(MP, DM, G, bx);
          for (int rep_ = 0; rep_ < REP_P6; ++rep_) { pg8::EpiDown E{X1B, rep_ + 1 < REP_P6 ? XN : X1B};
          DO_GEMM pg8::gemm_phase<pg8::EpiDown, pg8::StaticOrder, true, true>(lds + RING_OFF, g, S, E, wave); } }
        __syncthreads();
        { pg8::Gemm g2{(const bf16*)(args.ws + WS_HB), (const bf16*)(args.ws + WS_W2), MT, DM, 256, FF}; const pg8::SplitKOrder S2{(int)gridDim.x, (int)blockIdx.x, 16};
          pg8::EpiSlab E2{(float*)(args.ws + WS_SLAB)};
          DO_GEMM pg8::gemm_phase<pg8::EpiSlab, pg8::SplitKOrder, false, false>(lds + RING_OFF, g2, S2, E2, wave); }
    }
    xcd_barrier(bar);

    for (int rep7_ = 0; rep7_ < REP_P7; ++rep7_) {
    const int lane7 = lane_id_now();
    for (int m0 = gw; m0 < MP; m0 += 8 * NGW) final_norm_rows<8>(X1B, out + OFF_Y, final_g, m0, NGW, lane7);
    for (int rs = NGW - 1 - gw; rs < MS; rs += NGW) final_norm_sample_row(X1B, out + OFF_Y, SLAB, final_g, rs, lane7);
    }
}

extern "C" void kernel_launch(void* const* d_in, const int* in_sizes, int n_in, void* d_out, int out_size, void* d_ws, size_t ws_size, hipStream_t stream) {
    static int grid = 0;
    if (grid == 0) {
        if (n_in != 23 || in_sizes[0] != MP * DM || (size_t)out_size != OUT_TOTAL || ws_size < WS_END) {
            fprintf(stderr, "kernel_launch: shape mismatch: n_in %d in0 %d out %d ws %zu (need %zu); nothing launched\n", n_in, n_in > 0 ? in_sizes[0] : -1, out_size, ws_size, (size_t)WS_END); grid = -1; return; }
        int dev = 0, cus = 0, per_cu = 0;
        if (hipGetDevice(&dev) != hipSuccess || hipDeviceGetAttribute(&cus, hipDeviceAttributeMultiprocessorCount, dev) != hipSuccess) { fprintf(stderr, "kernel_launch: device query failed\n"); grid = -1; return; }
        if (hipFuncSetAttribute((const void*)hymba_fwd, hipFuncAttributeMaxDynamicSharedMemorySize, LDS_BYTES) != hipSuccess) { fprintf(stderr, "kernel_launch: hipFuncSetAttribute failed\n"); grid = -1; return; }
        if (hipOccupancyMaxActiveBlocksPerMultiprocessor(&per_cu, (const void*)hymba_fwd, NWAVES * 64, LDS_BYTES) != hipSuccess || per_cu < 1)
            fprintf(stderr, "kernel_launch: note: occupancy query reports %d workgroups per CU\n", per_cu);
        (void)hipGetLastError();
        if (cus <= 32) { fprintf(stderr, "kernel_launch: this kernel's unit dealing needs more than 32 CUs (device has %d); nothing launched\n", cus); grid = -1; return; }
        grid = cus;
    }
    if (grid < 0) return;
    if (hipMemsetAsync((char*)d_ws + WS_CTL, 0, CTL_ZERO_BYTES, stream) != hipSuccess) { fprintf(stderr, "kernel_launch: memset failed\n"); return; }
    Args a{};
    for (int i = 0; i < 23; ++i) a.in[i] = (const float*)d_in[i];
    a.out = (float*)d_out; a.ws = (unsigned char*)d_ws;
#ifdef REP_LAUNCH
    for (int r_ = 1; r_ < REP_LAUNCH; ++r_) { hipLaunchKernelGGL(hymba_fwd, dim3(grid), dim3(NWAVES * 64), LDS_BYTES, stream, a); (void)hipMemsetAsync((char*)d_ws + WS_CTL, 0, CTL_ZERO_BYTES, stream); }
#endif
    hipLaunchKernelGGL(hymba_fwd, dim3(grid), dim3(NWAVES * 64), LDS_BYTES, stream, a);
    const hipError_t le = hipPeekAtLastError();
    if (le != hipSuccess) fprintf(stderr, "kernel_launch: launch failed: %s\n", hipGetErrorName(le));
}
```
